# Optimizing an MI355X kernel written in HIP

```python
import math
import jax, jax.numpy as jnp
from jax import lax
import numpy as np

D_MODEL = 1024
BATCH = 8
SEQ = 2048
DEPTH = 2
DEC_BATCH = 128
DEC_SEQ = 8
PAST_LEN = 16384
PAGE_SIZE = 128

MIX_WIDTH = 2 * D_MODEL
SSD_WIDTH = MIX_WIDTH // 2
SSD_HEAD_DIM = 64
SSD_HEADS = SSD_WIDTH // SSD_HEAD_DIM
SSD_GROUPS = 2
SSD_HPG = SSD_HEADS // SSD_GROUPS
SSD_STATE = 128
SSD_CONV_DIM = SSD_WIDTH + 2 * SSD_GROUPS * SSD_STATE
ML_WIDTH = MIX_WIDTH // 4
ML_HEADS = 4
ML_HEAD_DIM = ML_WIDTH // ML_HEADS
LRU_WIDTH = MIX_WIDTH // 4
LRU_BLOCKS = 4
LRU_BLOCK_DIM = LRU_WIDTH // LRU_BLOCKS
LRU_C = 8.0
CONV_W = 4
CHUNK = 128
D_FF = 4 * D_MODEL
EPS = 1e-6
IN_SEGMENTS = (SSD_WIDTH, SSD_CONV_DIM, SSD_HEADS, ML_WIDTH, ML_WIDTH, ML_WIDTH, ML_WIDTH, ML_HEADS, ML_HEADS, LRU_WIDTH, LRU_WIDTH)
IN_DIM = sum(IN_SEGMENTS)

kernel_name = 'hymba_ssd_mlstm_rglru_decoder_step'


def _split_points():
    pts, acc = [], 0
    for s in IN_SEGMENTS[:-1]:
        acc += s
        pts.append(acc)
    return pts


def rmsnorm(x, w):
    xf = x.astype(jnp.float32)
    return xf * lax.rsqrt(jnp.mean(xf * xf, axis=-1, keepdims=True) + EPS) * w.astype(jnp.float32)


def causal_conv(x, buf, w, b):
    T = x.shape[1]
    xpad = jnp.concatenate([buf.astype(jnp.float32), x], axis=1)
    w = w.astype(jnp.float32)
    out = b.astype(jnp.float32) + xpad[:, 0:T] * w[0]
    for j in range(1, CONV_W):
        out = out + xpad[:, j:j + T] * w[j]
    return out, xpad[:, xpad.shape[1] - (CONV_W - 1):]


def causal_mask(L):
    i = jnp.arange(L)
    return i[:, None] >= i[None, :]


def to_chunks(a, L):
    return a.reshape((a.shape[0], a.shape[1] // L, L) + a.shape[2:]).swapaxes(0, 1)


def from_chunks(a):
    a = a.swapaxes(0, 1)
    return a.reshape((a.shape[0], a.shape[1] * a.shape[2]) + a.shape[3:])


def ssd_chunked(x, dt, a, bm, cm, s0):
    L = math.gcd(x.shape[1], CHUNK)
    mask = causal_mask(L)[None, :, :, None, None]

    def step(s, inp):
        xc, dtc, bc, cc = inp
        cum = jnp.cumsum(dtc * a, axis=1)
        decay = jnp.exp(jnp.where(mask, cum[:, :, None] - cum[:, None, :], -jnp.inf))
        att = jnp.einsum('btgn,bsgn->btsg', cc, bc)[..., None] * decay
        xdt = xc * dtc[..., None]
        y = (jnp.einsum('btsge,bsgep->btgep', att, xdt)
             + jnp.einsum('btgn,bgepn->btgep', cc, s) * jnp.exp(cum)[..., None])
        xend = xdt * jnp.exp(cum[:, -1:] - cum)[..., None]
        s = jnp.exp(cum[:, -1])[..., None, None] * s + jnp.einsum('bsgn,bsgep->bgepn', bc, xend)
        return s, y

    s, ys = lax.scan(step, s0, tuple(to_chunks(t, L) for t in (x, dt, bm, cm)))
    return from_chunks(ys), s


def mlstm_chunked(q, k, v, ig, lf, c0, n0, m0):
    L = math.gcd(q.shape[1], CHUNK)
    mask = causal_mask(L)[None, :, :, None]

    def step(carry, inp):
        c, n, m = carry
        qc, kc, vc, ic, fc = inp
        bc = jnp.cumsum(fc, axis=1)
        dmat = jnp.where(mask, bc[:, :, None] - bc[:, None, :] + ic[:, None, :], -jnp.inf)
        g = bc + m[:, None]
        mt = jnp.maximum(g, jnp.max(dmat, axis=2))
        w = jnp.exp(dmat - mt[:, :, None]) * jnp.einsum('bthd,bshd->btsh', qc, kc)
        inter = jnp.exp(g - mt)
        num = jnp.einsum('btsh,bshd->bthd', w, vc) + inter[..., None] * jnp.einsum('bhvd,bthd->bthv', c, qc)
        den = jnp.sum(w, axis=2) + inter * jnp.einsum('bhd,bthd->bth', n, qc)
        hout = num / jnp.maximum(jnp.abs(den), jnp.exp(-mt))[..., None]
        m_new = mt[:, -1]
        w_end = jnp.exp(bc[:, -1:] - bc + ic - m_new[:, None])
        dc = jnp.exp(bc[:, -1] + m - m_new)
        c = dc[..., None, None] * c + jnp.einsum('bshv,bshd->bhvd', vc * w_end[..., None], kc)
        n = dc[..., None] * n + jnp.einsum('bsh,bshd->bhd', w_end, kc)
        return (c, n, m_new), hout

    (c, n, m), hs = lax.scan(step, (c0, n0, m0), tuple(to_chunks(t, L) for t in (q, k, v, ig, lf)))
    return from_chunks(hs), c, n, m


def block_diag(x, w):
    b, T = x.shape[0], x.shape[1]
    xb = x.reshape(b, T, LRU_BLOCKS, LRU_BLOCK_DIM)
    return jnp.einsum('btkc,kcd->btkd', xb, w.astype(jnp.float32)).reshape(b, T, LRU_WIDTH)


def lru_scan(a, u, h0):
    u = u.at[:, 0].add(a[:, 0] * h0)

    def combine(left, right):
        return left[0] * right[0], right[0] * left[1] + right[1]

    _, hs = lax.associative_scan(combine, (a, u), axis=1)
    return hs, hs[:, -1]


def mixer(h, l, P, st, start_pos):
    f32 = jnp.float32
    b, T = h.shape[0], h.shape[1]
    ssm0, sconv0, mc0, mn0, mm0, lh0, lconv0 = (s.astype(f32) for s in st)
    u = jnp.matmul(h, P['w_in'][l]).astype(f32)
    z, xbc, dt_raw, q, k, v, o, ig, fg, xr, gr = jnp.split(u, _split_points(), axis=-1)

    xbc, sconv = causal_conv(xbc, sconv0, P['ssd_conv_w'][l], P['ssd_conv_b'][l])
    xbc = jax.nn.silu(xbc)
    xs, bm, cm = jnp.split(xbc, [SSD_WIDTH, SSD_WIDTH + SSD_GROUPS * SSD_STATE], axis=-1)
    dt = jax.nn.softplus(dt_raw + P['ssd_dt_bias'][l].astype(f32))
    a = -jnp.exp(P['ssd_a_log'][l].astype(f32))
    y, ssm = ssd_chunked(
        xs.reshape(b, T, SSD_GROUPS, SSD_HPG, SSD_HEAD_DIM),
        dt.reshape(b, T, SSD_GROUPS, SSD_HPG),
        a.reshape(SSD_GROUPS, SSD_HPG),
        bm.reshape(b, T, SSD_GROUPS, SSD_STATE),
        cm.reshape(b, T, SSD_GROUPS, SSD_STATE),
        ssm0.reshape(b, SSD_GROUPS, SSD_HPG, SSD_HEAD_DIM, SSD_STATE))
    y = y.reshape(b, T, SSD_WIDTH) + xs * jnp.repeat(P['ssd_d'][l].astype(f32), SSD_HEAD_DIM)
    y_ssd = rmsnorm(y * jax.nn.silu(z), P['ssd_norm_w'][l])
    ssm = ssm.reshape(b, SSD_HEADS, SSD_HEAD_DIM, SSD_STATE)

    hd = (b, T, ML_HEADS, ML_HEAD_DIM)
    hm, mc, mn, mm = mlstm_chunked(
        q.reshape(hd), k.reshape(hd) * (ML_HEAD_DIM ** -0.5), v.reshape(hd),
        ig + P['ml_i_bias'][l].astype(f32),
        jax.nn.log_sigmoid(fg + P['ml_f_bias'][l].astype(f32)),
        mc0, mn0, mm0)
    y_ml = rmsnorm(hm, P['ml_norm_w'][l].reshape(ML_HEADS, ML_HEAD_DIM)).reshape(b, T, ML_WIDTH) * jax.nn.sigmoid(o)

    xr, lconv = causal_conv(xr, lconv0, P['lru_conv_w'][l], P['lru_conv_b'][l])
    r = jax.nn.sigmoid(block_diag(xr, P['lru_wa'][l]) + P['lru_ba'][l].astype(f32))
    i = jax.nn.sigmoid(block_diag(xr, P['lru_wx'][l]) + P['lru_bx'][l].astype(f32))
    log_a = -LRU_C * r * jax.nn.softplus(-P['lru_lambda'][l].astype(f32))
    pos = start_pos + jnp.arange(T)
    mult = jnp.where((pos == 0)[None, :, None], 1.0, jnp.sqrt(-jnp.expm1(2.0 * log_a)))
    hr, lh = lru_scan(jnp.exp(log_a), mult * i * xr, lh0)
    y_lru = hr * jax.nn.gelu(gr)

    ycat = jnp.concatenate([y_ssd, y_ml, y_lru], axis=-1).astype(h.dtype)
    out = jnp.matmul(ycat, P['w_out'][l])
    return out, (ssm, sconv, mc, mn, mm, lh, lconv)


def zero_states(b):
    z = lambda s: jnp.zeros(s, jnp.float32)
    return (z((DEPTH, b, SSD_HEADS, SSD_HEAD_DIM, SSD_STATE)),
            z((DEPTH, b, CONV_W - 1, SSD_CONV_DIM)),
            z((DEPTH, b, ML_HEADS, ML_HEAD_DIM, ML_HEAD_DIM)),
            z((DEPTH, b, ML_HEADS, ML_HEAD_DIM)),
            z((DEPTH, b, ML_HEADS)),
            z((DEPTH, b, LRU_WIDTH)),
            z((DEPTH, b, CONV_W - 1, LRU_WIDTH)))


def trunk(x, c, states, P, start_pos):
    f32 = jnp.float32
    new = [[] for _ in states]
    cs = jax.nn.silu(c.astype(f32))
    for l in range(DEPTH):
        mod = jnp.matmul(cs, P['ada_w'][l].astype(f32)) + P['ada_b'][l].astype(f32)
        sh1, sc1, g1, sh2, sc2, g2 = (m[:, None, :] for m in jnp.split(mod, 6, axis=-1))
        hn = (rmsnorm(x, P['norm1_w'][l]) * (1.0 + sc1) + sh1).astype(x.dtype)
        mix, st_new = mixer(hn, l, P, tuple(s[l] for s in states), start_pos)
        x = (x.astype(f32) + g1 * mix.astype(f32)).astype(x.dtype)
        hn = (rmsnorm(x, P['norm2_w'][l]) * (1.0 + sc2) + sh2).astype(x.dtype)
        ff = jnp.matmul(jnp.square(jax.nn.relu(jnp.matmul(hn, P['mlp_up'][l]))), P['mlp_down'][l])
        x = (x.astype(f32) + g2 * ff.astype(f32)).astype(x.dtype)
        for lst, s in zip(new, st_new):
            lst.append(s)
    y = rmsnorm(x, P['final_norm_w']).astype(x.dtype)
    return y, tuple(jnp.stack(lst) for lst in new)


def setup_inputs(seed: int = 0) -> dict:
    key = jax.random.key(seed)
    ks = iter(jax.random.split(key, 48))
    f32 = jnp.float32

    def nrm(shape, scale):
        return scale * jax.random.normal(next(ks), shape, f32)

    def unif(shape, lo, hi):
        return jax.random.uniform(next(ks), shape, f32, lo, hi)

    dt0 = jnp.exp(unif((DEPTH, SSD_HEADS), math.log(1e-3), math.log(1e-1)))
    lam_a = unif((DEPTH, LRU_WIDTH), 0.9, 0.999)
    return {
        'x_prompt': nrm((BATCH, SEQ, D_MODEL), 1.0),
        'x_sample': nrm((DEC_BATCH, DEC_SEQ, D_MODEL), 1.0),
        'c_prompt': nrm((BATCH, D_MODEL), 1.0),
        'c_sample': nrm((DEC_BATCH, D_MODEL), 1.0),
        'state_ssm': nrm((DEPTH, DEC_BATCH, SSD_HEADS, SSD_HEAD_DIM, SSD_STATE), 0.1),
        'state_ssd_conv': nrm((DEPTH, DEC_BATCH, CONV_W - 1, SSD_CONV_DIM), 1.0),
        'state_mlstm_c': nrm((DEPTH, DEC_BATCH, ML_HEADS, ML_HEAD_DIM, ML_HEAD_DIM), 0.1),
        'state_mlstm_n': nrm((DEPTH, DEC_BATCH, ML_HEADS, ML_HEAD_DIM), 0.1),
        'state_mlstm_m': nrm((DEPTH, DEC_BATCH, ML_HEADS), 1.0),
        'state_lru_h': nrm((DEPTH, DEC_BATCH, LRU_WIDTH), 0.5),
        'state_lru_conv': nrm((DEPTH, DEC_BATCH, CONV_W - 1, LRU_WIDTH), 1.0),
        'ada_w': nrm((DEPTH, D_MODEL, 6 * D_MODEL), D_MODEL ** -0.5),
        'ada_b': nrm((DEPTH, 6 * D_MODEL), 0.01),
        'norm1_w': 1.0 + nrm((DEPTH, D_MODEL), 0.01),
        'norm2_w': 1.0 + nrm((DEPTH, D_MODEL), 0.01),
        'w_in': nrm((DEPTH, D_MODEL, IN_DIM), D_MODEL ** -0.5),
        'ssd_conv_w': nrm((DEPTH, CONV_W, SSD_CONV_DIM), CONV_W ** -0.5),
        'ssd_conv_b': nrm((DEPTH, SSD_CONV_DIM), 0.01),
        'ssd_dt_bias': dt0 + jnp.log(-jnp.expm1(-dt0)),
        'ssd_a_log': jnp.log(unif((DEPTH, SSD_HEADS), 1.0, 16.0)),
        'ssd_d': 1.0 + nrm((DEPTH, SSD_HEADS), 0.1),
        'ssd_norm_w': 1.0 + nrm((DEPTH, SSD_WIDTH), 0.01),
        'ml_i_bias': nrm((DEPTH, ML_HEADS), 0.1),
        'ml_f_bias': jnp.linspace(3.0, 6.0, ML_HEADS, dtype=f32)[None, :] + nrm((DEPTH, ML_HEADS), 0.1),
        'ml_norm_w': 1.0 + nrm((DEPTH, ML_WIDTH), 0.01),
        'lru_conv_w': nrm((DEPTH, CONV_W, LRU_WIDTH), CONV_W ** -0.5),
        'lru_conv_b': nrm((DEPTH, LRU_WIDTH), 0.01),
        'lru_wa': nrm((DEPTH, LRU_BLOCKS, LRU_BLOCK_DIM, LRU_BLOCK_DIM), LRU_BLOCK_DIM ** -0.5),
        'lru_ba': nrm((DEPTH, LRU_WIDTH), 0.01),
        'lru_wx': nrm((DEPTH, LRU_BLOCKS, LRU_BLOCK_DIM, LRU_BLOCK_DIM), LRU_BLOCK_DIM ** -0.5),
        'lru_bx': nrm((DEPTH, LRU_WIDTH), 0.01),
        'lru_lambda': jnp.log(lam_a) - jnp.log1p(-lam_a),
        'w_out': nrm((DEPTH, MIX_WIDTH, D_MODEL), MIX_WIDTH ** -0.5),
        'mlp_up': nrm((DEPTH, D_MODEL, D_FF), D_MODEL ** -0.5),
        'mlp_down': nrm((DEPTH, D_FF, D_MODEL), D_FF ** -0.5),
        'final_norm_w': 1.0 + nrm((D_MODEL,), 0.01),
    }


def reference(x_prompt, x_sample, c_prompt, c_sample,
              state_ssm, state_ssd_conv, state_mlstm_c, state_mlstm_n, state_mlstm_m,
              state_lru_h, state_lru_conv,
              ada_w, ada_b, norm1_w, norm2_w, w_in,
              ssd_conv_w, ssd_conv_b, ssd_dt_bias, ssd_a_log, ssd_d, ssd_norm_w,
              ml_i_bias, ml_f_bias, ml_norm_w,
              lru_conv_w, lru_conv_b, lru_wa, lru_ba, lru_wx, lru_bx, lru_lambda,
              w_out, mlp_up, mlp_down, final_norm_w):
    P = dict(ada_w=ada_w, ada_b=ada_b, norm1_w=norm1_w, norm2_w=norm2_w, w_in=w_in,
             ssd_conv_w=ssd_conv_w, ssd_conv_b=ssd_conv_b, ssd_dt_bias=ssd_dt_bias,
             ssd_a_log=ssd_a_log, ssd_d=ssd_d, ssd_norm_w=ssd_norm_w,
             ml_i_bias=ml_i_bias, ml_f_bias=ml_f_bias, ml_norm_w=ml_norm_w,
             lru_conv_w=lru_conv_w, lru_conv_b=lru_conv_b, lru_wa=lru_wa, lru_ba=lru_ba,
             lru_wx=lru_wx, lru_bx=lru_bx, lru_lambda=lru_lambda,
             w_out=w_out, mlp_up=mlp_up, mlp_down=mlp_down, final_norm_w=final_norm_w)
    y_prompt, (p_ssm, p_sconv, p_mc, p_mn, p_mm, p_lh, p_lconv) = trunk(
        x_prompt, c_prompt, zero_states(x_prompt.shape[0]), P, 0)
    y_sample, (s_ssm, s_sconv, s_mc, s_mn, s_mm, s_lh, s_lconv) = trunk(
        x_sample, c_sample,
        (state_ssm, state_ssd_conv, state_mlstm_c, state_mlstm_n, state_mlstm_m, state_lru_h, state_lru_conv),
        P, PAST_LEN)
    return (y_prompt, y_sample,
            p_ssm, p_sconv, p_mc, p_mn, p_mm, p_lh, p_lconv,
            s_ssm, s_sconv, s_mc, s_mn, s_mm, s_lh, s_lconv)
```

```cpp
#include <hip/hip_runtime.h>
#include <cstdio>
#include <cstdint>
namespace pg8 {
#define PG8_LAS __attribute__((address_space(3)))
typedef unsigned short bf16_t;
typedef short bf16x8 __attribute__((ext_vector_type(8)));
typedef float f32x4 __attribute__((ext_vector_type(4)));
typedef unsigned u32x4 __attribute__((ext_vector_type(4)));
constexpr int BM = 256, BK = 64, HALF = 128, HTB = HALF * BK * 2  , STAGE_BYTES = 8 * HTB, NXCD = 8, WGM = 8;

__host__ __device__ __forceinline__ int lds_byte(int r, int c) { const int st = (r >> 4) * 2 + (c >> 5), rr = r & 15, cc = c & 31, ob = rr * 64 + cc * 2; return st * 1024 + (ob ^ (((ob >> 9) & 1) << 5)); }
__host__ __device__ __forceinline__ void stage_rc(int b, int& R, int& C) { const int st = b / 1024, sb = b % 1024, swz = sb ^ (((sb >> 9) & 1) << 5); R = (st >> 1) * 16 + swz / 64; C = (st & 1) * 32 + (swz % 64) / 2; }
__host__ __device__ __forceinline__ int perm32(int rho) { const int n = rho >> 4, i = rho & 15; return 8 * (i >> 2) + 4 * n + (i & 3); }

struct Unit { int pm, pn; };
struct Gemm { const bf16_t* A; const bf16_t* Bt; int M, N, K; };

struct StaticOrder {
    int nM, nN, nwg, G, c;
    __host__ __device__ void init(int M, int N, int G_, int c_) { nM = M / BM; nN = N / BM; nwg = nM * nN; G = G_; c = c_; }
    __host__ __device__ bool next(int i, Unit& u) const {
        const long L = (long)i * G + c; if (L >= nwg) return false;
        int wgid = (int)L; { const int q = nwg / NXCD, r = nwg % NXCD, xcd = wgid % NXCD, off = wgid / NXCD; wgid = (xcd < r ? xcd * (q + 1) : r * (q + 1) + (xcd - r) * q) + off; }
        const int nig = WGM * nN, gid = wgid / nig, fm = gid * WGM, gsz = (nM - fm) < WGM ? (nM - fm) : WGM;
        u.pm = fm + ((wgid % nig) % gsz); u.pn = (wgid % nig) / gsz; return true;
    }
    __device__ __forceinline__ void a_ready(const Unit&) const {}
    __device__ __forceinline__ void done(const Unit&) const {}
};

__device__ __forceinline__ unsigned cvt_pk_bf16(float lo, float hi) { unsigned r; asm volatile("v_cvt_pk_bf16_f32 %0, %1, %2" : "=v"(r) : "v"(lo), "v"(hi)); return r; }

template <int ACT> struct EpiBf16 {
    static constexpr bool PERM = true, AFTER_DRAIN = false;
    bf16_t* O; int ldc;
    __device__ __forceinline__ void operator()(const f32x4 (&acc)[2][2][4][2], const Unit& u, int wr, int wc, int fr, int fq) const {
        const int row0 = u.pm * BM + wr * 64 + fr; const int col0 = u.pn * BM + wc * 32 + 8 * fq;
#pragma unroll
        for (int ai = 0; ai < 2; ++ai)
#pragma unroll
            for (int m = 0; m < 4; ++m) { bf16_t* rowp = O + (size_t)(row0 + ai * HALF + m * 16) * ldc + col0;
#pragma unroll
                for (int bj = 0; bj < 2; ++bj) { f32x4 v0 = acc[ai][bj][m][0], v1 = acc[ai][bj][m][1];
                    if (ACT == 1) {
#pragma unroll
                        for (int e = 0; e < 4; ++e) { const float a0 = fmaxf(v0[e], 0.f), a1 = fmaxf(v1[e], 0.f); v0[e] = a0 * a0; v1[e] = a1 * a1; } }
                    u32x4 w; w.x = cvt_pk_bf16(v0[0], v0[1]); w.y = cvt_pk_bf16(v0[2], v0[3]); w.z = cvt_pk_bf16(v1[0], v1[1]); w.w = cvt_pk_bf16(v1[2], v1[3]);
                    *(u32x4*)(rowp + bj * HALF) = w; } }
    }
};
struct EpiResid {
    static constexpr bool PERM = false, AFTER_DRAIN = false;
    const float* xp; const float* xs; float* out; const float* gate;
    __device__ __forceinline__ void operator()(const f32x4 (&acc)[2][2][4][2], const Unit& u, int wr, int wc, int fr, int fq) const {
        const int col0 = u.pn * BM + wc * 32 + 4 * fq;
#pragma unroll
        for (int ai = 0; ai < 2; ++ai)
#pragma unroll
            for (int m = 0; m < 4; ++m) { const int row = u.pm * BM + ai * HALF + wr * 64 + m * 16 + fr;
                const int mr = row < 16384 ? (row >> 11) : 8 + ((row - 16384) >> 3);
                const float* xin = row < 16384 ? xp + (size_t)row * 1024 : xs + (size_t)(row - 16384) * 1024;
                const float* gp = gate + (size_t)mr * 6144; float* op = out + (size_t)row * 1024;
#pragma unroll
                for (int bj = 0; bj < 2; ++bj)
#pragma unroll
                    for (int n = 0; n < 2; ++n) { const int c = col0 + bj * HALF + n * 16;
                        const f32x4 g = *(const f32x4*)(gp + c), x = *(const f32x4*)(xin + c); *(f32x4*)(op + c) = x + g * acc[ai][bj][m][n]; }
                if (m & 1) asm volatile("" ::: "memory"); }
    }
};
template <class Epi, class Sched, bool ALIGN_EPI = false, bool SP2 = false>
__device__ __forceinline__ void gemm_phase(PG8_LAS unsigned char* lds, const Gemm g, const Sched& S, const Epi& E) {
    int tid_ = threadIdx.x; asm volatile("" : "+v"(tid_));
    const int tid = tid_, wid = __builtin_amdgcn_readfirstlane(tid >> 6), lane = tid & 63, wr = wid >> 2, wc = wid & 3, fr = lane & 15, fq = lane >> 4;
    const int K = g.K, nt = K / BK;
    unsigned voffA[2], voffB[2];
#pragma unroll
    for (int i = 0; i < 2; ++i) { int R, C; stage_rc(tid * 16 + i * 8192, R, C); const int Rb = Epi::PERM ? ((R & ~31) + perm32(R & 31)) : R;
        voffA[i] = (unsigned)(R * K + C) * 2u; voffB[i] = (unsigned)(Rb * K + C) * 2u; }
    const size_t kstep = (size_t)(BK * 2);
    const size_t hstep = (size_t)HALF * K * 2;
    const size_t tstep = 2 * hstep;
    const unsigned ldsw = (unsigned)wid * 1024u;
    const int aoff = lds_byte(wr * 64 + fr, fq * 8), boff = lds_byte(wc * 32 + fr, fq * 8);
#define PG8_SA(b, h) (((b) * 2 + (h)) * HTB)
#define PG8_SB(b, h) ((4 + (b) * 2 + (h)) * HTB)
#define PG8_STAGE(bufoff, gbase, voff) do { _Pragma("unroll") for (int _i = 0; _i < 2; ++_i) \
        __builtin_amdgcn_global_load_lds((const unsigned*)((const char*)(gbase) + (voff)[_i]), (PG8_LAS unsigned*)(lds + (bufoff) + ldsw + _i * 8192), 16, 0, 0); } while (0)
#define PG8_LDA(dst, b, h) do { _Pragma("unroll") for (int m = 0; m < 4; ++m) _Pragma("unroll") for (int k = 0; k < 2; ++k) dst[m][k] = *(const PG8_LAS bf16x8*)(lds + PG8_SA(b, h) + aoff + m * 2048 + k * 1024); } while (0)
#define PG8_LDB(dst, b, h) do { _Pragma("unroll") for (int n = 0; n < 2; ++n) _Pragma("unroll") for (int k = 0; k < 2; ++k) dst[n][k] = *(const PG8_LAS bf16x8*)(lds + PG8_SB(b, h) + boff + n * 2048 + k * 1024); } while (0)
#define PG8_MMA(ai, bj, At, Bt) do { __builtin_amdgcn_s_setprio(1); _Pragma("unroll") for (int m = 0; m < 4; ++m) _Pragma("unroll") for (int n = 0; n < 2; ++n) _Pragma("unroll") for (int k = 0; k < 2; ++k) \
        acc[ai][bj][m][n] = __builtin_amdgcn_mfma_f32_16x16x32_bf16(Bt[n][k], At[m][k], acc[ai][bj][m][n], 0, 0, 0); __builtin_amdgcn_s_setprio(0); } while (0)
#define PG8_WAIT_V(n) asm volatile("s_waitcnt vmcnt(" #n ")" ::: "memory")
#define PG8_WAIT_L(n) asm volatile("s_waitcnt lgkmcnt(" #n ")" ::: "memory")
#define PG8_BAR __builtin_amdgcn_s_barrier()
#define PG8_SCHED __builtin_amdgcn_sched_barrier(0)
    Unit cur, nxt; int ui = 0;
    if (!S.next(0, cur)) return;
    f32x4 acc[2][2][4][2];
#pragma unroll
    for (int a = 0; a < 2; ++a)
#pragma unroll
        for (int b = 0; b < 2; ++b)
#pragma unroll
            for (int m = 0; m < 4; ++m)
#pragma unroll
                for (int n = 0; n < 2; ++n) acc[a][b][m][n] = (f32x4){0.f, 0.f, 0.f, 0.f};
    bf16x8 At[4][2], B0[2][2], B1[2][2];
    const char* cA = (const char*)g.A + (size_t)cur.pm * tstep; const char* cB = (const char*)g.Bt + (size_t)cur.pn * tstep;
    S.a_ready(cur);
    if constexpr (SP2) {
        PG8_STAGE(PG8_SB(0, 0), cB, voffB); PG8_STAGE(PG8_SB(0, 1), cB + hstep, voffB); PG8_STAGE(PG8_SA(0, 0), cA, voffA); PG8_STAGE(PG8_SA(0, 1), cA + hstep, voffA);
        if (wr == 1) PG8_BAR;
        PG8_WAIT_V(2); PG8_BAR;
        PG8_STAGE(PG8_SB(1, 0), cB + kstep, voffB); PG8_STAGE(PG8_SA(1, 0), cA + kstep, voffA); PG8_STAGE(PG8_SB(1, 1), cB + hstep + kstep, voffB);
        PG8_WAIT_V(6); PG8_BAR;
    } else {
        PG8_STAGE(PG8_SB(0, 0), cB, voffB); PG8_STAGE(PG8_SA(0, 0), cA, voffA); PG8_STAGE(PG8_SB(0, 1), cB + hstep, voffB); PG8_STAGE(PG8_SA(0, 1), cA + hstep, voffA);
        if (wr == 1) PG8_BAR;
        PG8_WAIT_V(4); PG8_BAR;
        PG8_STAGE(PG8_SB(1, 0), cB + kstep, voffB); PG8_STAGE(PG8_SA(1, 0), cA + kstep, voffA); PG8_STAGE(PG8_SB(1, 1), cB + hstep + kstep, voffB);
        PG8_WAIT_V(6); PG8_BAR;
    }
    for (;;) {
        const bool has_next = S.next(ui + 1, nxt);
        const char* nA = has_next ? (const char*)g.A + (size_t)nxt.pm * tstep : cA; const char* nB = has_next ? (const char*)g.Bt + (size_t)nxt.pn * tstep : cB;
        for (int t = 0; t < nt; t += 2) {
            const bool last = (t == nt - 2);
            const char* a1 = cA + (size_t)(t + 1) * kstep;
            const char* a2 = last ? nA : cA + (size_t)(t + 2) * kstep; const char* b2 = last ? nB : cB + (size_t)(t + 2) * kstep;
            const char* a3 = a2 + kstep; const char* b3 = b2 + kstep;
            if (last && has_next) S.a_ready(nxt);
            if constexpr (SP2) {
            PG8_LDB(B0, 0, 0); PG8_LDB(B1, 0, 1); PG8_SCHED; PG8_LDA(At, 0, 0); PG8_STAGE(PG8_SA(1, 1), a1 + hstep, voffA);
            PG8_WAIT_V(8); PG8_WAIT_L(0); PG8_BAR; PG8_MMA(0, 0, At, B0); PG8_MMA(0, 1, At, B1); PG8_BAR; PG8_SCHED;
            PG8_LDA(At, 0, 1); PG8_STAGE(PG8_SB(0, 0), b2, voffB); PG8_STAGE(PG8_SB(0, 1), b2 + hstep, voffB); PG8_STAGE(PG8_SA(0, 0), a2, voffA);
            PG8_WAIT_V(8); PG8_WAIT_L(0); PG8_BAR; PG8_MMA(1, 0, At, B0); PG8_MMA(1, 1, At, B1); PG8_BAR; PG8_SCHED;
            PG8_LDB(B0, 1, 0); PG8_LDB(B1, 1, 1); PG8_SCHED; PG8_LDA(At, 1, 0); PG8_STAGE(PG8_SA(0, 1), a2 + hstep, voffA);
            PG8_WAIT_V(8); PG8_WAIT_L(0); PG8_BAR; PG8_MMA(0, 0, At, B0); PG8_MMA(0, 1, At, B1); PG8_BAR; PG8_SCHED;
            PG8_LDA(At, 1, 1); PG8_STAGE(PG8_SB(1, 0), b3, voffB); PG8_STAGE(PG8_SB(1, 1), b3 + hstep, voffB); PG8_STAGE(PG8_SA(1, 0), a3, voffA);
            PG8_WAIT_V(8); PG8_WAIT_L(0); PG8_BAR; PG8_MMA(1, 0, At, B0); PG8_MMA(1, 1, At, B1); PG8_BAR; PG8_SCHED;
            } else {
            PG8_LDB(B0, 0, 0); PG8_SCHED; PG8_LDA(At, 0, 0); PG8_STAGE(PG8_SA(1, 1), a1 + hstep, voffA);
            PG8_WAIT_L(8); PG8_BAR; PG8_WAIT_L(0); PG8_MMA(0, 0, At, B0); PG8_BAR; PG8_SCHED;
            PG8_LDB(B1, 0, 1); PG8_STAGE(PG8_SB(0, 0), b2, voffB);
            PG8_BAR; PG8_WAIT_L(0); PG8_MMA(0, 1, At, B1); PG8_BAR;
            PG8_LDA(At, 0, 1); PG8_STAGE(PG8_SA(0, 0), a2, voffA);
            PG8_BAR; PG8_WAIT_L(0); PG8_MMA(1, 0, At, B0); PG8_BAR; PG8_SCHED;
            PG8_STAGE(PG8_SB(0, 1), b2 + hstep, voffB);
            PG8_WAIT_V(6); PG8_BAR; PG8_MMA(1, 1, At, B1); PG8_BAR;
            PG8_LDB(B0, 1, 0); PG8_SCHED; PG8_LDA(At, 1, 0); PG8_STAGE(PG8_SA(0, 1), a2 + hstep, voffA);
            PG8_WAIT_L(8); PG8_BAR; PG8_WAIT_L(0); PG8_MMA(0, 0, At, B0); PG8_BAR; PG8_SCHED;
            PG8_LDB(B1, 1, 1); PG8_STAGE(PG8_SB(1, 0), b3, voffB);
            PG8_BAR; PG8_WAIT_L(0); PG8_MMA(0, 1, At, B1); PG8_BAR;
            PG8_LDA(At, 1, 1); PG8_STAGE(PG8_SA(1, 0), a3, voffA);
            PG8_BAR; PG8_WAIT_L(0); PG8_MMA(1, 0, At, B0); PG8_BAR; PG8_SCHED;
            PG8_STAGE(PG8_SB(1, 1), b3 + hstep, voffB);
            PG8_WAIT_V(6); PG8_BAR; PG8_MMA(1, 1, At, B1); PG8_BAR;
            }
        }
        if constexpr (ALIGN_EPI) { if (wr == 0) PG8_BAR; }
        if constexpr (!Epi::AFTER_DRAIN) { E(acc, cur, wr, wc, fr, fq); S.done(cur); }
        if (!has_next) break;
#pragma unroll
        for (int a = 0; a < 2; ++a)
#pragma unroll
            for (int b = 0; b < 2; ++b)
#pragma unroll
                for (int m = 0; m < 4; ++m)
#pragma unroll
                    for (int n = 0; n < 2; ++n) acc[a][b][m][n] = (f32x4){0.f, 0.f, 0.f, 0.f};
        cur = nxt; cA = nA; cB = nB; ++ui;
        if constexpr (ALIGN_EPI) { if (wr == 1) PG8_BAR; }
    }
    PG8_WAIT_V(0);
    if constexpr (!ALIGN_EPI) { if (wr == 0) PG8_BAR; }
    PG8_BAR;
    if constexpr (Epi::AFTER_DRAIN) { E.fused(acc, cur, wr, wc, fr, fq, lds, wid, lane); S.done(cur); }
#undef PG8_SA
#undef PG8_SB
#undef PG8_STAGE
#undef PG8_LDA
#undef PG8_LDB
#undef PG8_MMA
#undef PG8_WAIT_V
#undef PG8_WAIT_L
#undef PG8_BAR
#undef PG8_SCHED
}
}

#ifndef MK_ONE
#define MK_ONE 0
#endif
constexpr int DM = 1024, NB_P = 8, SEQ_P = 2048, NB_S = 128, SEQ_S = 8, DEPTH = 2;
constexpr int MP = NB_P * SEQ_P, MS = NB_S * SEQ_S, MT = MP + MS;
constexpr int IN_DIM = 5656, NU = 5632, NG = 24, DFF = 4096, MIXW = 2048, CONVD = 1536, LRUW = 512;
constexpr int MODLD = 6144, MODROWS = 160;
constexpr float EPS = 1e-6f;
constexpr int UC_Z = 0, UC_XBC = 1024, UC_Q = 2560, UC_K = 3072, UC_V = 3584, UC_O = 4096, UC_XR = 4608, UC_GR = 5120;
constexpr size_t O_YP = 0, O_YS = O_YP + (size_t)MP * DM;
constexpr size_t O_P_SSM = O_YS + (size_t)MS * DM, O_P_SCONV = O_P_SSM + (size_t)DEPTH * NB_P * 16 * 64 * 128, O_P_MC = O_P_SCONV + (size_t)DEPTH * NB_P * 3 * CONVD,
                 O_P_MN = O_P_MC + (size_t)DEPTH * NB_P * 4 * 128 * 128, O_P_MM = O_P_MN + (size_t)DEPTH * NB_P * 4 * 128, O_P_LH = O_P_MM + (size_t)DEPTH * NB_P * 4,
                 O_P_LCONV = O_P_LH + (size_t)DEPTH * NB_P * LRUW;
constexpr size_t O_S_SSM = O_P_LCONV + (size_t)DEPTH * NB_P * 3 * LRUW, O_S_SCONV = O_S_SSM + (size_t)DEPTH * NB_S * 16 * 64 * 128, O_S_MC = O_S_SCONV + (size_t)DEPTH * NB_S * 3 * CONVD,
                 O_S_MN = O_S_MC + (size_t)DEPTH * NB_S * 4 * 128 * 128, O_S_MM = O_S_MN + (size_t)DEPTH * NB_S * 4 * 128, O_S_LH = O_S_MM + (size_t)DEPTH * NB_S * 4,
                 O_S_LCONV = O_S_LH + (size_t)DEPTH * NB_S * LRUW, O_END = O_S_LCONV + (size_t)DEPTH * NB_S * 3 * LRUW;
static_assert(O_END == 73253952, "output size");
constexpr size_t MiB = 1u << 20;
constexpr size_t WS_CTL = 0, CTL_ZERO_BYTES = 1 * MiB;
constexpr size_t WS_WG = 1 * MiB, WS_MOD = 2 * MiB, WS_WIN = 10 * MiB, WS_WOUT = 32 * MiB, WS_WUP = 40 * MiB, WS_WDN = 56 * MiB;
constexpr size_t WS_GATES = 72 * MiB, WS_SSQ = 74 * MiB, WS_HN = 76 * MiB, WS_XW = 110 * MiB, WS_YCAT = 178 * MiB, WS_YZ = 246 * MiB, WS_U = 314 * MiB, WS_END = 502 * MiB;
constexpr size_t WS_HID = WS_U;
static_assert(WS_U + (size_t)MT * NU * 2 <= WS_END && (size_t)MT * DFF * 2 <= (size_t)MT * NU * 2 && WS_MOD + (size_t)DEPTH * MODROWS * MODLD * 4 <= WS_WIN, "ws map");
static_assert((size_t)DEPTH * NU * DM * 2 == WS_WOUT - WS_WIN && (size_t)MT * DM * 2 == WS_XW - WS_HN && (size_t)MT * DM * 4 == WS_YCAT - WS_XW && (size_t)MT * MIXW * 2 == WS_YZ - WS_YCAT, "ws map 2");
constexpr int CW_Q = 64;
constexpr int CW_BAR = 4096;
constexpr int RING_BYTES = 131072, LDSCTL_OFF = RING_BYTES, MISC_OFF = LDSCTL_OFF + 320, LDS_BYTES = 147456;
constexpr int NWAVES = 8, NTHR = 512;

#define GAS __attribute__((address_space(1)))
#define LAS __attribute__((address_space(3)))
typedef unsigned short bf16;
typedef unsigned v4u __attribute__((ext_vector_type(4)));
typedef unsigned v2u __attribute__((ext_vector_type(2)));
typedef float f32x4 __attribute__((ext_vector_type(4)));
typedef float f32x16 __attribute__((ext_vector_type(16)));
#define LDS_WAIT() asm volatile("s_waitcnt lgkmcnt(0)" ::: "memory")
__device__ __forceinline__ unsigned f2bf(float f) { unsigned u = __builtin_bit_cast(unsigned, f); return (u + 0x7fffu + ((u >> 16) & 1u)) >> 16; }
__device__ __forceinline__ unsigned pk2(float lo, float hi) { return f2bf(lo) | (f2bf(hi) << 16); }
__device__ __forceinline__ float bf2f(bf16 h) { return __uint_as_float((unsigned)h << 16); }
__device__ __forceinline__ float wave_sum(float v) {
#pragma unroll
    for (int o = 1; o < 64; o <<= 1) v += __shfl_xor(v, o);
    return v;
}
__device__ __forceinline__ float sigmoidf_(float x) { return 1.f / (1.f + expf(-x)); }
__device__ __forceinline__ float siluf_(float x) { return x / (1.f + expf(-x)); }
__device__ __forceinline__ float softplusf_(float x) { return fmaxf(x, 0.f) + log1pf(expf(-fabsf(x))); }
__device__ __forceinline__ float gelu_tanhf_(float x) { return 0.5f * x * (1.f + tanhf(0.7978845608028654f * (x + 0.044715f * x * x * x))); }
__device__ __forceinline__ int modrow(int row) { return row < MP ? (row >> 11) : NB_P + ((row - MP) >> 3); }

#define XB_TMO      128
#define XB_XCNT(j)  (256  + 64 * (j))
#define XB_XSUB(j)  (1280 + 64 * (j))
#define XB_XGEN(j)  (2304 + 64 * (j))
#define XB_TOP      3328
#define XB_TOPGEN   3392
#define XCD_BAR_WORDS 3456
#define XB_SPIN_CAP (1u << 18)
__device__ __forceinline__ unsigned xb_ld(unsigned* p)              { return __hip_atomic_load(p, __ATOMIC_RELAXED, __HIP_MEMORY_SCOPE_AGENT); }
__device__ __forceinline__ unsigned xb_add(unsigned* p, unsigned v) { return __hip_atomic_fetch_add(p, v, __ATOMIC_RELAXED, __HIP_MEMORY_SCOPE_AGENT); }
__device__ __forceinline__ unsigned xb_xcc_id() { return (unsigned)__builtin_amdgcn_s_getreg((3 << 11) | 20) & 0xFu; }
#define XB_SPIN(cond, bar) do { unsigned _sp = 0; while (cond) { __builtin_amdgcn_s_sleep(1); \
    if ((++_sp & 255u) == 0u) { if (xb_ld(&(bar)[XB_TMO])) break; if (_sp > XB_SPIN_CAP) { atomicAdd(&(bar)[XB_TMO], 1u); break; } } } } while (0)
struct XcdBarrier { unsigned* bar; unsigned x; volatile LAS unsigned* st; };
__device__ __forceinline__ XcdBarrier xcd_barrier_post(unsigned* bar, volatile LAS unsigned* st) {
    XcdBarrier b; b.bar = bar; b.x = xb_xcc_id(); b.st = st;
    if (threadIdx.x == 0) (void)xb_add(&bar[XB_XCNT(b.x)], 1u);
    return b;
}
__device__ __forceinline__ void xcd_barrier_complete(unsigned* bar, unsigned x, unsigned& nloc, unsigned& nx) {
    const unsigned G = gridDim.x * gridDim.y * gridDim.z;
    unsigned sum, cnt, mine, sp = 0u;
    for (;;) {
        sum = 0u; cnt = 0u; mine = 0u;
#pragma unroll
        for (unsigned j = 0; j < 16; ++j) { const unsigned c = xb_ld(&bar[XB_XCNT(j)]); sum += c; cnt += (c > 0u) ? 1u : 0u; mine = (j == x) ? c : mine; }
        if (sum == G) break;
        __builtin_amdgcn_s_sleep(1);
        if ((++sp & 255u) == 0u) { if (xb_ld(&bar[XB_TMO])) break; if (sp > XB_SPIN_CAP) { atomicAdd(&bar[XB_TMO], 1u); break; } }
    }
    nloc = mine > 0u ? mine : 1u; nx = cnt > 0u ? cnt : 1u;
}
__device__ __forceinline__ void xcd_barrier(const XcdBarrier& b) {
    asm volatile("s_waitcnt vmcnt(0)" ::: "memory");
    __syncthreads();
    if (threadIdx.x == 0) {
        unsigned* bar = b.bar;
        __builtin_amdgcn_s_waitcnt(0);
        unsigned nloc = b.st[0], nx = b.st[1];
        if (nloc == 0u) { xcd_barrier_complete(bar, b.x, nloc, nx); b.st[0] = nloc; b.st[1] = nx; }
        const unsigned old = xb_add(&bar[XB_XSUB(b.x)], 1u);
        const unsigned gen = old / nloc;
        if (old + 1u == (gen + 1u) * nloc) {
            __builtin_amdgcn_fence(__ATOMIC_RELEASE, "agent");
            asm volatile("s_waitcnt vmcnt(0)" ::: "memory");
            const unsigned og = xb_add(&bar[XB_TOP], 1u);
            const unsigned tg = og / nx;
            if (og + 1u == (tg + 1u) * nx) xb_add(&bar[XB_TOPGEN], 1u);
            else XB_SPIN(xb_ld(&bar[XB_TOPGEN]) == tg, bar);
            __builtin_amdgcn_fence(__ATOMIC_ACQUIRE, "agent");
            xb_add(&bar[XB_XGEN(b.x)], 1u);
            asm volatile("s_waitcnt vmcnt(0)" ::: "memory");
        } else {
            XB_SPIN(xb_ld(&bar[XB_XGEN(b.x)]) == gen, bar);
            __builtin_amdgcn_fence(__ATOMIC_ACQUIRE, "agent");
            asm volatile("s_waitcnt vmcnt(0)" ::: "memory");
        }
    }
    __syncthreads();
}

struct Args { const float* in[36]; float* out; unsigned char* ws; int ph_lo, ph_hi; };
enum { I_XP = 0, I_XS, I_CP, I_CS, I_SSM, I_SCONV, I_MC, I_MN, I_MM, I_LH, I_LCONV, I_ADAW, I_ADAB, I_N1W, I_N2W, I_WIN, I_SCW, I_SCB, I_DTB, I_ALOG, I_SSD_D, I_SNW,
       I_MIB, I_MFB, I_MNW, I_LCW, I_LCB, I_LWA, I_LBA, I_LWX, I_LBX, I_LLAM, I_WOUT, I_WUP, I_WDN, I_FNW };
struct Frame { LAS unsigned char* lds; int tid, lane, wave, G; };
typedef const __attribute__((address_space(4))) unsigned char* kargp_t;
__device__ __forceinline__ const float* INP(int i) { asm volatile("" : "+s"(i)); return *(const float* const __attribute__((address_space(4)))*)((kargp_t)__builtin_amdgcn_kernarg_segment_ptr() + 8 * i); }
__device__ __forceinline__ float* OUTP() { int o = 288; asm volatile("" : "+s"(o)); return *(float* const __attribute__((address_space(4)))*)((kargp_t)__builtin_amdgcn_kernarg_segment_ptr() + o); }
__device__ __forceinline__ unsigned char* WSP(size_t off) { int o = 296; asm volatile("" : "+s"(o)); unsigned char* w = *(unsigned char* const __attribute__((address_space(4)))*)((kargp_t)__builtin_amdgcn_kernarg_segment_ptr() + o); return w + off; }
static_assert(offsetof(Args, out) == 288 && offsetof(Args, ws) == 296, "kernarg layout");
#define P_CTL   ((unsigned*)WSP(WS_CTL))
#define P_WG    ((float*)WSP(WS_WG))
#define P_MOD   ((float*)WSP(WS_MOD))
#define P_WINT  ((bf16*)WSP(WS_WIN))
#define P_WOUTT ((bf16*)WSP(WS_WOUT))
#define P_WUPT  ((bf16*)WSP(WS_WUP))
#define P_WDNT  ((bf16*)WSP(WS_WDN))
#define P_GATES ((float*)WSP(WS_GATES))
#define P_SSQ   ((float*)WSP(WS_SSQ))
#define P_HN    ((bf16*)WSP(WS_HN))
#define P_XW    ((float*)WSP(WS_XW))
#define P_YCAT  ((bf16*)WSP(WS_YCAT))
#define P_YZ    ((float*)WSP(WS_YZ))
#define P_U     ((bf16*)WSP(WS_U))
#define P_HID   ((bf16*)WSP(WS_HID))

__device__ __forceinline__ void transpose_item(const float* W, int ldw, int ncs, bf16* WT, int K, int n0, int k0, LAS float* scr, int lane) {
#pragma unroll 8
    for (int i = 0; i < 32; ++i) { const int kk = 2 * i + (lane >> 5); scr[kk * 33 + (lane & 31)] = W[(size_t)(k0 + kk) * ldw + ncs + (lane & 31)]; }
    LDS_WAIT(); asm volatile("" ::: "memory");
    const int c = lane & 7;
#pragma unroll
    for (int j = 0; j < 4; ++j) { const int n = (lane >> 3) + 8 * j; const LAS float* s = scr + (8 * c) * 33 + n;
        v4u o; o.x = pk2(s[0 * 33], s[1 * 33]); o.y = pk2(s[2 * 33], s[3 * 33]); o.z = pk2(s[4 * 33], s[5 * 33]); o.w = pk2(s[6 * 33], s[7 * 33]);
        *(GAS v4u*)(WT + (size_t)(n0 + n) * K + k0 + 8 * c) = o; }
    LDS_WAIT(); asm volatile("" ::: "memory");
}
__device__ __forceinline__ void p0_prologue(Frame& F) {
    const float* c_p = INP(I_CP); const float* c_s = INP(I_CS); const float* ada_w = INP(I_ADAW); const float* ada_b = INP(I_ADAB);
    static_assert(32 * 1025 * 4 <= MISC_OFF, "mod tile fits below MISC");
    LAS float* sc = (LAS float*)F.lds;
    for (int it = blockIdx.x; it < DEPTH * 5 * 24; it += F.G) {
        const int rb = it % 5, cg = (it / 5) % 24, l = it / 120;
        for (int idx = F.tid; idx < 32 * 1024; idx += NTHR) { const int rr = idx >> 10, k = idx & 1023, r = rb * 32 + rr;
            const float v = r < NB_P ? c_p[r * 1024 + k] : (r < NB_P + NB_S ? c_s[(r - NB_P) * 1024 + k] : 0.f);
            sc[rr * 1025 + k] = siluf_(v); }
        __syncthreads();
        const int j0 = cg * 256 + F.wave * 32; const float* wl = ada_w + (size_t)l * 1024 * MODLD + j0 + (F.lane & 31);
        f32x16 acc; for (int r = 0; r < 16; ++r) acc[r] = 0.f;
        const LAS float* ap = sc + (F.lane & 31) * 1025 + (F.lane >> 5);
#pragma unroll 8
        for (int k0 = 0; k0 < 1024; k0 += 2) { const float a = ap[k0]; const float b = wl[(size_t)(k0 + (F.lane >> 5)) * MODLD]; acc = __builtin_amdgcn_mfma_f32_32x32x2f32(a, b, acc, 0, 0, 0); }
        const int col = j0 + (F.lane & 31); const float bb = ada_b[l * MODLD + col];
#pragma unroll
        for (int r = 0; r < 16; ++r) { const int row = rb * 32 + (r & 3) + 8 * (r >> 2) + 4 * (F.lane >> 5); P_MOD[((size_t)l * MODROWS + row) * MODLD + col] = acc[r] + bb; }
        __syncthreads();
    }
    { const float* w_in = INP(I_WIN);
      for (int idx = blockIdx.x * NTHR + F.tid; idx < DEPTH * NG * 1024; idx += F.G * NTHR) { const int k = idx & 1023, j = (idx >> 10) % NG, l = idx / (NG * 1024);
          const int col = j < 16 ? 2560 + j : 4624 + (j - 16); P_WG[idx] = w_in[((size_t)l * 1024 + k) * IN_DIM + col]; } }
    LAS float* scr = (LAS float*)(F.lds + F.wave * 16384);
    const int gw = blockIdx.x * NWAVES + F.wave, NGW = F.G * NWAVES;
    constexpr int I_IN = 16 * 176, I_OUT = 32 * 32, I_UP = 16 * 128, I_DN = 64 * 32, I_L = I_IN + I_OUT + I_UP + I_DN;
    for (int it = gw; it < DEPTH * I_L; it += NGW) {
        const int l = it / I_L; int r = it % I_L;
        if (r < I_IN) { const int kb = r / 176, nb = r % 176, n0 = nb * 32, ncs = n0 + (n0 >= 2560 ? 16 : 0) + (n0 >= 4608 ? 8 : 0);
            transpose_item(INP(I_WIN) + (size_t)l * 1024 * IN_DIM, IN_DIM, ncs, P_WINT + (size_t)l * NU * 1024, 1024, n0, kb * 64, scr, F.lane); continue; } r -= I_IN;
        if (r < I_OUT) { const int kb = r / 32, nb = r % 32; transpose_item(INP(I_WOUT) + (size_t)l * MIXW * DM, DM, nb * 32, P_WOUTT + (size_t)l * DM * MIXW, MIXW, nb * 32, kb * 64, scr, F.lane); continue; } r -= I_OUT;
        if (r < I_UP) { const int kb = r / 128, nb = r % 128; transpose_item(INP(I_WUP) + (size_t)l * DM * DFF, DFF, nb * 32, P_WUPT + (size_t)l * DFF * DM, DM, nb * 32, kb * 64, scr, F.lane); continue; } r -= I_UP;
        { const int kb = r / 32, nb = r % 32; transpose_item(INP(I_WDN) + (size_t)l * DFF * DM, DM, nb * 32, P_WDNT + (size_t)l * DM * DFF, DFF, nb * 32, kb * 64, scr, F.lane); }
    }
}

template <bool GATESP>
__device__ __forceinline__ void norm_phase(Frame& F, int l, int which) {
    LAS float* wg = (LAS float*)F.lds;
    if (GATESP) { for (int i = F.tid; i < NG * 1024 / 4; i += NTHR) ((LAS f32x4*)wg)[i] = ((const f32x4*)(P_WG + (size_t)l * NG * 1024))[i]; __syncthreads(); }
    const int gw = blockIdx.x * NWAVES + F.wave, NGW = F.G * NWAVES;
    const float* nw = (which == 1 ? INP(I_N1W) : INP(I_N2W)) + l * DM;
    for (int row = gw; row < MT; row += NGW) {
        const float* xrow = (which == 1 && l == 0) ? (row < MP ? INP(I_XP) + (size_t)row * DM : INP(I_XS) + (size_t)(row - MP) * DM) : P_XW + (size_t)row * DM;
        const f32x4* xr = (const f32x4*)xrow + F.lane;
        f32x4 v[4]; float s = 0.f;
#pragma unroll
        for (int j = 0; j < 4; ++j) { v[j] = xr[64 * j]; s += (v[j].x * v[j].x + v[j].y * v[j].y) + (v[j].z * v[j].z + v[j].w * v[j].w); }
        const float rstd = rsqrtf(wave_sum(s) * (1.f / DM) + EPS);
        const float* mrow = P_MOD + ((size_t)l * MODROWS + modrow(row)) * MODLD + (which == 1 ? 0 : 3072);
        unsigned long long* o8 = (unsigned long long*)(P_HN + (size_t)row * DM) + F.lane;
#pragma unroll
        for (int j = 0; j < 4; ++j) { const int c = 4 * F.lane + 256 * j; const f32x4 w4 = *(const f32x4*)(nw + c), sh4 = *(const f32x4*)(mrow + c), sc4 = *(const f32x4*)(mrow + 1024 + c);
            v[j] = v[j] * rstd * w4 * (sc4 + 1.f) + sh4;
            o8[64 * j] = (unsigned long long)pk2(v[j].x, v[j].y) | ((unsigned long long)pk2(v[j].z, v[j].w) << 32); }
        if (GATESP) {
            float gv = 0.f;
#pragma unroll 4
            for (int g = 0; g < NG; ++g) { float p = 0.f;
#pragma unroll
                for (int j = 0; j < 4; ++j) { const f32x4 w4 = *(const LAS f32x4*)(wg + g * 1024 + 4 * F.lane + 256 * j); p += (v[j].x * w4.x + v[j].y * w4.y) + (v[j].z * w4.z + v[j].w * w4.w); }
                p = wave_sum(p); gv = (F.lane == g) ? p : gv; }
            if (F.lane < NG) P_GATES[(size_t)row * NG + F.lane] = gv;
        }
    }
}
__device__ __forceinline__ void final_norm_phase(Frame& F) {
    const int gw = blockIdx.x * NWAVES + F.wave, NGW = F.G * NWAVES; const float* nw = INP(I_FNW);
    for (int row = gw; row < MT; row += NGW) {
        const f32x4* xr = (const f32x4*)(P_XW + (size_t)row * DM) + F.lane; f32x4* o = (f32x4*)(OUTP() + (size_t)row * DM) + F.lane;
        f32x4 v[4]; float s = 0.f;
#pragma unroll
        for (int j = 0; j < 4; ++j) { v[j] = xr[64 * j]; s += (v[j].x * v[j].x + v[j].y * v[j].y) + (v[j].z * v[j].z + v[j].w * v[j].w); }
        const float rstd = rsqrtf(wave_sum(s) * (1.f / DM) + EPS);
#pragma unroll
        for (int j = 0; j < 4; ++j) { const f32x4 w4 = *(const f32x4*)(nw + 4 * F.lane + 256 * j); o[64 * j] = v[j] * rstd * w4; }
    }
}
__device__ __forceinline__ void yscale_phase(Frame& F, int l) {
    const int gw = blockIdx.x * NWAVES + F.wave, NGW = F.G * NWAVES; const float* nw = INP(I_SNW) + l * 1024;
    for (int row = gw; row < MT; row += NGW) {
        float s = P_SSQ[(size_t)row * 16 + (F.lane & 15)];
        s += __shfl_xor(s, 1); s += __shfl_xor(s, 2); s += __shfl_xor(s, 4); s += __shfl_xor(s, 8);
        const float rs = rsqrtf(s * (1.f / 1024.f) + EPS);
        const f32x4* yr = (const f32x4*)(P_YZ + (size_t)row * 1024) + F.lane; unsigned long long* o8 = (unsigned long long*)(P_YCAT + (size_t)row * MIXW) + F.lane;
#pragma unroll
        for (int j = 0; j < 4; ++j) { const f32x4 w4 = *(const f32x4*)(nw + 4 * F.lane + 256 * j); const f32x4 y = yr[64 * j] * rs * w4;
            o8[64 * j] = (unsigned long long)pk2(y.x, y.y) | ((unsigned long long)pk2(y.z, y.w) << 32); }
    }
}

__device__ __forceinline__ void ssd_item(Frame& F, int l, int grp, int b, int h) {
    const int T = grp ? SEQ_S : SEQ_P, rowbase = grp ? MP + b * SEQ_S : b * SEQ_P, Bn = grp ? NB_S : NB_P, g = h >> 3;
    const int tid = F.tid, p = tid >> 3, nq = tid & 7, n0 = nq * 16;
    LAS float* xs = (LAS float*)F.lds; LAS float* Bm = xs + 512; LAS float* Cm = Bm + 1024; LAS float* dts = Cm + 1024; LAS float* dAs = dts + 8; LAS float* ybuf = dAs + 8;
    float S[16];
    if (grp) { const float* sp = INP(I_SSM) + ((((size_t)l * NB_S + b) * 16 + h) * 64 + p) * 128 + n0;
#pragma unroll
        for (int j = 0; j < 16; ++j) S[j] = sp[j]; }
    else {
#pragma unroll
        for (int j = 0; j < 16; ++j) S[j] = 0.f; }
    const float a = -expf(INP(I_ALOG)[l * 16 + h]), dtb = INP(I_DTB)[l * 16 + h], Dh = INP(I_SSD_D)[l * 16 + h];
    const float* cw = INP(I_SCW) + (size_t)l * 4 * CONVD; const float* cb = INP(I_SCB) + (size_t)l * CONVD;
    const float* hist = INP(I_SCONV) + ((size_t)l * NB_S + b) * 3 * CONVD;
    for (int t0 = 0; t0 < T; t0 += 8) {
#pragma unroll
        for (int j5 = 0; j5 < 5; ++j5) { const int idx = tid + NTHR * j5, ci = idx % 320, tt = idx / 320, t = t0 + tt;
            const int c = ci < 64 ? h * 64 + ci : (ci < 192 ? 1024 + g * 128 + (ci - 64) : 1280 + g * 128 + (ci - 192));
            float acc = cb[c];
#pragma unroll
            for (int j = 0; j < 4; ++j) { const int tp = t - 3 + j; float val;
                if (tp >= 0) val = bf2f(P_U[(size_t)(rowbase + tp) * NU + UC_XBC + c]); else val = grp ? hist[(tp + 3) * CONVD + c] : 0.f;
                acc += cw[j * CONVD + c] * val; }
            const float act = siluf_(acc);
            if (ci < 64) xs[tt * 64 + ci] = act; else if (ci < 192) Bm[tt * 128 + ci - 64] = act; else Cm[tt * 128 + ci - 192] = act; }
        if (tid < 8) { const float dt = softplusf_(P_GATES[(size_t)(rowbase + t0 + tid) * NG + h] + dtb); dts[tid] = dt; dAs[tid] = expf(dt * a); }
        __syncthreads();
        for (int tt = 0; tt < 8; ++tt) {
            const float dt = dts[tt], dA = dAs[tt], xv = xs[tt * 64 + p], dx = dt * xv; float part = 0.f;
#pragma unroll
            for (int j = 0; j < 16; ++j) { S[j] = dA * S[j] + dx * Bm[tt * 128 + n0 + j]; part += Cm[tt * 128 + n0 + j] * S[j]; }
            part += __shfl_xor(part, 1); part += __shfl_xor(part, 2); part += __shfl_xor(part, 4);
            if (nq == 0) { const size_t row = (size_t)(rowbase + t0 + tt); const float y = part + Dh * xv, z = bf2f(P_U[row * NU + UC_Z + h * 64 + p]), yz = y * siluf_(z);
                P_YZ[row * 1024 + h * 64 + p] = yz; ybuf[tt * 64 + p] = yz; }
        }
        __syncthreads();
        if (tid < 8) { float s = 0.f; for (int q = 0; q < 64; ++q) { const float y = ybuf[tid * 64 + q]; s += y * y; } P_SSQ[(size_t)(rowbase + t0 + tid) * 16 + h] = s; }
    }
    { float* so = OUTP() + (grp ? O_S_SSM : O_P_SSM) + ((((size_t)l * Bn + b) * 16 + h) * 64 + p) * 128 + n0;
#pragma unroll
      for (int j = 0; j < 16; ++j) so[j] = S[j]; }
    if (h == 0) { float* co = OUTP() + (grp ? O_S_SCONV : O_P_SCONV) + ((size_t)l * Bn + b) * 3 * CONVD;
        for (int idx = tid; idx < 3 * CONVD; idx += NTHR) { const int j = idx / CONVD, c = idx % CONVD; co[idx] = bf2f(P_U[(size_t)(rowbase + T - 3 + j) * NU + UC_XBC + c]); } }
    __syncthreads();
}
__device__ __forceinline__ void mlstm_item(Frame& F, int l, int grp, int b, int h) {
    const int T = grp ? SEQ_S : SEQ_P, rowbase = grp ? MP + b * SEQ_S : b * SEQ_P, Bn = grp ? NB_S : NB_P;
    const int tid = F.tid, v = tid >> 2, dq = tid & 3, d0 = dq * 32;
    LAS float* q = (LAS float*)F.lds; LAS float* k = q + 1024; LAS float* vv = k + 1024; LAS float* oo = vv + 1024; LAS float* igs = oo + 1024; LAS float* lfs = igs + 8; LAS float* hbuf = lfs + 8;
    float c[32], nn[32], m;
    if (grp) { const float* cp = INP(I_MC) + ((((size_t)l * NB_S + b) * 4 + h) * 128 + v) * 128 + d0; const float* np = INP(I_MN) + (((size_t)l * NB_S + b) * 4 + h) * 128 + d0;
#pragma unroll
        for (int j = 0; j < 32; ++j) { c[j] = cp[j]; nn[j] = np[j]; }
        m = INP(I_MM)[((size_t)l * NB_S + b) * 4 + h]; }
    else {
#pragma unroll
        for (int j = 0; j < 32; ++j) { c[j] = 0.f; nn[j] = 0.f; }
        m = 0.f; }
    const float ib = INP(I_MIB)[l * 4 + h], fb = INP(I_MFB)[l * 4 + h];
    const float* nw = INP(I_MNW) + l * 512 + h * 128;
    for (int t0 = 0; t0 < T; t0 += 8) {
#pragma unroll
        for (int j8 = 0; j8 < 8; ++j8) { const int idx = tid + NTHR * j8, arr = idx >> 10, tt = (idx >> 7) & 7, d = idx & 127;
            float val = bf2f(P_U[(size_t)(rowbase + t0 + tt) * NU + UC_Q + arr * 512 + h * 128 + d]); if (arr == 1) val *= 0.08838834764831845f;
            q[idx] = val; }
        if (tid < 8) { const size_t row = (size_t)(rowbase + t0 + tid); igs[tid] = P_GATES[row * NG + 16 + h] + ib; lfs[tid] = -softplusf_(-(P_GATES[row * NG + 20 + h] + fb)); }
        __syncthreads();
        for (int tt = 0; tt < 8; ++tt) {
            const float igv = igs[tt], lfv = lfs[tt], mn = fmaxf(lfv + m, igv), al = expf(lfv + m - mn), be = expf(igv - mn); m = mn;
            const float bv = be * vv[tt * 128 + v]; float pn = 0.f, pd = 0.f;
#pragma unroll
            for (int j = 0; j < 32; ++j) { const float kj = k[tt * 128 + d0 + j], qj = q[tt * 128 + d0 + j]; c[j] = al * c[j] + bv * kj; nn[j] = al * nn[j] + be * kj; pn += c[j] * qj; pd += nn[j] * qj; }
            pn += __shfl_xor(pn, 1); pn += __shfl_xor(pn, 2); pd += __shfl_xor(pd, 1); pd += __shfl_xor(pd, 2);
            if (dq == 0) hbuf[tt * 128 + v] = pn / fmaxf(fabsf(pd), expf(-m));
        }
        __syncthreads();
        { const int tt = F.wave; const size_t row = (size_t)(rowbase + t0 + tt); const float h0 = hbuf[tt * 128 + F.lane], h1 = hbuf[tt * 128 + 64 + F.lane];
          const float rstd = rsqrtf(wave_sum(h0 * h0 + h1 * h1) * (1.f / 128.f) + EPS);
          bf16* yo = P_YCAT + row * MIXW + 1024 + h * 128;
          yo[F.lane] = (bf16)f2bf(h0 * rstd * nw[F.lane] * sigmoidf_(oo[tt * 128 + F.lane])); yo[64 + F.lane] = (bf16)f2bf(h1 * rstd * nw[64 + F.lane] * sigmoidf_(oo[tt * 128 + 64 + F.lane])); }
        __syncthreads();
    }
    { float* co = OUTP() + (grp ? O_S_MC : O_P_MC) + ((((size_t)l * Bn + b) * 4 + h) * 128 + v) * 128 + d0;
#pragma unroll
      for (int j = 0; j < 32; ++j) co[j] = c[j];
      if (v == 0) { float* no = OUTP() + (grp ? O_S_MN : O_P_MN) + (((size_t)l * Bn + b) * 4 + h) * 128 + d0;
#pragma unroll
          for (int j = 0; j < 32; ++j) no[j] = nn[j]; }
      if (tid == 0) OUTP()[(grp ? O_S_MM : O_P_MM) + ((size_t)l * Bn + b) * 4 + h] = m; }
    __syncthreads();
}
__device__ __forceinline__ void lru_item(Frame& F, int l, int grp, int b, int kb) {
    const int T = grp ? SEQ_S : SEQ_P, rowbase = grp ? MP + b * SEQ_S : b * SEQ_P, Bn = grp ? NB_S : NB_P;
    const int tid = F.tid, d = tid & 127, tg = tid >> 7, ch = kb * 128 + d;
    LAS float* xc = (LAS float*)F.lds; LAS float* as = xc + 1024; LAS float* bs = as + 1024;
    float hreg = grp ? INP(I_LH)[((size_t)l * NB_S + b) * LRUW + ch] : 0.f;
    const float spl = softplusf_(-INP(I_LLAM)[l * LRUW + ch]), cb = INP(I_LCB)[l * LRUW + ch], ba = INP(I_LBA)[l * LRUW + ch], bx = INP(I_LBX)[l * LRUW + ch];
    float cw[4];
#pragma unroll
    for (int j = 0; j < 4; ++j) cw[j] = INP(I_LCW)[((size_t)l * 4 + j) * LRUW + ch];
    const float* hist = INP(I_LCONV) + ((size_t)l * NB_S + b) * 3 * LRUW;
    const float* wa = INP(I_LWA) + ((size_t)l * 4 + kb) * 128 * 128 + d; const float* wx = INP(I_LWX) + ((size_t)l * 4 + kb) * 128 * 128 + d;
    for (int t0 = 0; t0 < T; t0 += 8) {
#pragma unroll
        for (int e = 0; e < 2; ++e) { const int tt = tg * 2 + e, t = t0 + tt; float acc = cb;
#pragma unroll
            for (int j = 0; j < 4; ++j) { const int tp = t - 3 + j; float val;
                if (tp >= 0) val = bf2f(P_U[(size_t)(rowbase + tp) * NU + UC_XR + ch]); else val = grp ? hist[(tp + 3) * LRUW + ch] : 0.f;
                acc += cw[j] * val; }
            xc[tt * 128 + d] = acc; }
        __syncthreads();
        float ra0 = ba, ra1 = ba, ri0 = bx, ri1 = bx;
#pragma unroll 4
        for (int cc = 0; cc < 128; ++cc) { const float a_ = wa[cc * 128], x_ = wx[cc * 128], x0 = xc[(tg * 2) * 128 + cc], x1 = xc[(tg * 2 + 1) * 128 + cc];
            ra0 += x0 * a_; ra1 += x1 * a_; ri0 += x0 * x_; ri1 += x1 * x_; }
#pragma unroll
        for (int e = 0; e < 2; ++e) { const int tt = tg * 2 + e; const float r = sigmoidf_(e ? ra1 : ra0), ii = sigmoidf_(e ? ri1 : ri0), la = -8.f * r * spl;
            float mult = sqrtf(-expm1f(2.f * la)); if (!grp && t0 + tt == 0) mult = 1.f;
            as[tt * 128 + d] = expf(la); bs[tt * 128 + d] = mult * ii * xc[tt * 128 + d]; }
        __syncthreads();
        if (tid < 128) {
            for (int tt = 0; tt < 8; ++tt) { hreg = as[tt * 128 + d] * hreg + bs[tt * 128 + d]; const size_t row = (size_t)(rowbase + t0 + tt);
                P_YCAT[row * MIXW + 1536 + ch] = (bf16)f2bf(hreg * gelu_tanhf_(bf2f(P_U[row * NU + UC_GR + ch]))); } }
    }
    if (tid < 128) OUTP()[(grp ? O_S_LH : O_P_LH) + ((size_t)l * Bn + b) * LRUW + ch] = hreg;
    { float* co = OUTP() + (grp ? O_S_LCONV : O_P_LCONV) + ((size_t)l * Bn + b) * 3 * LRUW;
      for (int idx = tid; idx < 3 * 128; idx += NTHR) { const int j = idx / 128, dd = idx % 128; co[j * LRUW + kb * 128 + dd] = bf2f(P_U[(size_t)(rowbase + T - 3 + j) * NU + UC_XR + kb * 128 + dd]); } }
    __syncthreads();
}
__device__ __forceinline__ void mixer_phase(Frame& F, int l) {
    constexpr int N0 = 32, N1 = N0 + 128, N2 = N1 + 32, N3 = N2 + 2048, N4 = N3 + 512, N5 = N4 + 512;
    volatile LAS int* slot = (volatile LAS int*)(F.lds + 65536);
    for (;;) {
        if (F.tid == 0) *slot = (int)atomicAdd(P_CTL + CW_Q + 64 * l, 1u);
        __syncthreads();
        const int it = *slot;
        __syncthreads();
        if (it >= N5) break;
        if (it < N0) mlstm_item(F, l, 0, it >> 2, it & 3);
        else if (it < N1) ssd_item(F, l, 0, (it - N0) >> 4, (it - N0) & 15);
        else if (it < N2) lru_item(F, l, 0, (it - N1) >> 2, (it - N1) & 3);
        else if (it < N3) ssd_item(F, l, 1, (it - N2) >> 4, (it - N2) & 15);
        else if (it < N4) mlstm_item(F, l, 1, (it - N3) >> 2, (it - N3) & 3);
        else lru_item(F, l, 1, (it - N4) >> 2, (it - N4) & 3);
    }
}

#ifndef PHMASK
#define PHMASK 1023
#endif
constexpr int NPH = 18;
__global__ void __launch_bounds__(NTHR, 2) mega(Args args) {
    extern __shared__ __attribute__((aligned(16))) unsigned char lds_raw[];
    Frame F;
    F.lds = (LAS unsigned char*)lds_raw;
    F.tid = threadIdx.x; F.lane = F.tid & 63; F.wave = __builtin_amdgcn_readfirstlane(F.tid >> 6); F.G = gridDim.x;
    volatile LAS unsigned* MISC = (volatile LAS unsigned*)(F.lds + MISC_OFF);
    for (int u = F.tid; u < (LDS_BYTES - LDSCTL_OFF) / 4; u += NTHR) ((LAS unsigned*)(F.lds + LDSCTL_OFF))[u] = 0u;
    __syncthreads();
    XcdBarrier bar; bar.bar = nullptr; bar.x = 0; bar.st = nullptr;
    const bool multi = (args.ph_hi - args.ph_lo) > 1;
    if (multi) bar = xcd_barrier_post(P_CTL + CW_BAR, MISC + 8);
    for (int ph = args.ph_lo; ph < args.ph_hi; ++ph) {
        { int t_ = threadIdx.x; asm volatile("" : "+v"(t_)); F.tid = t_; F.lane = t_ & 63; F.wave = __builtin_amdgcn_readfirstlane(t_ >> 6); }
        if (ph == 0) { if (PHMASK & 256) p0_prologue(F); }
        else if (ph == NPH - 1) { if (PHMASK & 512) final_norm_phase(F); }
        else {
            const int l = (ph - 1) >> 3, sub = (ph - 1) & 7;
            if (sub == 0) { if (PHMASK & 1) norm_phase<true>(F, l, 1); }
            else if (sub == 1) { if (PHMASK & 2) { pg8::Gemm g{P_HN, P_WINT + (size_t)l * NU * DM, MT, NU, DM}; pg8::StaticOrder S; S.init(MT, NU, F.G, (int)blockIdx.x);
                pg8::EpiBf16<0> E{P_U, NU}; pg8::gemm_phase<pg8::EpiBf16<0>, pg8::StaticOrder, true, true>(F.lds, g, S, E); } }
            else if (sub == 2) { if (PHMASK & 4) mixer_phase(F, l); }
            else if (sub == 3) { if (PHMASK & 8) yscale_phase(F, l); }
            else if (sub == 4) { if (PHMASK & 16) { pg8::Gemm g{P_YCAT, P_WOUTT + (size_t)l * DM * MIXW, MT, DM, MIXW}; pg8::StaticOrder S; S.init(MT, DM, F.G, (int)blockIdx.x);
                const float* xp = l == 0 ? INP(I_XP) : P_XW; const float* xs = l == 0 ? INP(I_XS) : P_XW + (size_t)MP * DM;
                pg8::EpiResid E{xp, xs, P_XW, P_MOD + (size_t)l * MODROWS * MODLD + 2048}; pg8::gemm_phase<pg8::EpiResid, pg8::StaticOrder, true, true>(F.lds, g, S, E); } }
            else if (sub == 5) { if (PHMASK & 32) norm_phase<false>(F, l, 2); }
            else if (sub == 6) { if (PHMASK & 64) { pg8::Gemm g{P_HN, P_WUPT + (size_t)l * DFF * DM, MT, DFF, DM}; pg8::StaticOrder S; S.init(MT, DFF, F.G, (int)blockIdx.x);
                pg8::EpiBf16<1> E{P_HID, DFF}; pg8::gemm_phase<pg8::EpiBf16<1>, pg8::StaticOrder, true, true>(F.lds, g, S, E); } }
            else { if (PHMASK & 128) { pg8::Gemm g{P_HID, P_WDNT + (size_t)l * DM * DFF, MT, DM, DFF}; pg8::StaticOrder S; S.init(MT, DM, F.G, (int)blockIdx.x);
                pg8::EpiResid E{P_XW, P_XW + (size_t)MP * DM, P_XW, P_MOD + (size_t)l * MODROWS * MODLD + 5120}; pg8::gemm_phase<pg8::EpiResid, pg8::StaticOrder, true, true>(F.lds, g, S, E); } }
        }
        if (ph + 1 < args.ph_hi) xcd_barrier(bar);
    }
}

extern "C" void kernel_launch(void* const* d_in, const int* in_sizes, int n_in, void* d_out, int out_size, void* d_ws, size_t ws_size, hipStream_t stream) {
    static int grid = 0;
    if (grid == 0) {
        if (n_in != 36 || out_size != (int)O_END || ws_size < WS_END) { fprintf(stderr, "kernel_launch: unexpected shapes: n_in %d out %d ws %zu; nothing launched\n", n_in, out_size, ws_size); grid = -1; return; }
        int dev = 0, cus = 0, per_cu = 0;
        if (hipGetDevice(&dev) != hipSuccess || hipDeviceGetAttribute(&cus, hipDeviceAttributeMultiprocessorCount, dev) != hipSuccess) { grid = -1; return; }
        if (hipFuncSetAttribute((const void*)mega, hipFuncAttributeMaxDynamicSharedMemorySize, LDS_BYTES) != hipSuccess) { fprintf(stderr, "kernel_launch: hipFuncSetAttribute failed\n"); grid = -1; return; }
        if (hipOccupancyMaxActiveBlocksPerMultiprocessor(&per_cu, (const void*)mega, NTHR, LDS_BYTES) != hipSuccess || per_cu < 1) { fprintf(stderr, "kernel_launch: occupancy query says %d\n", per_cu); per_cu = 1; }
        (void)hipGetLastError();
        grid = cus;
    }
    if (grid < 0) return;
    if (hipMemsetAsync((char*)d_ws + WS_CTL, 0, CTL_ZERO_BYTES, stream) != hipSuccess) { fprintf(stderr, "kernel_launch: memset failed\n"); return; }
    Args a{};
    for (int i = 0; i < 36; ++i) a.in[i] = (const float*)d_in[i];
    a.out = (float*)d_out; a.ws = (unsigned char*)d_ws;
#if MK_ONE
    a.ph_lo = 0; a.ph_hi = NPH;
    { void* kargs[] = {&a}; hipError_t e = hipLaunchCooperativeKernel((const void*)mega, dim3(grid), dim3(NTHR), kargs, LDS_BYTES, stream);
      if (e != hipSuccess) fprintf(stderr, "kernel_launch: cooperative launch failed: %s (grid %d)\n", hipGetErrorString(e), grid); }
#else
    for (int ph = 0; ph < NPH; ++ph) { a.ph_lo = ph; a.ph_hi = ph + 1; hipLaunchKernelGGL(mega, dim3(grid), dim3(NTHR), LDS_BYTES, stream, a); }
#endif
}
```

```cpp
#include <hip/hip_runtime.h>
#include <cstdio>
#include <cstdint>
namespace pg8 {
#define PG8_LAS __attribute__((address_space(3)))
typedef unsigned short bf16_t;
typedef short bf16x8 __attribute__((ext_vector_type(8)));
typedef float f32x4 __attribute__((ext_vector_type(4)));
typedef unsigned u32x4 __attribute__((ext_vector_type(4)));
constexpr int BM = 256, BK = 64, HALF = 128, HTB = HALF * BK * 2  , STAGE_BYTES = 8 * HTB, NXCD = 8, WGM = 8;

__host__ __device__ __forceinline__ int lds_byte(int r, int c) { const int st = (r >> 4) * 2 + (c >> 5), rr = r & 15, cc = c & 31, ob = rr * 64 + cc * 2; return st * 1024 + (ob ^ (((ob >> 9) & 1) << 5)); }
__host__ __device__ __forceinline__ void stage_rc(int b, int& R, int& C) { const int st = b / 1024, sb = b % 1024, swz = sb ^ (((sb >> 9) & 1) << 5); R = (st >> 1) * 16 + swz / 64; C = (st & 1) * 32 + (swz % 64) / 2; }
__host__ __device__ __forceinline__ int perm32(int rho) { const int n = rho >> 4, i = rho & 15; return 8 * (i >> 2) + 4 * n + (i & 3); }

struct Unit { int pm, pn, k0, nt, flags; };
struct Gemm { const bf16_t* A; const bf16_t* Bt; int M, N, K; };

struct StaticOrder {
    int nM, nN, nwg, G, c;
    __host__ __device__ void init(int M, int N, int G_, int c_) { nM = M / BM; nN = N / BM; nwg = nM * nN; G = G_; c = c_; }
    __host__ __device__ bool next(int i, Unit& u) const {
        const long L = (long)i * G + c; if (L >= nwg) return false;
        int wgid = (int)L; { const int q = nwg / NXCD, r = nwg % NXCD, xcd = wgid % NXCD, off = wgid / NXCD; wgid = (xcd < r ? xcd * (q + 1) : r * (q + 1) + (xcd - r) * q) + off; }
        const int nig = WGM * nN, gid = wgid / nig, fm = gid * WGM, gsz = (nM - fm) < WGM ? (nM - fm) : WGM;
        u.pm = fm + ((wgid % nig) % gsz); u.pn = (wgid % nig) / gsz; u.k0 = 0; u.nt = 0; u.flags = 0; return true;
    }
    __device__ __forceinline__ void a_ready(const Unit&) const {}
    __device__ __forceinline__ void done(const Unit&) const {}
};

__device__ __forceinline__ unsigned cvt_pk_bf16(float lo, float hi) { unsigned r; asm volatile("v_cvt_pk_bf16_f32 %0, %1, %2" : "=v"(r) : "v"(lo), "v"(hi)); return r; }

template <int ACT> struct EpiBf16 {
    static constexpr bool PERM = true, AFTER_DRAIN = false, MIDK = false;
    bf16_t* O; int ldc;
    __device__ __forceinline__ bool deferred(const Unit&) const { return false; }
    __device__ __forceinline__ void fused(const f32x4 (&)[2][2][4][2], const Unit&, int, int, int, int, PG8_LAS unsigned char*, int, int) const {}
    __device__ __forceinline__ void operator()(const f32x4 (&acc)[2][2][4][2], const Unit& u, int wr, int wc, int fr, int fq) const {
        const int row0 = u.pm * BM + wr * 64 + fr; const int col0 = u.pn * BM + wc * 32 + 8 * fq;
#pragma unroll
        for (int ai = 0; ai < 2; ++ai)
#pragma unroll
            for (int m = 0; m < 4; ++m) { bf16_t* rowp = O + (size_t)(row0 + ai * HALF + m * 16) * ldc + col0;
#pragma unroll
                for (int bj = 0; bj < 2; ++bj) { f32x4 v0 = acc[ai][bj][m][0], v1 = acc[ai][bj][m][1];
                    if (ACT == 1) {
#pragma unroll
                        for (int e = 0; e < 4; ++e) { const float a0 = fmaxf(v0[e], 0.f), a1 = fmaxf(v1[e], 0.f); v0[e] = a0 * a0; v1[e] = a1 * a1; } }
                    u32x4 w; w.x = cvt_pk_bf16(v0[0], v0[1]); w.y = cvt_pk_bf16(v0[2], v0[3]); w.z = cvt_pk_bf16(v1[0], v1[1]); w.w = cvt_pk_bf16(v1[2], v1[3]);
                    *(u32x4*)(rowp + bj * HALF) = w; } }
    }
};
template <bool MIDK_> struct EpiResid {
    static constexpr bool PERM = false, AFTER_DRAIN = false, MIDK = MIDK_;
    const float* xp; const float* xs; float* out; const float* gate; const float* ssq; int midk_kt; float inv_n, eps;
    __device__ __forceinline__ bool deferred(const Unit&) const { return false; }
    __device__ __forceinline__ void fused(const f32x4 (&)[2][2][4][2], const Unit&, int, int, int, int, PG8_LAS unsigned char*, int, int) const {}
    __device__ __forceinline__ void operator()(const f32x4 (&acc)[2][2][4][2], const Unit& u, int wr, int wc, int fr, int fq) const {
        const int col0 = u.pn * BM + wc * 32 + 4 * fq, row00 = u.pm * BM + wr * 64 + fr;
        const int mr = row00 < 16384 ? (row00 >> 11) : 8 + ((row00 - 16384) >> 3); const float* gp = gate + (size_t)mr * 6144;
        f32x4 g4[2][2], xa[2][2], xb[2][2];
#pragma unroll
        for (int bj = 0; bj < 2; ++bj)
#pragma unroll
            for (int n = 0; n < 2; ++n) g4[bj][n] = *(const f32x4*)(gp + col0 + bj * HALF + n * 16);
        auto ldx = [&](int k, f32x4 (&x)[2][2]) { const int row = row00 + (k >> 2) * HALF + (k & 3) * 16; const float* xin = row < 16384 ? xp + (size_t)row * 1024 : xs + (size_t)(row - 16384) * 1024;
#pragma unroll
            for (int bj = 0; bj < 2; ++bj)
#pragma unroll
                for (int n = 0; n < 2; ++n) x[bj][n] = *(const f32x4*)(xin + col0 + bj * HALF + n * 16); };
        auto stx = [&](int k, const f32x4 (&x)[2][2]) { const int ai = k >> 2, m = k & 3, row = row00 + ai * HALF + m * 16; float* op = out + (size_t)row * 1024;
#pragma unroll
            for (int bj = 0; bj < 2; ++bj)
#pragma unroll
                for (int n = 0; n < 2; ++n) *(f32x4*)(op + col0 + bj * HALF + n * 16) = x[bj][n] + g4[bj][n] * acc[ai][bj][m][n]; };
        ldx(0, xa);
#pragma unroll
        for (int k = 0; k < 8; k += 2) { ldx(k + 1, xb); stx(k, xa); asm volatile("" ::: "memory"); if (k + 2 < 8) ldx(k + 2, xa); stx(k + 1, xb); asm volatile("" ::: "memory"); }
    }
};
template <bool MIDK_> struct EpiAtomic {
    static constexpr bool PERM = false, AFTER_DRAIN = false, MIDK = MIDK_;
    float* out; const float* gate; const float* ssq; int midk_kt; float inv_n, eps;
    __device__ __forceinline__ bool deferred(const Unit&) const { return true; }
    __device__ __forceinline__ void operator()(const f32x4 (&)[2][2][4][2], const Unit&, int, int, int, int) const {}
    __device__ __forceinline__ void fused(const f32x4 (&acc)[2][2][4][2], const Unit& u, int wr, int wc, int fr, int fq, PG8_LAS unsigned char* lds, int wid, int lane) const {
#pragma unroll
        for (int ai = 0; ai < 2; ++ai) {
#pragma unroll
            for (int m = 0; m < 4; ++m) { const int row = wr * 64 + m * 16 + fr;
#pragma unroll
                for (int bj = 0; bj < 2; ++bj)
#pragma unroll
                    for (int n = 0; n < 2; ++n) { const int chunk = (bj * HALF + wc * 32 + n * 16 + 4 * fq) >> 2; *(PG8_LAS f32x4*)(lds + row * 1024 + ((chunk ^ (row & 15)) << 4)) = acc[ai][bj][m][n]; } }
            asm volatile("s_waitcnt lgkmcnt(0)" ::: "memory"); __builtin_amdgcn_s_barrier(); asm volatile("" ::: "memory");
#pragma unroll
            for (int hb = 0; hb < 2; ++hb) {
                const int grow0 = u.pm * BM + ai * HALF + wid * 16 + 8 * hb; const int mr = grow0 < 16384 ? (grow0 >> 11) : 8 + ((grow0 - 16384) >> 3);
                const float* gp = gate + (size_t)mr * 6144 + u.pn * BM; float gv[4];
#pragma unroll
                for (int j = 0; j < 4; ++j) gv[j] = gp[lane + 64 * j];
#pragma unroll
                for (int r8 = 0; r8 < 8; ++r8) { const int row = wid * 16 + 8 * hb + r8; float* op = out + (size_t)(grow0 + r8) * 1024 + u.pn * BM;
#pragma unroll
                    for (int j = 0; j < 4; ++j) { const int col = lane + 64 * j; const float v = *(const PG8_LAS float*)(lds + row * 1024 + (((col >> 2) ^ (row & 15)) << 4) + (col & 3) * 4);
                        __hip_atomic_fetch_add(op + col, gv[j] * v, __ATOMIC_RELAXED, __HIP_MEMORY_SCOPE_AGENT); } } }
            asm volatile("s_waitcnt lgkmcnt(0)" ::: "memory"); __builtin_amdgcn_s_barrier(); asm volatile("" ::: "memory");
        }
    }
};
struct SampleSplitOrder {
    int nN, c, ntk, SPLIT, midk_kt;
    __device__ void init(int N, int K, int c_, int split, int midk) { nN = N / BM; c = c_; ntk = K / BK; SPLIT = split; midk_kt = midk; }
    __device__ bool next(int i, Unit& u) const {
        if (i != 0 || c >= 4 * nN * SPLIT) return false;
        const int tile = c / SPLIT, sp = c % SPLIT; u.pm = 64 + tile / nN; u.pn = tile % nN; u.nt = ntk / SPLIT; u.k0 = sp * u.nt; u.flags = (u.k0 + u.nt <= midk_kt) ? 2 : 0; return true;
    }
    __device__ __forceinline__ void a_ready(const Unit&) const {}
    __device__ __forceinline__ void done(const Unit&) const {}
};
struct MidkOrder {
    StaticOrder P; int ntk, midk_kt;
    __device__ void init(int M, int N, int K, int G_, int c_, int midk) { P.init(M, N, G_, c_); ntk = K / BK; midk_kt = midk; }
    __device__ bool next(int i, Unit& u) const {
        if (!P.next(i >> 1, u)) return false;
        if (i & 1) { u.k0 = midk_kt; u.nt = ntk - midk_kt; u.flags = 0; } else { u.k0 = 0; u.nt = midk_kt; u.flags = 1; }
        return true;
    }
    __device__ __forceinline__ void a_ready(const Unit&) const {}
    __device__ __forceinline__ void done(const Unit&) const {}
};
template <class Epi, class Sched, bool ALIGN_EPI = false, bool SP2 = false>
__device__ __forceinline__ void gemm_phase(PG8_LAS unsigned char* lds, const Gemm g, const Sched& S, const Epi& E, int tid_in) {
    int tid_ = tid_in; asm volatile("" : "+v"(tid_));
    const int tid = tid_, wid = __builtin_amdgcn_readfirstlane(tid >> 6), lane = tid & 63, wr = wid >> 2, wc = wid & 3, fr = lane & 15, fq = lane >> 4;
    const int K = g.K; int nt = K / BK;
    unsigned voffA[2], voffB[2];
#pragma unroll
    for (int i = 0; i < 2; ++i) { int R, C; stage_rc(tid * 16 + i * 8192, R, C); const int Rb = Epi::PERM ? ((R & ~31) + perm32(R & 31)) : R;
        voffA[i] = (unsigned)(R * K + C) * 2u; voffB[i] = (unsigned)(Rb * K + C) * 2u; }
    const size_t kstep = (size_t)(BK * 2);
    const size_t hstep = (size_t)HALF * K * 2;
    const size_t tstep = 2 * hstep;
    const unsigned ldsw = (unsigned)wid * 1024u;
    const int aoff = lds_byte(wr * 64 + fr, fq * 8), boff = lds_byte(wc * 32 + fr, fq * 8);
#define PG8_SA(b, h) (((b) * 2 + (h)) * HTB)
#define PG8_SB(b, h) ((4 + (b) * 2 + (h)) * HTB)
#define PG8_STAGE(bufoff, gbase, voff) do { _Pragma("unroll") for (int _i = 0; _i < 2; ++_i) \
        __builtin_amdgcn_global_load_lds((const unsigned*)((const char*)(gbase) + (voff)[_i]), (PG8_LAS unsigned*)(lds + (bufoff) + ldsw + _i * 8192), 16, 0, 0); } while (0)
#define PG8_LDA(dst, b, h) do { _Pragma("unroll") for (int m = 0; m < 4; ++m) _Pragma("unroll") for (int k = 0; k < 2; ++k) dst[m][k] = *(const PG8_LAS bf16x8*)(lds + PG8_SA(b, h) + aoff + m * 2048 + k * 1024); } while (0)
#define PG8_LDB(dst, b, h) do { _Pragma("unroll") for (int n = 0; n < 2; ++n) _Pragma("unroll") for (int k = 0; k < 2; ++k) dst[n][k] = *(const PG8_LAS bf16x8*)(lds + PG8_SB(b, h) + boff + n * 2048 + k * 1024); } while (0)
#define PG8_MMA(ai, bj, At, Bt) do { __builtin_amdgcn_s_setprio(1); _Pragma("unroll") for (int m = 0; m < 4; ++m) _Pragma("unroll") for (int n = 0; n < 2; ++n) _Pragma("unroll") for (int k = 0; k < 2; ++k) \
        acc[ai][bj][m][n] = __builtin_amdgcn_mfma_f32_16x16x32_bf16(Bt[n][k], At[m][k], acc[ai][bj][m][n], 0, 0, 0); __builtin_amdgcn_s_setprio(0); } while (0)
#define PG8_WAIT_V(n) asm volatile("s_waitcnt vmcnt(" #n ")" ::: "memory")
#define PG8_WAIT_L(n) asm volatile("s_waitcnt lgkmcnt(" #n ")" ::: "memory")
#define PG8_BAR __builtin_amdgcn_s_barrier()
#define PG8_SCHED __builtin_amdgcn_sched_barrier(0)
    Unit cur, nxt; int ui = 0;
    if (!S.next(0, cur)) return;
    PG8_LAS float* rsb = (PG8_LAS float*)(lds + STAGE_BYTES + 1024);
#define PG8_RS_UNIT(u_) do { if constexpr (Epi::MIDK) { const int r_ = tid >> 1, hh_ = tid & 1; const float* sp_ = E.ssq + ((size_t)(u_).pm * BM + r_) * 16 + hh_ * 8; \
        const f32x4 s0_ = *(const f32x4*)sp_, s1_ = *(const f32x4*)(sp_ + 4); float s_ = (s0_[0] + s0_[1]) + (s0_[2] + s0_[3]) + (s1_[0] + s1_[1]) + (s1_[2] + s1_[3]); s_ += __shfl_xor(s_, 1); \
        if (hh_ == 0) rsb[r_] = __builtin_amdgcn_rsqf(s_ * E.inv_n + E.eps); } } while (0)
#define PG8_RS_APPLY() do { _Pragma("unroll") for (int a_ = 0; a_ < 2; ++a_) _Pragma("unroll") for (int m_ = 0; m_ < 4; ++m_) { const float rs_ = rsb[a_ * HALF + wr * 64 + m_ * 16 + fr]; \
        _Pragma("unroll") for (int b_ = 0; b_ < 2; ++b_) _Pragma("unroll") for (int n_ = 0; n_ < 2; ++n_) acc[a_][b_][m_][n_] *= rs_; } } while (0)
    if constexpr (Epi::MIDK) { PG8_RS_UNIT(cur); }
    f32x4 acc[2][2][4][2];
#pragma unroll
    for (int a = 0; a < 2; ++a)
#pragma unroll
        for (int b = 0; b < 2; ++b)
#pragma unroll
            for (int m = 0; m < 4; ++m)
#pragma unroll
                for (int n = 0; n < 2; ++n) acc[a][b][m][n] = (f32x4){0.f, 0.f, 0.f, 0.f};
    bf16x8 At[4][2], B0[2][2], B1[2][2];
    if (cur.nt) nt = cur.nt;
    const char* cA = (const char*)g.A + (size_t)cur.pm * tstep + (size_t)cur.k0 * kstep; const char* cB = (const char*)g.Bt + (size_t)cur.pn * tstep + (size_t)cur.k0 * kstep;
    S.a_ready(cur);
    if constexpr (SP2) {
        PG8_STAGE(PG8_SB(0, 0), cB, voffB); PG8_STAGE(PG8_SB(0, 1), cB + hstep, voffB); PG8_STAGE(PG8_SA(0, 0), cA, voffA); PG8_STAGE(PG8_SA(0, 1), cA + hstep, voffA);
        if (wr == 1) PG8_BAR;
        PG8_WAIT_V(2); PG8_BAR;
        PG8_STAGE(PG8_SB(1, 0), cB + kstep, voffB); PG8_STAGE(PG8_SA(1, 0), cA + kstep, voffA); PG8_STAGE(PG8_SB(1, 1), cB + hstep + kstep, voffB);
        PG8_WAIT_V(6); PG8_BAR;
    } else {
        PG8_STAGE(PG8_SB(0, 0), cB, voffB); PG8_STAGE(PG8_SA(0, 0), cA, voffA); PG8_STAGE(PG8_SB(0, 1), cB + hstep, voffB); PG8_STAGE(PG8_SA(0, 1), cA + hstep, voffA);
        if (wr == 1) PG8_BAR;
        PG8_WAIT_V(4); PG8_BAR;
        PG8_STAGE(PG8_SB(1, 0), cB + kstep, voffB); PG8_STAGE(PG8_SA(1, 0), cA + kstep, voffA); PG8_STAGE(PG8_SB(1, 1), cB + hstep + kstep, voffB);
        PG8_WAIT_V(6); PG8_BAR;
    }
    for (;;) {
        const bool has_next = S.next(ui + 1, nxt);
        const char* nA = has_next ? (const char*)g.A + (size_t)nxt.pm * tstep + (size_t)nxt.k0 * kstep : cA; const char* nB = has_next ? (const char*)g.Bt + (size_t)nxt.pn * tstep + (size_t)nxt.k0 * kstep : cB;
        for (int t = 0; t < nt; t += 2) {
            const bool last = (t == nt - 2);
            const char* a1 = cA + (size_t)(t + 1) * kstep;
            const char* a2 = last ? nA : cA + (size_t)(t + 2) * kstep; const char* b2 = last ? nB : cB + (size_t)(t + 2) * kstep;
            const char* a3 = a2 + kstep; const char* b3 = b2 + kstep;
            if (last && has_next) S.a_ready(nxt);
            if constexpr (SP2) {
            PG8_LDB(B0, 0, 0); PG8_LDB(B1, 0, 1); PG8_SCHED; PG8_LDA(At, 0, 0); PG8_STAGE(PG8_SA(1, 1), a1 + hstep, voffA);
            PG8_WAIT_V(8); PG8_WAIT_L(0); PG8_BAR; PG8_MMA(0, 0, At, B0); PG8_MMA(0, 1, At, B1); PG8_BAR; PG8_SCHED;
            PG8_LDA(At, 0, 1); PG8_STAGE(PG8_SB(0, 0), b2, voffB); PG8_STAGE(PG8_SB(0, 1), b2 + hstep, voffB); PG8_STAGE(PG8_SA(0, 0), a2, voffA);
            PG8_WAIT_V(8); PG8_WAIT_L(0); PG8_BAR; PG8_MMA(1, 0, At, B0); PG8_MMA(1, 1, At, B1); PG8_BAR; PG8_SCHED;
            PG8_LDB(B0, 1, 0); PG8_LDB(B1, 1, 1); PG8_SCHED; PG8_LDA(At, 1, 0); PG8_STAGE(PG8_SA(0, 1), a2 + hstep, voffA);
            PG8_WAIT_V(8); PG8_WAIT_L(0); PG8_BAR; PG8_MMA(0, 0, At, B0); PG8_MMA(0, 1, At, B1); PG8_BAR; PG8_SCHED;
            PG8_LDA(At, 1, 1); PG8_STAGE(PG8_SB(1, 0), b3, voffB); PG8_STAGE(PG8_SB(1, 1), b3 + hstep, voffB); PG8_STAGE(PG8_SA(1, 0), a3, voffA);
            PG8_WAIT_V(8); PG8_WAIT_L(0); PG8_BAR; PG8_MMA(1, 0, At, B0); PG8_MMA(1, 1, At, B1); PG8_BAR; PG8_SCHED;
            } else {
            PG8_LDB(B0, 0, 0); PG8_SCHED; PG8_LDA(At, 0, 0); PG8_STAGE(PG8_SA(1, 1), a1 + hstep, voffA);
            PG8_WAIT_L(8); PG8_BAR; PG8_WAIT_L(0); PG8_MMA(0, 0, At, B0); PG8_BAR; PG8_SCHED;
            PG8_LDB(B1, 0, 1); PG8_STAGE(PG8_SB(0, 0), b2, voffB);
            PG8_BAR; PG8_WAIT_L(0); PG8_MMA(0, 1, At, B1); PG8_BAR;
            PG8_LDA(At, 0, 1); PG8_STAGE(PG8_SA(0, 0), a2, voffA);
            PG8_BAR; PG8_WAIT_L(0); PG8_MMA(1, 0, At, B0); PG8_BAR; PG8_SCHED;
            PG8_STAGE(PG8_SB(0, 1), b2 + hstep, voffB);
            PG8_WAIT_V(6); PG8_BAR; PG8_MMA(1, 1, At, B1); PG8_BAR;
            PG8_LDB(B0, 1, 0); PG8_SCHED; PG8_LDA(At, 1, 0); PG8_STAGE(PG8_SA(0, 1), a2 + hstep, voffA);
            PG8_WAIT_L(8); PG8_BAR; PG8_WAIT_L(0); PG8_MMA(0, 0, At, B0); PG8_BAR; PG8_SCHED;
            PG8_LDB(B1, 1, 1); PG8_STAGE(PG8_SB(1, 0), b3, voffB);
            PG8_BAR; PG8_WAIT_L(0); PG8_MMA(0, 1, At, B1); PG8_BAR;
            PG8_LDA(At, 1, 1); PG8_STAGE(PG8_SA(1, 0), a3, voffA);
            PG8_BAR; PG8_WAIT_L(0); PG8_MMA(1, 0, At, B0); PG8_BAR; PG8_SCHED;
            PG8_STAGE(PG8_SB(1, 1), b3 + hstep, voffB);
            PG8_WAIT_V(6); PG8_BAR; PG8_MMA(1, 1, At, B1); PG8_BAR;
            }
        }
        bool partial = false;
        if constexpr (Epi::MIDK) { if (cur.flags & 3) PG8_RS_APPLY(); partial = (cur.flags & 1) != 0; }
        if (!partial) {
        if constexpr (ALIGN_EPI) { if (wr == 0) PG8_BAR; }
        if constexpr (!Epi::AFTER_DRAIN) { if (!E.deferred(cur)) E(acc, cur, wr, wc, fr, fq); S.done(cur); }
        }
        if (!has_next) break;
        if (!partial) {
#pragma unroll
        for (int a = 0; a < 2; ++a)
#pragma unroll
            for (int b = 0; b < 2; ++b)
#pragma unroll
                for (int m = 0; m < 4; ++m)
#pragma unroll
                    for (int n = 0; n < 2; ++n) acc[a][b][m][n] = (f32x4){0.f, 0.f, 0.f, 0.f};
        }
        cur = nxt; cA = nA; cB = nB; ++ui; nt = cur.nt ? cur.nt : K / BK;
        if (!partial) {
        if constexpr (Epi::MIDK) { PG8_RS_UNIT(cur); }
        if constexpr (ALIGN_EPI) { if (wr == 1) PG8_BAR; }
        }
    }
    PG8_WAIT_V(0);
    if constexpr (!ALIGN_EPI) { if (wr == 0) PG8_BAR; }
    PG8_BAR;
    if constexpr (Epi::AFTER_DRAIN) { E.fused(acc, cur, wr, wc, fr, fq, lds, wid, lane); S.done(cur); }
    else { if (E.deferred(cur)) E.fused(acc, cur, wr, wc, fr, fq, lds, wid, lane); }
#undef PG8_RS_UNIT
#undef PG8_RS_APPLY
#undef PG8_SA
#undef PG8_SB
#undef PG8_STAGE
#undef PG8_LDA
#undef PG8_LDB
#undef PG8_MMA
#undef PG8_WAIT_V
#undef PG8_WAIT_L
#undef PG8_BAR
#undef PG8_SCHED
}
}

#ifndef SSD2PASS
#define SSD2PASS 0
#endif
#ifndef SSD2F
#define SSD2F 0
#endif
#ifndef MERGEB
#define MERGEB 1
#endif
#ifndef MK_ONE
#define MK_ONE 1
#endif
constexpr int DM = 1024, NB_P = 8, SEQ_P = 2048, NB_S = 128, SEQ_S = 8, DEPTH = 2;
constexpr int MP = NB_P * SEQ_P, MS = NB_S * SEQ_S, MT = MP + MS;
constexpr int IN_DIM = 5656, NU = 5632, NG = 24, DFF = 4096, MIXW = 2048, CONVD = 1536, LRUW = 512;
constexpr int MODLD = 6144, MODROWS = 160;
constexpr float EPS = 1e-6f;
constexpr int UC_Z = 0, UC_XBC = 1024, UC_Q = 2560, UC_K = 3072, UC_V = 3584, UC_O = 4096, UC_XR = 4608, UC_GR = 5120;
constexpr size_t O_YP = 0, O_YS = O_YP + (size_t)MP * DM;
constexpr size_t O_P_SSM = O_YS + (size_t)MS * DM, O_P_SCONV = O_P_SSM + (size_t)DEPTH * NB_P * 16 * 64 * 128, O_P_MC = O_P_SCONV + (size_t)DEPTH * NB_P * 3 * CONVD,
                 O_P_MN = O_P_MC + (size_t)DEPTH * NB_P * 4 * 128 * 128, O_P_MM = O_P_MN + (size_t)DEPTH * NB_P * 4 * 128, O_P_LH = O_P_MM + (size_t)DEPTH * NB_P * 4,
                 O_P_LCONV = O_P_LH + (size_t)DEPTH * NB_P * LRUW;
constexpr size_t O_S_SSM = O_P_LCONV + (size_t)DEPTH * NB_P * 3 * LRUW, O_S_SCONV = O_S_SSM + (size_t)DEPTH * NB_S * 16 * 64 * 128, O_S_MC = O_S_SCONV + (size_t)DEPTH * NB_S * 3 * CONVD,
                 O_S_MN = O_S_MC + (size_t)DEPTH * NB_S * 4 * 128 * 128, O_S_MM = O_S_MN + (size_t)DEPTH * NB_S * 4 * 128, O_S_LH = O_S_MM + (size_t)DEPTH * NB_S * 4,
                 O_S_LCONV = O_S_LH + (size_t)DEPTH * NB_S * LRUW, O_END = O_S_LCONV + (size_t)DEPTH * NB_S * 3 * LRUW;
static_assert(O_END == 73253952, "output size");
constexpr size_t MiB = 1u << 20;
constexpr size_t WS_CTL = 0, CTL_ZERO_BYTES = 131072;
constexpr size_t WS_WG = 1 * MiB, WS_MOD = 2 * MiB, WS_WIN = 10 * MiB, WS_WOUT = 32 * MiB, WS_WUP = 40 * MiB, WS_WDN = 56 * MiB;
constexpr size_t WS_GATES = 72 * MiB, WS_SSQ = 74 * MiB, WS_HN = 76 * MiB, WS_XW = 110 * MiB, WS_YCAT = 178 * MiB, WS_YZ = 246 * MiB, WS_U = 315 * MiB, WS_END = 503 * MiB;
constexpr size_t WS_HID = WS_U;
static_assert(WS_U + (size_t)MT * NU * 2 <= WS_END && (size_t)MT * DFF * 2 <= (size_t)MT * NU * 2 && WS_MOD + (size_t)DEPTH * MODROWS * MODLD * 4 <= WS_WIN, "ws map");
static_assert((size_t)DEPTH * NU * DM * 2 == WS_WOUT - WS_WIN && (size_t)MT * DM * 2 == WS_XW - WS_HN && (size_t)MT * DM * 4 == WS_YCAT - WS_XW && (size_t)MT * MIXW * 2 == WS_YZ - WS_YCAT, "ws map 2");
constexpr int CW_Q = 64;
constexpr int CW_BAR = 4096;
constexpr int CW_FLAG2 = 16384;
constexpr int CW_FLAG = 8192;
static_assert((CW_FLAG + 64 * 128) <= CW_FLAG2 && (CW_FLAG2 + 16 * 512) * 4 <= (int)CTL_ZERO_BYTES, "flags inside the per-call memset");
constexpr int RING_BYTES = 131072, LDS_BYTES = 147456, MISC_OFF = LDS_BYTES - 128, LDSCTL_OFF = MISC_OFF;
constexpr int NWAVES = 8, NTHR = 512;

#define GAS __attribute__((address_space(1)))
#define LAS __attribute__((address_space(3)))
typedef unsigned short bf16;
typedef unsigned v4u __attribute__((ext_vector_type(4)));
typedef unsigned v2u __attribute__((ext_vector_type(2)));
typedef float f32x4 __attribute__((ext_vector_type(4)));
typedef float f32x16 __attribute__((ext_vector_type(16)));
#define LDS_WAIT() asm volatile("s_waitcnt lgkmcnt(0)" ::: "memory")
#define LBAR() do { asm volatile("s_waitcnt lgkmcnt(0)" ::: "memory"); __builtin_amdgcn_s_barrier(); asm volatile("" ::: "memory"); } while (0)
__device__ __forceinline__ float bf2f(bf16 h) { return __uint_as_float((unsigned)h << 16); }
typedef short bf16x8 __attribute__((ext_vector_type(8)));
__device__ __forceinline__ float lo_bf(unsigned u) { return __uint_as_float(u << 16); }
__device__ __forceinline__ float hi_bf(unsigned u) { return __uint_as_float(u & 0xffff0000u); }
__device__ __forceinline__ float wave_sum(float v) {
#pragma unroll
    for (int o = 1; o < 64; o <<= 1) v += __shfl_xor(v, o);
    return v;
}
__device__ __forceinline__ float fexp(float x) { return __builtin_amdgcn_exp2f(x * 1.4426950408889634f); }
__device__ __forceinline__ float frcp(float x) { return __builtin_amdgcn_rcpf(x); }
__device__ __forceinline__ float sigmoidf_(float x) { return frcp(1.f + fexp(-x)); }
__device__ __forceinline__ float siluf_(float x) { return x * frcp(1.f + fexp(-x)); }
__device__ __forceinline__ float softplusf_(float x) { return fmaxf(x, 0.f) + 0.6931471805599453f * __builtin_amdgcn_logf(1.f + fexp(-fabsf(x))); }
__device__ __forceinline__ float gelu_tanhf_(float x) { const float u = 0.7978845608028654f * (x + 0.044715f * x * x * x); return 0.5f * x * (2.f - 2.f * frcp(fexp(2.f * u) + 1.f)); }
typedef float f32x2_t __attribute__((ext_vector_type(2))); typedef __bf16 bf16x2_t __attribute__((ext_vector_type(2)));
__device__ __forceinline__ unsigned pk2(float lo, float hi) { f32x2_t v = {lo, hi}; bf16x2_t b = __builtin_convertvector(v, bf16x2_t); return __builtin_bit_cast(unsigned, b); }
__device__ __forceinline__ unsigned f2bf(float f) { return pk2(f, 0.f) & 0xffffu; }
__device__ __forceinline__ int modrow(int row) { return row < MP ? (row >> 11) : NB_P + ((row - MP) >> 3); }

#define XB_TMO      128
#define XB_XCNT(j)  (256  + 64 * (j))
#define XB_XSUB(j)  (1280 + 64 * (j))
#define XB_XGEN(j)  (2304 + 64 * (j))
#define XB_TOP      3328
#define XB_TOPGEN   3392
#define XCD_BAR_WORDS 3456
#define XB_SPIN_CAP (1u << 18)
__device__ __forceinline__ unsigned xb_ld(unsigned* p)              { return __hip_atomic_load(p, __ATOMIC_RELAXED, __HIP_MEMORY_SCOPE_AGENT); }
__device__ __forceinline__ unsigned xb_add(unsigned* p, unsigned v) { return __hip_atomic_fetch_add(p, v, __ATOMIC_RELAXED, __HIP_MEMORY_SCOPE_AGENT); }
__device__ __forceinline__ unsigned xb_xcc_id() { return (unsigned)__builtin_amdgcn_s_getreg((3 << 11) | 20) & 0xFu; }
#define XB_SPIN(cond, bar) do { unsigned _sp = 0; while (cond) { __builtin_amdgcn_s_sleep(1); \
    if ((++_sp & 255u) == 0u) { if (xb_ld(&(bar)[XB_TMO])) break; if (_sp > XB_SPIN_CAP) { atomicAdd(&(bar)[XB_TMO], 1u); break; } } } } while (0)
struct XcdBarrier { unsigned* bar; unsigned x; volatile LAS unsigned* st; };
__device__ __forceinline__ XcdBarrier xcd_barrier_post(unsigned* bar, volatile LAS unsigned* st, int tid) {
    XcdBarrier b; b.bar = bar; b.x = xb_xcc_id(); b.st = st;
    if (tid == 0) (void)xb_add(&bar[XB_XCNT(b.x)], 1u);
    return b;
}
__device__ __forceinline__ void xcd_barrier_complete(unsigned* bar, unsigned x, unsigned& nloc, unsigned& nx) {
    const unsigned G = gridDim.x * gridDim.y * gridDim.z;
    unsigned sum, cnt, mine, sp = 0u;
    for (;;) {
        sum = 0u; cnt = 0u; mine = 0u;
#pragma unroll
        for (unsigned j = 0; j < 16; ++j) { const unsigned c = xb_ld(&bar[XB_XCNT(j)]); sum += c; cnt += (c > 0u) ? 1u : 0u; mine = (j == x) ? c : mine; }
        if (sum == G) break;
        __builtin_amdgcn_s_sleep(1);
        if ((++sp & 255u) == 0u) { if (xb_ld(&bar[XB_TMO])) break; if (sp > XB_SPIN_CAP) { atomicAdd(&bar[XB_TMO], 1u); break; } }
    }
    nloc = mine > 0u ? mine : 1u; nx = cnt > 0u ? cnt : 1u;
}
__device__ __forceinline__ void xcd_barrier(const XcdBarrier& b, int tid) {
    asm volatile("s_waitcnt vmcnt(0)" ::: "memory");
    __syncthreads();
    if (tid == 0) {
        unsigned* bar = b.bar;
        __builtin_amdgcn_s_waitcnt(0);
        unsigned nloc = b.st[0], nx = b.st[1];
        if (nloc == 0u) { xcd_barrier_complete(bar, b.x, nloc, nx); b.st[0] = nloc; b.st[1] = nx; }
        const unsigned old = xb_add(&bar[XB_XSUB(b.x)], 1u);
        const unsigned gen = old / nloc;
        if (old + 1u == (gen + 1u) * nloc) {
            __builtin_amdgcn_fence(__ATOMIC_RELEASE, "agent");
            asm volatile("s_waitcnt vmcnt(0)" ::: "memory");
            const unsigned og = xb_add(&bar[XB_TOP], 1u);
            const unsigned tg = og / nx;
            if (og + 1u == (tg + 1u) * nx) xb_add(&bar[XB_TOPGEN], 1u);
            else XB_SPIN(xb_ld(&bar[XB_TOPGEN]) == tg, bar);
            __builtin_amdgcn_fence(__ATOMIC_ACQUIRE, "agent");
            xb_add(&bar[XB_XGEN(b.x)], 1u);
            asm volatile("s_waitcnt vmcnt(0)" ::: "memory");
        } else {
            XB_SPIN(xb_ld(&bar[XB_XGEN(b.x)]) == gen, bar);
            __builtin_amdgcn_fence(__ATOMIC_ACQUIRE, "agent");
            asm volatile("s_waitcnt vmcnt(0)" ::: "memory");
        }
    }
    __syncthreads();
}

struct Args { const float* in[36]; float* out; unsigned char* ws; int ph_lo, ph_hi; };
enum { I_XP = 0, I_XS, I_CP, I_CS, I_SSM, I_SCONV, I_MC, I_MN, I_MM, I_LH, I_LCONV, I_ADAW, I_ADAB, I_N1W, I_N2W, I_WIN, I_SCW, I_SCB, I_DTB, I_ALOG, I_SSD_D, I_SNW,
       I_MIB, I_MFB, I_MNW, I_LCW, I_LCB, I_LWA, I_LBA, I_LWX, I_LBX, I_LLAM, I_WOUT, I_WUP, I_WDN, I_FNW };
struct Frame { LAS unsigned char* lds; int tid, lane, wave, G; };
typedef const __attribute__((address_space(4))) unsigned char* kargp_t;
__device__ __forceinline__ const float* INP(int i) { asm volatile("" : "+s"(i)); return *(const float* const __attribute__((address_space(4)))*)((kargp_t)__builtin_amdgcn_kernarg_segment_ptr() + 8 * i); }
__device__ __forceinline__ float* OUTP() { int o = 288; asm volatile("" : "+s"(o)); return *(float* const __attribute__((address_space(4)))*)((kargp_t)__builtin_amdgcn_kernarg_segment_ptr() + o); }
__device__ __forceinline__ unsigned char* WSP(size_t off) { int o = 296; asm volatile("" : "+s"(o)); unsigned char* w = *(unsigned char* const __attribute__((address_space(4)))*)((kargp_t)__builtin_amdgcn_kernarg_segment_ptr() + o); return w + off; }
static_assert(offsetof(Args, out) == 288 && offsetof(Args, ws) == 296, "kernarg layout");
#define P_CTL   ((unsigned*)WSP(WS_CTL))
#define P_WG    ((float*)WSP(WS_WG))
#define P_MOD   ((float*)WSP(WS_MOD))
#define P_WINT  ((bf16*)WSP(WS_WIN))
#define P_WOUTT ((bf16*)WSP(WS_WOUT))
#define P_WUPT  ((bf16*)WSP(WS_WUP))
#define P_WDNT  ((bf16*)WSP(WS_WDN))
#define P_GATES ((float*)WSP(WS_GATES))
#define P_SSQ   ((float*)WSP(WS_SSQ))
#define P_HN    ((bf16*)WSP(WS_HN))
#define P_XW    ((float*)WSP(WS_XW))
#define P_YCAT  ((bf16*)WSP(WS_YCAT))
#define P_YZ    ((float*)WSP(WS_YZ))
#define P_CIN   ((bf16*)WSP(WS_YZ))
#define P_NIN   ((float*)WSP(WS_YZ + 32 * MiB))
#define P_MLG   ((float*)WSP(WS_YZ + 33 * MiB))
#define P_BCA   ((bf16*)WSP(WS_YZ + 34 * MiB))
#define P_U     ((bf16*)WSP(WS_U))
#define P_HID   ((bf16*)WSP(WS_HID))

__device__ __forceinline__ void transpose_item(const float* W, int ldw, int ncs, bf16* WT, int K, int n0, int k0, LAS float* scr, int lane) {
    f32x4 v[8];
#pragma unroll
    for (int i = 0; i < 8; ++i) v[i] = *(const f32x4*)(W + (size_t)(k0 + 8 * i + (lane >> 3)) * ldw + ncs + 4 * (lane & 7));
#pragma unroll
    for (int i = 0; i < 8; ++i) { LAS float* s = scr + (8 * i + (lane >> 3)) * 33 + 4 * (lane & 7); s[0] = v[i].x; s[1] = v[i].y; s[2] = v[i].z; s[3] = v[i].w; }
    LDS_WAIT(); asm volatile("" ::: "memory");
    const int c = lane & 7;
#pragma unroll
    for (int j = 0; j < 4; ++j) { const int n = (lane >> 3) + 8 * j; const LAS float* s = scr + (8 * c) * 33 + n;
        v4u o; o.x = pk2(s[0 * 33], s[1 * 33]); o.y = pk2(s[2 * 33], s[3 * 33]); o.z = pk2(s[4 * 33], s[5 * 33]); o.w = pk2(s[6 * 33], s[7 * 33]);
        *(GAS v4u*)(WT + (size_t)(n0 + n) * K + k0 + 8 * c) = o; }
    LDS_WAIT(); asm volatile("" ::: "memory");
}
constexpr int CI_IN = 16 * 176, CI_OUT = 32 * 32, CI_UP = 16 * 128, CI_DN = 64 * 32, CI_L = CI_IN + CI_OUT + CI_UP + CI_DN, CONV_EARLY = CI_IN, CONV_ALL = DEPTH * CI_L;
__device__ __forceinline__ void convert_item(Frame& F, int it) {
    LAS float* scr = (LAS float*)(F.lds + F.wave * 16384);
    const int l = it / CI_L; int r = it % CI_L;
    if (r < CI_IN) { const int kb = r / 176, nb = r % 176, n0 = nb * 32, ncs = n0 + (n0 >= 2560 ? 16 : 0) + (n0 >= 4608 ? 8 : 0);
        transpose_item(INP(I_WIN) + (size_t)l * 1024 * IN_DIM, IN_DIM, ncs, P_WINT + (size_t)l * NU * 1024, 1024, n0, kb * 64, scr, F.lane); return; } r -= CI_IN;
    if (r < CI_OUT) { const int kb = r / 32, nb = r % 32; transpose_item(INP(I_WOUT) + (size_t)l * MIXW * DM, DM, nb * 32, P_WOUTT + (size_t)l * DM * MIXW, MIXW, nb * 32, kb * 64, scr, F.lane); return; } r -= CI_OUT;
    if (r < CI_UP) { const int kb = r / 128, nb = r % 128; transpose_item(INP(I_WUP) + (size_t)l * DM * DFF, DFF, nb * 32, P_WUPT + (size_t)l * DFF * DM, DM, nb * 32, kb * 64, scr, F.lane); return; } r -= CI_UP;
    { const int kb = r / 32, nb = r % 32; transpose_item(INP(I_WDN) + (size_t)l * DFF * DM, DM, nb * 32, P_WDNT + (size_t)l * DM * DFF, DFF, nb * 32, kb * 64, scr, F.lane); }
}
__device__ __forceinline__ void p0_prologue(Frame& F) {
    const float* c_p = INP(I_CP); const float* c_s = INP(I_CS); const float* ada_w = INP(I_ADAW); const float* ada_b = INP(I_ADAB);
    constexpr int ASTR = 2064;
    static_assert(2 * 32 * ASTR <= MISC_OFF && RING_BYTES + 2048 <= MISC_OFF, "mod A images / GEMM rs table fit below MISC");
    LAS unsigned char* ahi = F.lds; LAS unsigned char* alo = F.lds + 32 * ASTR;
    for (int it = blockIdx.x; it < DEPTH * 5 * 24; it += F.G) {
        const int rb = it % 5, cg = (it / 5) % 24, l = it / 120;
        for (int idx = F.tid; idx < 32 * 512; idx += NTHR) { const int rr = idx >> 9, k = 2 * (idx & 511), r = rb * 32 + rr;
            const float* cp = r < NB_P ? c_p + r * 1024 + k : c_s + (r - NB_P) * 1024 + k; float v0 = 0.f, v1 = 0.f;
            if (r < NB_P + NB_S) { v0 = siluf_(cp[0]); v1 = siluf_(cp[1]); }
            const unsigned h2 = pk2(v0, v1); *(LAS unsigned*)(ahi + rr * ASTR + k * 2) = h2; *(LAS unsigned*)(alo + rr * ASTR + k * 2) = pk2(v0 - lo_bf(h2), v1 - hi_bf(h2)); }
        __syncthreads();
        const int j0 = cg * 256 + F.wave * 32; const float* wl = ada_w + (size_t)l * 1024 * MODLD + j0 + (F.lane & 31) + (size_t)(8 * (F.lane >> 5)) * MODLD;
        f32x16 acc; for (int r = 0; r < 16; ++r) acc[r] = 0.f;
        const int aoff = (F.lane & 31) * ASTR + (F.lane >> 5) * 16;
#pragma unroll 4
        for (int ks = 0; ks < 64; ++ks) {
            float wv[8];
#pragma unroll
            for (int jj = 0; jj < 8; ++jj) wv[jj] = wl[(size_t)(ks * 16 + jj) * MODLD];
            const bf16x8 ah = *(const LAS bf16x8*)(ahi + aoff + ks * 32), al = *(const LAS bf16x8*)(alo + aoff + ks * 32);
            v4u bh, bl;
#pragma unroll
            for (int e = 0; e < 4; ++e) { const unsigned h2 = pk2(wv[2 * e], wv[2 * e + 1]); bh[e] = h2; bl[e] = pk2(wv[2 * e] - lo_bf(h2), wv[2 * e + 1] - hi_bf(h2)); }
            const bf16x8 bhf = __builtin_bit_cast(bf16x8, bh), blf = __builtin_bit_cast(bf16x8, bl);
            acc = __builtin_amdgcn_mfma_f32_32x32x16_bf16(ah, bhf, acc, 0, 0, 0); acc = __builtin_amdgcn_mfma_f32_32x32x16_bf16(al, bhf, acc, 0, 0, 0); acc = __builtin_amdgcn_mfma_f32_32x32x16_bf16(ah, blf, acc, 0, 0, 0); }
        const int col = j0 + (F.lane & 31); const float bb = ada_b[l * MODLD + col];
#pragma unroll
        for (int r = 0; r < 16; ++r) { const int row = rb * 32 + (r & 3) + 8 * (r >> 2) + 4 * (F.lane >> 5); P_MOD[((size_t)l * MODROWS + row) * MODLD + col] = acc[r] + bb; }
        __syncthreads();
    }
    { const float* w_in = INP(I_WIN);
      for (int idx = blockIdx.x * NTHR + F.tid; idx < DEPTH * NG * 1024; idx += F.G * NTHR) { const int k = idx & 1023, j = (idx >> 10) % NG, l = idx / (NG * 1024);
          const int col = j < 16 ? 2560 + j : 4624 + (j - 16); P_WG[idx] = w_in[((size_t)l * 1024 + k) * IN_DIM + col]; } }
    for (int it = blockIdx.x * NWAVES + F.wave; it < CONV_EARLY; it += F.G * NWAVES) convert_item(F, it);
}

template <bool GATESP>
__device__ __forceinline__ void norm_phase(Frame& F, int l, int which) {
    LAS float* wg = (LAS float*)F.lds;
    if (GATESP) { for (int i = F.tid; i < NG * 1024 / 4; i += NTHR) ((LAS f32x4*)wg)[i] = ((const f32x4*)(P_WG + (size_t)l * NG * 1024))[i]; __syncthreads(); }
    const int gw = blockIdx.x * NWAVES + F.wave, NGW = F.G * NWAVES;
    const float* nwp = (which == 1 ? INP(I_N1W) : INP(I_N2W)) + l * DM;
    f32x4 nw4[4];
#pragma unroll
    for (int j = 0; j < 4; ++j) nw4[j] = *(const f32x4*)(nwp + 4 * F.lane + 256 * j);
    constexpr int RPW = GATESP ? 2 : 1;
    const bool first = (which == 1 && l == 0);
    constexpr bool PFMOD = !GATESP;
    f32x4 xn[RPW][4], shn[RPW][4], scn[RPW][4];
    auto load_mod = [&](int row0) {
#pragma unroll
        for (int rr = 0; rr < RPW; ++rr) { const float* mrow = P_MOD + ((size_t)l * MODROWS + modrow(row0 + rr)) * MODLD + (which == 1 ? 0 : 3072);
#pragma unroll
            for (int j = 0; j < 4; ++j) { shn[rr][j] = *(const f32x4*)(mrow + 4 * F.lane + 256 * j); scn[rr][j] = *(const f32x4*)(mrow + 1024 + 4 * F.lane + 256 * j); } }
    };
    auto load_rows = [&](int row0) {
#pragma unroll
        for (int rr = 0; rr < RPW; ++rr) { const int row = row0 + rr;
            const float* xrow = first ? (row < MP ? INP(I_XP) + (size_t)row * DM : INP(I_XS) + (size_t)(row - MP) * DM) : P_XW + (size_t)row * DM;
#pragma unroll
            for (int j = 0; j < 4; ++j) xn[rr][j] = *((const f32x4*)xrow + F.lane + 64 * j); }
        if (PFMOD) load_mod(row0);
    };
    if (gw * RPW < MT) load_rows(gw * RPW);
    for (int row0 = gw * RPW; row0 < MT; row0 += NGW * RPW) {
        f32x4 va[4], vb[4];
        f32x4 xv[RPW][4], shv[RPW][4], scv[RPW][4];
        if (!PFMOD) load_mod(row0);
#pragma unroll
        for (int rr = 0; rr < RPW; ++rr)
#pragma unroll
            for (int j = 0; j < 4; ++j) { xv[rr][j] = xn[rr][j]; shv[rr][j] = shn[rr][j]; scv[rr][j] = scn[rr][j]; }
        if (row0 + NGW * RPW < MT) load_rows(row0 + NGW * RPW);
#pragma unroll
        for (int rr = 0; rr < RPW; ++rr) { const int row = row0 + rr; f32x4 v[4]; float s = 0.f;
#pragma unroll
            for (int j = 0; j < 4; ++j) { v[j] = xv[rr][j]; s += (v[j].x * v[j].x + v[j].y * v[j].y) + (v[j].z * v[j].z + v[j].w * v[j].w); }
            const float rstd = rsqrtf(wave_sum(s) * (1.f / DM) + EPS);
            if (first && row >= MP) { f32x4* xo = (f32x4*)(P_XW + (size_t)row * DM) + F.lane;
#pragma unroll
                for (int j = 0; j < 4; ++j) xo[64 * j] = v[j]; }
            unsigned long long* o8 = (unsigned long long*)(P_HN + (size_t)row * DM) + F.lane;
#pragma unroll
            for (int j = 0; j < 4; ++j) { v[j] = v[j] * rstd * nw4[j] * (scv[rr][j] + 1.f) + shv[rr][j];
                o8[64 * j] = (unsigned long long)pk2(v[j].x, v[j].y) | ((unsigned long long)pk2(v[j].z, v[j].w) << 32);
                if (rr == 0) va[j] = v[j]; else vb[j] = v[j]; } }
        if (GATESP) {
            const bool b5 = F.lane & 32, b4 = F.lane & 16, b3 = F.lane & 8, b2 = F.lane & 4;
            float p[NG];
#pragma unroll
            for (int g = 0; g < NG; ++g) { float a0 = 0.f, a1 = 0.f;
#pragma unroll
                for (int j = 0; j < 4; ++j) { const f32x4 w4 = *(const LAS f32x4*)(wg + g * 1024 + 4 * F.lane + 256 * j);
                    a0 += (va[j].x * w4.x + va[j].y * w4.y) + (va[j].z * w4.z + va[j].w * w4.w); a1 += (vb[j].x * w4.x + vb[j].y * w4.y) + (vb[j].z * w4.z + vb[j].w * w4.w); }
                const float send = b5 ? a0 : a1, keep = b5 ? a1 : a0; p[g] = keep + __shfl_xor(send, 32); }
            float q[12], r6[6], s3[3];
#pragma unroll
            for (int g = 0; g < 12; ++g) { const float send = b4 ? p[g] : p[g + 12], keep = b4 ? p[g + 12] : p[g]; q[g] = keep + __shfl_xor(send, 16); }
#pragma unroll
            for (int g = 0; g < 6; ++g) { const float send = b3 ? q[g] : q[g + 6], keep = b3 ? q[g + 6] : q[g]; r6[g] = keep + __shfl_xor(send, 8); }
#pragma unroll
            for (int g = 0; g < 3; ++g) { const float send = b2 ? r6[g] : r6[g + 3], keep = b2 ? r6[g + 3] : r6[g]; float s = keep + __shfl_xor(send, 4);
                s += __shfl_xor(s, 2); s += __shfl_xor(s, 1); s3[g] = s; }
            if ((F.lane & 3) == 0) { float* go = P_GATES + (size_t)(row0 + (b5 ? 1 : 0)) * NG + (b4 ? 12 : 0) + (b3 ? 6 : 0) + (b2 ? 3 : 0); go[0] = s3[0]; go[1] = s3[1]; go[2] = s3[2]; }
        }
    }
}
__device__ __forceinline__ void final_norm_phase(Frame& F) {
    const int gw = blockIdx.x * NWAVES + F.wave, NGW = F.G * NWAVES; const float* nw = INP(I_FNW);
    f32x4 nw4[4], xn[4];
#pragma unroll
    for (int j = 0; j < 4; ++j) nw4[j] = *(const f32x4*)(nw + 4 * F.lane + 256 * j);
    if (gw < MT) {
#pragma unroll
        for (int j = 0; j < 4; ++j) xn[j] = *((const f32x4*)(P_XW + (size_t)gw * DM) + F.lane + 64 * j); }
    for (int row = gw; row < MT; row += NGW) {
        f32x4* o = (f32x4*)(OUTP() + (size_t)row * DM) + F.lane;
        f32x4 v[4]; float s = 0.f;
#pragma unroll
        for (int j = 0; j < 4; ++j) { v[j] = xn[j]; s += (v[j].x * v[j].x + v[j].y * v[j].y) + (v[j].z * v[j].z + v[j].w * v[j].w); }
        if (row + NGW < MT) {
#pragma unroll
            for (int j = 0; j < 4; ++j) xn[j] = *((const f32x4*)(P_XW + (size_t)(row + NGW) * DM) + F.lane + 64 * j); }
        const float rstd = rsqrtf(wave_sum(s) * (1.f / DM) + EPS);
#pragma unroll
        for (int j = 0; j < 4; ++j) o[64 * j] = v[j] * rstd * nw4[j];
    }
}
__device__ __forceinline__ void yscale_phase(Frame& F, int l) {
    const int gw = blockIdx.x * NWAVES + F.wave, NGW = F.G * NWAVES; const float* nw = INP(I_SNW) + l * 1024;
    for (int row = gw; row < MT; row += NGW) {
        float s = P_SSQ[(size_t)row * 16 + (F.lane & 15)];
        s += __shfl_xor(s, 1); s += __shfl_xor(s, 2); s += __shfl_xor(s, 4); s += __shfl_xor(s, 8);
        const float rs = rsqrtf(s * (1.f / 1024.f) + EPS);
        const f32x4* yr = (const f32x4*)(P_YZ + (size_t)row * 1024) + F.lane; unsigned long long* o8 = (unsigned long long*)(P_YCAT + (size_t)row * MIXW) + F.lane;
#pragma unroll
        for (int j = 0; j < 4; ++j) { const f32x4 w4 = *(const f32x4*)(nw + 4 * F.lane + 256 * j); const f32x4 y = yr[64 * j] * rs * w4;
            o8[64 * j] = (unsigned long long)pk2(y.x, y.y) | ((unsigned long long)pk2(y.z, y.w) << 32); }
    }
}

__device__ __forceinline__ void ssd_item(Frame& F, int l, int grp, int b, int h) {
    const int T = grp ? SEQ_S : SEQ_P, rowbase = grp ? MP + b * SEQ_S : b * SEQ_P, Bn = grp ? NB_S : NB_P, g = h >> 3;
    const int tid = F.tid, p = tid >> 3, nq = tid & 7, n0 = nq * 16;
    LAS float* xs = (LAS float*)F.lds; LAS float* Bm = xs + 512; LAS float* Cm = Bm + 1024; LAS float* dts = Cm + 1024; LAS float* dAs = dts + 8; LAS float* ybuf = dAs + 8;
    float S[16];
    if (grp) { const float* sp = INP(I_SSM) + ((((size_t)l * NB_S + b) * 16 + h) * 64 + p) * 128 + n0;
#pragma unroll
        for (int j = 0; j < 16; ++j) S[j] = sp[j]; }
    else {
#pragma unroll
        for (int j = 0; j < 16; ++j) S[j] = 0.f; }
    const float a = -fexp(INP(I_ALOG)[l * 16 + h]), dtb = INP(I_DTB)[l * 16 + h], Dh = INP(I_SSD_D)[l * 16 + h];
    const float* cw = INP(I_SCW) + (size_t)l * 4 * CONVD; const float* cb = INP(I_SCB) + (size_t)l * CONVD;
    const float* hist = INP(I_SCONV) + ((size_t)l * NB_S + b) * 3 * CONVD;
    for (int t0 = 0; t0 < T; t0 += 8) {
#pragma unroll
        for (int j5 = 0; j5 < 5; ++j5) { const int idx = tid + NTHR * j5, ci = idx % 320, tt = idx / 320, t = t0 + tt;
            const int c = ci < 64 ? h * 64 + ci : (ci < 192 ? 1024 + g * 128 + (ci - 64) : 1280 + g * 128 + (ci - 192));
            float acc = cb[c];
#pragma unroll
            for (int j = 0; j < 4; ++j) { const int tp = t - 3 + j; float val;
                if (tp >= 0) val = bf2f(P_U[(size_t)(rowbase + tp) * NU + UC_XBC + c]); else val = grp ? hist[(tp + 3) * CONVD + c] : 0.f;
                acc += cw[j * CONVD + c] * val; }
            const float act = siluf_(acc);
            if (ci < 64) xs[tt * 64 + ci] = act; else if (ci < 192) Bm[tt * 128 + ci - 64] = act; else Cm[tt * 128 + ci - 192] = act; }
        if (tid < 8) { const float dt = softplusf_(P_GATES[(size_t)(rowbase + t0 + tid) * NG + h] + dtb); dts[tid] = dt; dAs[tid] = fexp(dt * a); }
        __syncthreads();
        for (int tt = 0; tt < 8; ++tt) {
            const float dt = dts[tt], dA = dAs[tt], xv = xs[tt * 64 + p], dx = dt * xv; float part = 0.f;
#pragma unroll
            for (int j = 0; j < 16; ++j) { S[j] = dA * S[j] + dx * Bm[tt * 128 + n0 + j]; part += Cm[tt * 128 + n0 + j] * S[j]; }
            part += __shfl_xor(part, 1); part += __shfl_xor(part, 2); part += __shfl_xor(part, 4);
            if (nq == 0) { const size_t row = (size_t)(rowbase + t0 + tt); const float y = part + Dh * xv, z = bf2f(P_U[row * NU + UC_Z + h * 64 + p]), yz = y * siluf_(z);
                P_YZ[row * 1024 + h * 64 + p] = yz; ybuf[tt * 64 + p] = yz; }
        }
        __syncthreads();
        if (tid < 8) { float s = 0.f; for (int q = 0; q < 64; ++q) { const float y = ybuf[tid * 64 + q]; s += y * y; } P_SSQ[(size_t)(rowbase + t0 + tid) * 16 + h] = s; }
    }
    { float* so = OUTP() + (grp ? O_S_SSM : O_P_SSM) + ((((size_t)l * Bn + b) * 16 + h) * 64 + p) * 128 + n0;
#pragma unroll
      for (int j = 0; j < 16; ++j) so[j] = S[j]; }
    if (h == 0) { float* co = OUTP() + (grp ? O_S_SCONV : O_P_SCONV) + ((size_t)l * Bn + b) * 3 * CONVD;
        for (int idx = tid; idx < 3 * CONVD; idx += NTHR) { const int j = idx / CONVD, c = idx % CONVD; co[idx] = bf2f(P_U[(size_t)(rowbase + T - 3 + j) * NU + UC_XBC + c]); } }
    __syncthreads();
}
__device__ __forceinline__ void mlstm_item(Frame& F, int l, int grp, int b, int h) {
    const int T = grp ? SEQ_S : SEQ_P, rowbase = grp ? MP + b * SEQ_S : b * SEQ_P, Bn = grp ? NB_S : NB_P;
    const int tid = F.tid, v = tid >> 2, dq = tid & 3, d0 = dq * 32;
    LAS float* q = (LAS float*)F.lds; LAS float* k = q + 1024; LAS float* vv = k + 1024; LAS float* oo = vv + 1024; LAS float* igs = oo + 1024; LAS float* lfs = igs + 8; LAS float* hbuf = lfs + 8;
    float c[32], nn[32], m;
    if (grp) { const float* cp = INP(I_MC) + ((((size_t)l * NB_S + b) * 4 + h) * 128 + v) * 128 + d0; const float* np = INP(I_MN) + (((size_t)l * NB_S + b) * 4 + h) * 128 + d0;
#pragma unroll
        for (int j = 0; j < 32; ++j) { c[j] = cp[j]; nn[j] = np[j]; }
        m = INP(I_MM)[((size_t)l * NB_S + b) * 4 + h]; }
    else {
#pragma unroll
        for (int j = 0; j < 32; ++j) { c[j] = 0.f; nn[j] = 0.f; }
        m = 0.f; }
    const float ib = INP(I_MIB)[l * 4 + h], fb = INP(I_MFB)[l * 4 + h];
    const float* nw = INP(I_MNW) + l * 512 + h * 128;
    for (int t0 = 0; t0 < T; t0 += 8) {
#pragma unroll
        for (int j8 = 0; j8 < 8; ++j8) { const int idx = tid + NTHR * j8, arr = idx >> 10, tt = (idx >> 7) & 7, d = idx & 127;
            float val = bf2f(P_U[(size_t)(rowbase + t0 + tt) * NU + UC_Q + arr * 512 + h * 128 + d]); if (arr == 1) val *= 0.08838834764831845f;
            q[idx] = val; }
        if (tid < 8) { const size_t row = (size_t)(rowbase + t0 + tid); igs[tid] = P_GATES[row * NG + 16 + h] + ib; lfs[tid] = -softplusf_(-(P_GATES[row * NG + 20 + h] + fb)); }
        __syncthreads();
        for (int tt = 0; tt < 8; ++tt) {
            const float igv = igs[tt], lfv = lfs[tt], mn = fmaxf(lfv + m, igv), al = fexp(lfv + m - mn), be = fexp(igv - mn); m = mn;
            const float bv = be * vv[tt * 128 + v]; float pn = 0.f, pd = 0.f;
#pragma unroll
            for (int j = 0; j < 32; ++j) { const float kj = k[tt * 128 + d0 + j], qj = q[tt * 128 + d0 + j]; c[j] = al * c[j] + bv * kj; nn[j] = al * nn[j] + be * kj; pn += c[j] * qj; pd += nn[j] * qj; }
            pn += __shfl_xor(pn, 1); pn += __shfl_xor(pn, 2); pd += __shfl_xor(pd, 1); pd += __shfl_xor(pd, 2);
            if (dq == 0) hbuf[tt * 128 + v] = pn / fmaxf(fabsf(pd), fexp(-m));
        }
        __syncthreads();
        { const int tt = F.wave; const size_t row = (size_t)(rowbase + t0 + tt); const float h0 = hbuf[tt * 128 + F.lane], h1 = hbuf[tt * 128 + 64 + F.lane];
          const float rstd = rsqrtf(wave_sum(h0 * h0 + h1 * h1) * (1.f / 128.f) + EPS);
          bf16* yo = P_YCAT + row * MIXW + 1024 + h * 128;
          yo[F.lane] = (bf16)f2bf(h0 * rstd * nw[F.lane] * sigmoidf_(oo[tt * 128 + F.lane])); yo[64 + F.lane] = (bf16)f2bf(h1 * rstd * nw[64 + F.lane] * sigmoidf_(oo[tt * 128 + 64 + F.lane])); }
        __syncthreads();
    }
    { float* co = OUTP() + (grp ? O_S_MC : O_P_MC) + ((((size_t)l * Bn + b) * 4 + h) * 128 + v) * 128 + d0;
#pragma unroll
      for (int j = 0; j < 32; ++j) co[j] = c[j];
      if (v == 0) { float* no = OUTP() + (grp ? O_S_MN : O_P_MN) + (((size_t)l * Bn + b) * 4 + h) * 128 + d0;
#pragma unroll
          for (int j = 0; j < 32; ++j) no[j] = nn[j]; }
      if (tid == 0) OUTP()[(grp ? O_S_MM : O_P_MM) + ((size_t)l * Bn + b) * 4 + h] = m; }
    __syncthreads();
}
__device__ __forceinline__ void lru_item(Frame& F, int l, int grp, int b, int kb) {
    const int T = grp ? SEQ_S : SEQ_P, rowbase = grp ? MP + b * SEQ_S : b * SEQ_P, Bn = grp ? NB_S : NB_P;
    const int tid = F.tid, d = tid & 127, tg = tid >> 7, ch = kb * 128 + d;
    LAS float* xc = (LAS float*)F.lds; LAS float* as = xc + 1024; LAS float* bs = as + 1024;
    float hreg = grp ? INP(I_LH)[((size_t)l * NB_S + b) * LRUW + ch] : 0.f;
    const float spl = softplusf_(-INP(I_LLAM)[l * LRUW + ch]), cb = INP(I_LCB)[l * LRUW + ch], ba = INP(I_LBA)[l * LRUW + ch], bx = INP(I_LBX)[l * LRUW + ch];
    float cw[4];
#pragma unroll
    for (int j = 0; j < 4; ++j) cw[j] = INP(I_LCW)[((size_t)l * 4 + j) * LRUW + ch];
    const float* hist = INP(I_LCONV) + ((size_t)l * NB_S + b) * 3 * LRUW;
    const float* wa = INP(I_LWA) + ((size_t)l * 4 + kb) * 128 * 128 + d; const float* wx = INP(I_LWX) + ((size_t)l * 4 + kb) * 128 * 128 + d;
    for (int t0 = 0; t0 < T; t0 += 8) {
#pragma unroll
        for (int e = 0; e < 2; ++e) { const int tt = tg * 2 + e, t = t0 + tt; float acc = cb;
#pragma unroll
            for (int j = 0; j < 4; ++j) { const int tp = t - 3 + j; float val;
                if (tp >= 0) val = bf2f(P_U[(size_t)(rowbase + tp) * NU + UC_XR + ch]); else val = grp ? hist[(tp + 3) * LRUW + ch] : 0.f;
                acc += cw[j] * val; }
            xc[tt * 128 + d] = acc; }
        __syncthreads();
        float ra0 = ba, ra1 = ba, ri0 = bx, ri1 = bx;
#pragma unroll 4
        for (int cc = 0; cc < 128; ++cc) { const float a_ = wa[cc * 128], x_ = wx[cc * 128], x0 = xc[(tg * 2) * 128 + cc], x1 = xc[(tg * 2 + 1) * 128 + cc];
            ra0 += x0 * a_; ra1 += x1 * a_; ri0 += x0 * x_; ri1 += x1 * x_; }
#pragma unroll
        for (int e = 0; e < 2; ++e) { const int tt = tg * 2 + e; const float r = sigmoidf_(e ? ra1 : ra0), ii = sigmoidf_(e ? ri1 : ri0), la = -8.f * r * spl;
            float mult = sqrtf(-expm1f(2.f * la)); if (!grp && t0 + tt == 0) mult = 1.f;
            as[tt * 128 + d] = fexp(la); bs[tt * 128 + d] = mult * ii * xc[tt * 128 + d]; }
        __syncthreads();
        if (tid < 128) {
            for (int tt = 0; tt < 8; ++tt) { hreg = as[tt * 128 + d] * hreg + bs[tt * 128 + d]; const size_t row = (size_t)(rowbase + t0 + tt);
                P_YCAT[row * MIXW + 1536 + ch] = (bf16)f2bf(hreg * gelu_tanhf_(bf2f(P_U[row * NU + UC_GR + ch]))); } }
    }
    if (tid < 128) OUTP()[(grp ? O_S_LH : O_P_LH) + ((size_t)l * Bn + b) * LRUW + ch] = hreg;
    { float* co = OUTP() + (grp ? O_S_LCONV : O_P_LCONV) + ((size_t)l * Bn + b) * 3 * LRUW;
      for (int idx = tid; idx < 3 * 128; idx += NTHR) { const int j = idx / 128, dd = idx % 128; co[j * LRUW + kb * 128 + dd] = bf2f(P_U[(size_t)(rowbase + T - 3 + j) * NU + UC_XR + kb * 128 + dd]); } }
    __syncthreads();
}

__device__ __forceinline__ int crow32(int r, int hi) { return (r & 3) + 8 * (r >> 2) + 4 * hi; }
__device__ __forceinline__ bf16x8 frag16(LAS const unsigned char* base, int stride, int r0, int kk, int lane) { return *(const LAS bf16x8*)(base + (r0 + (lane & 15)) * stride + kk * 64 + (lane >> 4) * 16); }
__device__ __forceinline__ bf16x8 frag32(LAS const unsigned char* base, int stride, int r0, int kk, int lane) { return *(const LAS bf16x8*)(base + (r0 + (lane & 31)) * stride + kk * 32 + (lane >> 5) * 16); }

typedef __amdgpu_buffer_rsrc_t rsrc_t;
__device__ __forceinline__ rsrc_t mk_rsrc(const void* p, unsigned bytes) { return __builtin_amdgcn_make_buffer_rsrc((void*)p, (short)0, (int)bytes, 0x00020000); }
#define U_RSRC() mk_rsrc((const unsigned char*)P_U - 3 * NU * 2, (unsigned)((MT + 3) * (size_t)NU * 2))
constexpr int ROWB = NU * 2;

__device__ __forceinline__ void ssd_prompt_item(Frame& F, int l, int b, int h) {
    constexpr int L = 64, NCH = SEQ_P / L;
    constexpr int CS = 0, BS = 17408, BST = 34816, XST = 53248, MS = 62464, SBF = 71680, GT = 89088, SSQP = GT + NCH * 1024, ZS = SSQP + 512;
    const int tid = F.tid, lane = F.lane, w = F.wave, g = h >> 3, rowbase = b * SEQ_P;
    LAS unsigned char* lds = F.lds;
    const bf16* U = P_U; const float* gates = P_GATES; float* SSQ = P_SSQ;
    const float a = -fexp(INP(I_ALOG)[l * 16 + h]), dtb = INP(I_DTB)[l * 16 + h], Dh = INP(I_SSD_D)[l * 16 + h];
    const int px = tid & 31, gx = tid >> 5, pb = tid & 63, gb = tid >> 6;
    const int colx = UC_XBC + h * 64 + 2 * px;
    float cwx[4][2], cbx[2];
    { const float* cw = INP(I_SCW) + (size_t)l * 4 * CONVD; const float* cb = INP(I_SCB) + (size_t)l * CONVD;
#pragma unroll
      for (int j = 0; j < 4; ++j)
#pragma unroll
          for (int e = 0; e < 2; ++e) cwx[j][e] = cw[j * CONVD + colx - UC_XBC + e];
#pragma unroll
      for (int e = 0; e < 2; ++e) cbx[e] = cb[colx - UC_XBC + e]; }
    struct Pre { unsigned rx[7], rb[8], rc[8]; v4u rz; };
    Pre PA, PB;
    const rsrc_t ru = U_RSRC(); const rsrc_t ryz = mk_rsrc(P_YCAT, (unsigned)((size_t)MT * MIXW * 2)); const rsrc_t rbca = mk_rsrc(P_BCA, (unsigned)((size_t)MP * 512 * 2));
    const int voffbc = (8 * gb * 512 + g * 128 + 2 * pb) * 2;
    const int voffx = (4 * gx * NU + colx) * 2, voffzt = (((tid >> 3) + 3) * NU + UC_Z + h * 64 + 8 * (tid & 7)) * 2;
    auto prefetch = [&](int c, Pre& P) {
        const int sb = (rowbase + c * L) * ROWB;
#pragma unroll
        for (int i = 0; i < 7; ++i) { P.rx[i] = __builtin_amdgcn_raw_buffer_load_b32(ru, voffx, sb + i * ROWB, 0); if (c == 0 && 4 * gx + i < 3) P.rx[i] = 0u; }
#pragma unroll
        for (int i = 0; i < 8; ++i) { P.rb[i] = __builtin_amdgcn_raw_buffer_load_b32(rbca, voffbc, (rowbase + c * L + i) * 1024, 0); P.rc[i] = __builtin_amdgcn_raw_buffer_load_b32(rbca, voffbc + 512, (rowbase + c * L + i) * 1024, 0); }
        P.rz = __builtin_amdgcn_raw_buffer_load_b128(ru, voffzt, sb, 0);
    };
    for (int c = w; c < NCH; c += NWAVES) {
        LAS float* gtw = (LAS float*)(lds + GT) + c * 256;
        const float dt = softplusf_(gates[(size_t)(rowbase + c * L + lane) * NG + h] + dtb); float x = dt * a;
#pragma unroll
        for (int o = 1; o < 64; o <<= 1) { const float y = __shfl_up(x, o); if (lane >= o) x += y; }
        const float cl = __shfl(x, 63);
        gtw[lane] = x; gtw[64 + lane] = dt; gtw[128 + lane] = fexp(cl - x) * dt; gtw[192 + lane] = fexp(x);
    }
    f32x16 S; for (int r = 0; r < 16; ++r) S[r] = 0.f;
    for (int i = tid; i < 17408 / 4; i += NTHR) ((LAS unsigned*)(lds + SBF))[i] = 0u;
    prefetch(0, PA); prefetch(1, PB);
    LBAR();
    const int ti = w >> 1, pj0 = 2 * (w & 1), pi = w >> 2, ni = w & 3, q4 = lane >> 4, c16 = lane & 15;
    const int voffz = ((ti * 16 + 4 * q4 + 3) * NU + UC_Z + h * 64 + pj0 * 16 + c16) * 2, voffy = ((ti * 16 + 4 * q4) * MIXW + h * 64 + pj0 * 16 + c16) * 2;
    const float nw0 = INP(I_SNW)[l * 1024 + h * 64 + pj0 * 16 + c16], nw1 = INP(I_SNW)[l * 1024 + h * 64 + (pj0 + 1) * 16 + c16];
    auto step = [&](int c, Pre& P) {
        const int t0 = c * L; const LAS float* gt = (const LAS float*)(lds + GT) + c * 256;
        { float o0[4], o1[4];
#pragma unroll
          for (int i = 0; i < 4; ++i) { float a0 = cbx[0], a1 = cbx[1];
#pragma unroll
              for (int j = 0; j < 4; ++j) { a0 += cwx[j][0] * lo_bf(P.rx[i + j]); a1 += cwx[j][1] * hi_bf(P.rx[i + j]); }
              o0[i] = siluf_(a0); o1[i] = siluf_(a1); }
          *(LAS v2u*)(lds + XST + (2 * px) * 144 + 8 * gx) = (v2u){pk2(o0[0], o0[1]), pk2(o0[2], o0[3])};
          *(LAS v2u*)(lds + XST + (2 * px + 1) * 144 + 8 * gx) = (v2u){pk2(o1[0], o1[1]), pk2(o1[2], o1[3])}; }
        { float o0[8], o1[8];
#pragma unroll
          for (int i = 0; i < 8; ++i) { *(LAS unsigned*)(lds + BS + (8 * gb + i) * 272 + 4 * pb) = P.rb[i]; *(LAS unsigned*)(lds + CS + (8 * gb + i) * 272 + 4 * pb) = P.rc[i];
              const float ws = gt[128 + 8 * gb + i]; o0[i] = lo_bf(P.rb[i]) * ws; o1[i] = hi_bf(P.rb[i]) * ws; }
          *(LAS v4u*)(lds + BST + (2 * pb) * 144 + 16 * gb) = (v4u){pk2(o0[0], o0[1]), pk2(o0[2], o0[3]), pk2(o0[4], o0[5]), pk2(o0[6], o0[7])};
          *(LAS v4u*)(lds + BST + (2 * pb + 1) * 144 + 16 * gb) = (v4u){pk2(o1[0], o1[1]), pk2(o1[2], o1[3]), pk2(o1[4], o1[5]), pk2(o1[6], o1[7])}; }
        *(LAS v4u*)(lds + ZS + (tid >> 3) * 144 + (tid & 7) * 16) = P.rz;
        if (c + 2 < NCH) prefetch(c + 2, P);
        LBAR();
        { f32x4 ga[2] = {{0.f, 0.f, 0.f, 0.f}, {0.f, 0.f, 0.f, 0.f}};
#pragma unroll
          for (int kk = 0; kk < 4; ++kk) { const bf16x8 af = frag16(lds + CS, 272, ti * 16, kk, lane);
#pragma unroll
              for (int jj = 0; jj < 2; ++jj) { const bf16x8 bfr = frag16(lds + BS, 272, (pj0 + jj) * 16, kk, lane); ga[jj] = __builtin_amdgcn_mfma_f32_16x16x32_bf16(af, bfr, ga[jj], 0, 0, 0); } }
          float ct[4];
#pragma unroll
          for (int r = 0; r < 4; ++r) ct[r] = gt[ti * 16 + 4 * q4 + r];
#pragma unroll
          for (int jj = 0; jj < 2; ++jj) { const int s = (pj0 + jj) * 16 + c16; const float cs = gt[s], ds = gt[64 + s];
#pragma unroll
              for (int r = 0; r < 4; ++r) { const int t = ti * 16 + 4 * q4 + r; const float v = s <= t ? ga[jj][r] * fexp(ct[r] - cs) * ds : 0.f;
                  *(LAS bf16*)(lds + MS + t * 144 + s * 2) = (bf16)f2bf(v); } } }
        LBAR();
        { f32x4 ya[2] = {{0.f, 0.f, 0.f, 0.f}, {0.f, 0.f, 0.f, 0.f}};
#pragma unroll
          for (int kk = 0; kk < 4; ++kk) { const bf16x8 af = frag16(lds + CS, 272, ti * 16, kk, lane);
#pragma unroll
              for (int jj = 0; jj < 2; ++jj) { const bf16x8 bfr = frag16(lds + SBF, 272, (pj0 + jj) * 16, kk, lane); ya[jj] = __builtin_amdgcn_mfma_f32_16x16x32_bf16(af, bfr, ya[jj], 0, 0, 0); } }
#pragma unroll
          for (int r = 0; r < 4; ++r) { const float e = gt[192 + ti * 16 + 4 * q4 + r]; ya[0][r] *= e; ya[1][r] *= e; }
#pragma unroll
          for (int kk = 0; kk < 2; ++kk) { const bf16x8 af = frag16(lds + MS, 144, ti * 16, kk, lane);
#pragma unroll
              for (int jj = 0; jj < 2; ++jj) { const bf16x8 bfr = frag16(lds + XST, 144, (pj0 + jj) * 16, kk, lane); ya[jj] = __builtin_amdgcn_mfma_f32_16x16x32_bf16(af, bfr, ya[jj], 0, 0, 0); } }
          float sq[4] = {0.f, 0.f, 0.f, 0.f};
#pragma unroll
          for (int jj = 0; jj < 2; ++jj) { const int p = (pj0 + jj) * 16 + c16; const v2u xv = *(const LAS v2u*)(lds + XST + p * 144 + (ti * 16 + 4 * q4) * 2);
              const float xs4[4] = {lo_bf(xv.x), hi_bf(xv.x), lo_bf(xv.y), hi_bf(xv.y)};
#pragma unroll
              for (int r = 0; r < 4; ++r) { const float y = ya[jj][r] + Dh * xs4[r], yz = y * siluf_(bf2f(*(const LAS bf16*)(lds + ZS + (ti * 16 + 4 * q4 + r) * 144 + p * 2)));
                  __builtin_amdgcn_raw_buffer_store_b16((bf16)f2bf(yz * (jj ? nw1 : nw0)), ryz, voffy + jj * 32, (rowbase + t0 + r) * (MIXW * 2), 0); sq[r] += yz * yz; } }
#pragma unroll
          for (int r = 0; r < 4; ++r) { float v = sq[r]; v += __shfl_xor(v, 1); v += __shfl_xor(v, 2); v += __shfl_xor(v, 4); v += __shfl_xor(v, 8);
              if (c16 == 0) ((LAS float*)(lds + SSQP))[(w & 1) * 64 + ti * 16 + 4 * q4 + r] = v; } }
        { const float dal = gt[192 + 63];
#pragma unroll
          for (int r = 0; r < 16; ++r) S[r] *= dal;
#pragma unroll
          for (int kk = 0; kk < 4; ++kk) { const bf16x8 af = frag32(lds + XST, 144, pi * 32, kk, lane); const bf16x8 bfr = frag32(lds + BST, 144, ni * 32, kk, lane);
              S = __builtin_amdgcn_mfma_f32_32x32x16_bf16(af, bfr, S, 0, 0, 0); } }
        LBAR();
#pragma unroll
        for (int r = 0; r < 16; ++r) *(LAS bf16*)(lds + SBF + (pi * 32 + crow32(r, lane >> 5)) * 272 + (ni * 32 + (lane & 31)) * 2) = (bf16)f2bf(S[r]);
        if (tid < 64) SSQ[(size_t)(rowbase + t0 + tid) * 16 + h] = ((LAS float*)(lds + SSQP))[tid] + ((LAS float*)(lds + SSQP))[64 + tid];
        };
    for (int c2 = 0; c2 < NCH; c2 += 2) { step(c2, PA); step(c2 + 1, PB); }
    { float* so = OUTP() + O_P_SSM + (((size_t)l * NB_P + b) * 16 + h) * 8192;
#pragma unroll
      for (int r = 0; r < 16; ++r) so[(pi * 32 + crow32(r, lane >> 5)) * 128 + ni * 32 + (lane & 31)] = S[r]; }
    if (h == 0) { float* co = OUTP() + O_P_SCONV + ((size_t)l * NB_P + b) * 3 * CONVD;
        for (int idx = tid; idx < 3 * CONVD; idx += NTHR) { const int j = idx / CONVD, cc = idx % CONVD; co[idx] = bf2f(U[(size_t)(rowbase + SEQ_P - 3 + j) * NU + UC_XBC + cc]); } }
    LBAR();
}

__device__ __forceinline__ void bca_prepass(Frame& F, int l) {
    const rsrc_t ru = U_RSRC(); v4u* bca = (v4u*)P_BCA;
    const float* cw = INP(I_SCW) + (size_t)l * 4 * CONVD + 1024; const float* cb = INP(I_SCB) + (size_t)l * CONVD + 1024;
    for (int unit = blockIdx.x * NTHR + F.tid; unit < (MP / 8) * 64; unit += F.G * NTHR) {
        const int rg = unit >> 6, ch = unit & 63, row0 = rg * 8; const bool head = (row0 & (SEQ_P - 1)) == 0;
        v4u r[11];
#pragma unroll
        for (int i = 0; i < 11; ++i) { r[i] = __builtin_amdgcn_raw_buffer_load_b128(ru, (UC_XBC + 1024 + 8 * ch) * 2, (row0 + i) * ROWB, 0); if (head && i < 3) r[i] = (v4u){0u, 0u, 0u, 0u}; }
        v4u o[8];
#pragma unroll
        for (int e2 = 0; e2 < 4; ++e2) { float w0[4], w1[4];
#pragma unroll
            for (int j = 0; j < 4; ++j) { w0[j] = cw[j * CONVD + 8 * ch + 2 * e2]; w1[j] = cw[j * CONVD + 8 * ch + 2 * e2 + 1]; }
            const float b0 = cb[8 * ch + 2 * e2], b1 = cb[8 * ch + 2 * e2 + 1];
#pragma unroll
            for (int i = 0; i < 8; ++i) { float a0 = b0, a1 = b1;
#pragma unroll
                for (int j = 0; j < 4; ++j) { const unsigned u = r[i + j][e2]; a0 += w0[j] * lo_bf(u); a1 += w1[j] * hi_bf(u); }
                o[i][e2] = pk2(siluf_(a0), siluf_(a1)); } }
#pragma unroll
        for (int i = 0; i < 8; ++i) bca[(size_t)(row0 + i) * 64 + ch] = o[i];
    }
}

__device__ __forceinline__ bf16* ssd_sin_ptr(int b, int h, int c) { bf16* base = b < 4 ? (bf16*)WSP(WS_YZ + 34 * MiB) : (bf16*)WSP(WS_HN); return base + ((size_t)((b & 3) * 16 + h) * 32 + c) * 8192; }
__device__ __forceinline__ void ssd_passA(Frame& F, int l, int b, int h) {
    constexpr int L = 64, NCH = SEQ_P / L;
    constexpr int BST = 0, XST = 18432, GT = 27648;
    const int tid = F.tid, lane = F.lane, w = F.wave, g = h >> 3, rowbase = b * SEQ_P;
    LAS unsigned char* lds = F.lds;
    const bf16* U = P_U; const float* gates = P_GATES;
    const float a = -fexp(INP(I_ALOG)[l * 16 + h]), dtb = INP(I_DTB)[l * 16 + h];
    const int px = tid & 31, gx = tid >> 5, pb = tid & 63, gb = tid >> 6;
    const int colx = UC_XBC + h * 64 + 2 * px, colb = UC_XBC + 1024 + g * 128 + 2 * pb;
    float cwx[4][2], cwb[4][2], cbx[2], cbb[2];
    { const float* cw = INP(I_SCW) + (size_t)l * 4 * CONVD; const float* cb = INP(I_SCB) + (size_t)l * CONVD;
#pragma unroll
      for (int j = 0; j < 4; ++j)
#pragma unroll
          for (int e = 0; e < 2; ++e) { cwx[j][e] = cw[j * CONVD + colx - UC_XBC + e]; cwb[j][e] = cw[j * CONVD + colb - UC_XBC + e]; }
#pragma unroll
      for (int e = 0; e < 2; ++e) { cbx[e] = cb[colx - UC_XBC + e]; cbb[e] = cb[colb - UC_XBC + e]; } }
    unsigned rx[7], rb[11];
    const rsrc_t ru = U_RSRC();
    const int voffx = (4 * gx * NU + colx) * 2, voffb = (8 * gb * NU + colb) * 2;
    auto prefetch = [&](int c) {
        const int sb = (rowbase + c * L) * ROWB;
#pragma unroll
        for (int i = 0; i < 7; ++i) { rx[i] = __builtin_amdgcn_raw_buffer_load_b32(ru, voffx, sb + i * ROWB, 0); if (c == 0 && 4 * gx + i < 3) rx[i] = 0u; }
#pragma unroll
        for (int i = 0; i < 11; ++i) { rb[i] = __builtin_amdgcn_raw_buffer_load_b32(ru, voffb, sb + i * ROWB, 0); if (c == 0 && 8 * gb + i < 3) rb[i] = 0u; }
    };
    for (int c = w; c < NCH; c += NWAVES) {
        LAS float* gtw = (LAS float*)(lds + GT) + c * 128;
        const float dt = softplusf_(gates[(size_t)(rowbase + c * L + lane) * NG + h] + dtb); float x = dt * a;
#pragma unroll
        for (int o = 1; o < 64; o <<= 1) { const float y = __shfl_up(x, o); if (lane >= o) x += y; }
        const float cl = __shfl(x, 63);
        gtw[lane] = fexp(cl - x) * dt; if (lane == 63) gtw[64] = fexp(x);
    }
    f32x16 S; for (int r = 0; r < 16; ++r) S[r] = 0.f;
    prefetch(0);
    __syncthreads();
    const int pi = w >> 2, ni = w & 3;
    for (int c = 0; c < NCH; ++c) {
        const LAS float* gt = (const LAS float*)(lds + GT) + c * 128;
        { bf16* so = ssd_sin_ptr(b, h, c);
#pragma unroll
          for (int r = 0; r < 16; ++r) so[(pi * 32 + crow32(r, lane >> 5)) * 128 + ni * 32 + (lane & 31)] = (bf16)f2bf(S[r]); }
        { float o0[4], o1[4];
#pragma unroll
          for (int i = 0; i < 4; ++i) { float a0 = cbx[0], a1 = cbx[1];
#pragma unroll
              for (int j = 0; j < 4; ++j) { a0 += cwx[j][0] * lo_bf(rx[i + j]); a1 += cwx[j][1] * hi_bf(rx[i + j]); }
              o0[i] = siluf_(a0); o1[i] = siluf_(a1); }
          *(LAS v2u*)(lds + XST + (2 * px) * 144 + 8 * gx) = (v2u){pk2(o0[0], o0[1]), pk2(o0[2], o0[3])};
          *(LAS v2u*)(lds + XST + (2 * px + 1) * 144 + 8 * gx) = (v2u){pk2(o1[0], o1[1]), pk2(o1[2], o1[3])}; }
        { float o0[8], o1[8];
#pragma unroll
          for (int i = 0; i < 8; ++i) { float a0 = cbb[0], a1 = cbb[1];
#pragma unroll
              for (int j = 0; j < 4; ++j) { a0 += cwb[j][0] * lo_bf(rb[i + j]); a1 += cwb[j][1] * hi_bf(rb[i + j]); }
              const float ws = gt[8 * gb + i]; o0[i] = siluf_(a0) * ws; o1[i] = siluf_(a1) * ws; }
          *(LAS v4u*)(lds + BST + (2 * pb) * 144 + 16 * gb) = (v4u){pk2(o0[0], o0[1]), pk2(o0[2], o0[3]), pk2(o0[4], o0[5]), pk2(o0[6], o0[7])};
          *(LAS v4u*)(lds + BST + (2 * pb + 1) * 144 + 16 * gb) = (v4u){pk2(o1[0], o1[1]), pk2(o1[2], o1[3]), pk2(o1[4], o1[5]), pk2(o1[6], o1[7])}; }
        if (c + 1 < NCH) prefetch(c + 1);
        LBAR();
        { const float dal = gt[64];
#pragma unroll
          for (int r = 0; r < 16; ++r) S[r] *= dal;
#pragma unroll
          for (int kk = 0; kk < 4; ++kk) { const bf16x8 af = frag32(lds + XST, 144, pi * 32, kk, lane); const bf16x8 bfr = frag32(lds + BST, 144, ni * 32, kk, lane);
              S = __builtin_amdgcn_mfma_f32_32x32x16_bf16(af, bfr, S, 0, 0, 0); } }
        LBAR();
    }
    { float* so = OUTP() + O_P_SSM + (((size_t)l * NB_P + b) * 16 + h) * 8192;
#pragma unroll
      for (int r = 0; r < 16; ++r) so[(pi * 32 + crow32(r, lane >> 5)) * 128 + ni * 32 + (lane & 31)] = S[r]; }
    if (h == 0) { float* co = OUTP() + O_P_SCONV + ((size_t)l * NB_P + b) * 3 * CONVD;
        for (int idx = tid; idx < 3 * CONVD; idx += NTHR) { const int j = idx / CONVD, cc = idx % CONVD; co[idx] = bf2f(U[(size_t)(rowbase + SEQ_P - 3 + j) * NU + UC_XBC + cc]); } }
    __syncthreads();
}

__device__ __forceinline__ void ssd_passB(Frame& F, int l, int b, int c, int g) {
    constexpr int L = 64;
    constexpr int CS = 0, BS = 17408, GS = 34816, XST = 44032, GT = 117760;
    const int tid = F.tid, lane = F.lane, w = F.wave, rowbase = b * SEQ_P, t0 = c * L, h = g * 8 + w;
    LAS unsigned char* lds = F.lds;
    const float* gates = P_GATES;
    const rsrc_t ru = U_RSRC(); const rsrc_t ryc = mk_rsrc(P_YCAT, (unsigned)((size_t)MT * MIXW * 2));
    const float* cw = INP(I_SCW) + (size_t)l * 4 * CONVD; const float* cb = INP(I_SCB) + (size_t)l * CONVD;
    const int sb = (rowbase + t0) * ROWB;
    { LAS float* gtw = (LAS float*)(lds + GT) + w * 192;
      const float dt = softplusf_(gates[(size_t)(rowbase + t0 + lane) * NG + h] + INP(I_DTB)[l * 16 + h]); float x = -dt * fexp(INP(I_ALOG)[l * 16 + h]);
#pragma unroll
      for (int o = 1; o < 64; o <<= 1) { const float y = __shfl_up(x, o); if (lane >= o) x += y; }
      gtw[lane] = x; gtw[64 + lane] = dt; gtw[128 + lane] = fexp(x); }
    { const int pb = tid & 63, gb = tid >> 6, colb = UC_XBC + 1024 + g * 128 + 2 * pb, voffb = (8 * gb * NU + colb) * 2;
      unsigned rb[11], rc[11];
#pragma unroll
      for (int i = 0; i < 11; ++i) { rb[i] = __builtin_amdgcn_raw_buffer_load_b32(ru, voffb, sb + i * ROWB, 0); rc[i] = __builtin_amdgcn_raw_buffer_load_b32(ru, voffb + 512, sb + i * ROWB, 0);
          if (c == 0 && 8 * gb + i < 3) { rb[i] = 0u; rc[i] = 0u; } }
      float wb[4][2], wc[4][2], bb[2], bc[2];
#pragma unroll
      for (int e = 0; e < 2; ++e) { bb[e] = cb[colb - UC_XBC + e]; bc[e] = cb[colb + 256 - UC_XBC + e];
#pragma unroll
          for (int j = 0; j < 4; ++j) { wb[j][e] = cw[j * CONVD + colb - UC_XBC + e]; wc[j][e] = cw[j * CONVD + colb + 256 - UC_XBC + e]; } }
#pragma unroll
      for (int i = 0; i < 8; ++i) { float a0 = bb[0], a1 = bb[1], c0 = bc[0], c1 = bc[1];
#pragma unroll
          for (int j = 0; j < 4; ++j) { a0 += wb[j][0] * lo_bf(rb[i + j]); a1 += wb[j][1] * hi_bf(rb[i + j]); c0 += wc[j][0] * lo_bf(rc[i + j]); c1 += wc[j][1] * hi_bf(rc[i + j]); }
          *(LAS unsigned*)(lds + BS + (8 * gb + i) * 272 + 4 * pb) = pk2(siluf_(a0), siluf_(a1)); *(LAS unsigned*)(lds + CS + (8 * gb + i) * 272 + 4 * pb) = pk2(siluf_(c0), siluf_(c1)); } }
    { const int cx = tid & 63, gx8 = tid >> 6, colx = UC_XBC + g * 512 + 8 * cx, hh = cx >> 3, p0 = 8 * (cx & 7);
      v4u rx[11];
#pragma unroll
      for (int i = 0; i < 11; ++i) { rx[i] = __builtin_amdgcn_raw_buffer_load_b128(ru, (8 * gx8 * NU + colx) * 2, sb + i * ROWB, 0); if (c == 0 && 8 * gx8 + i < 3) rx[i] = (v4u){0u, 0u, 0u, 0u}; }
#pragma unroll
      for (int e2 = 0; e2 < 4; ++e2) {
          float w0[4], w1[4];
#pragma unroll
          for (int j = 0; j < 4; ++j) { w0[j] = cw[j * CONVD + colx - UC_XBC + 2 * e2]; w1[j] = cw[j * CONVD + colx - UC_XBC + 2 * e2 + 1]; }
          const float b0 = cb[colx - UC_XBC + 2 * e2], b1 = cb[colx - UC_XBC + 2 * e2 + 1];
          float o0[8], o1[8];
#pragma unroll
          for (int i = 0; i < 8; ++i) { float a0 = b0, a1 = b1;
#pragma unroll
              for (int j = 0; j < 4; ++j) { const unsigned u = rx[i + j][e2]; a0 += w0[j] * lo_bf(u); a1 += w1[j] * hi_bf(u); }
              o0[i] = siluf_(a0); o1[i] = siluf_(a1); }
          *(LAS v4u*)(lds + XST + hh * 9216 + (p0 + 2 * e2) * 144 + ((gx8 ^ (cx & 7)) << 4)) = (v4u){pk2(o0[0], o0[1]), pk2(o0[2], o0[3]), pk2(o0[4], o0[5]), pk2(o0[6], o0[7])};
          *(LAS v4u*)(lds + XST + hh * 9216 + (p0 + 2 * e2 + 1) * 144 + ((gx8 ^ (cx & 7)) << 4)) = (v4u){pk2(o1[0], o1[1]), pk2(o1[2], o1[3]), pk2(o1[4], o1[5]), pk2(o1[6], o1[7])}; } }
    const int q4 = lane >> 4, c16 = lane & 15;
    v2u zz[4][4];
    { const int voffz = ((c16 + 3) * NU + UC_Z + h * 64 + 4 * q4) * 2;
#pragma unroll
      for (int ti = 0; ti < 4; ++ti)
#pragma unroll
          for (int pj = 0; pj < 4; ++pj) zz[ti][pj] = __builtin_amdgcn_raw_buffer_load_b64(ru, voffz + pj * 32, sb + ti * 16 * ROWB, 0); }
    bf16x8 sf[4][4];
    { const bf16* sin = ssd_sin_ptr(b, h, c);
#pragma unroll
      for (int kk = 0; kk < 4; ++kk)
#pragma unroll
          for (int pj = 0; pj < 4; ++pj) sf[kk][pj] = *(const bf16x8*)(sin + (pj * 16 + c16) * 128 + kk * 32 + q4 * 8); }
    LBAR();
    { const int ti = w >> 1, sj0 = 2 * (w & 1); f32x4 ga[2] = {{0.f, 0.f, 0.f, 0.f}, {0.f, 0.f, 0.f, 0.f}};
#pragma unroll
      for (int kk = 0; kk < 4; ++kk) { const bf16x8 af = frag16(lds + CS, 272, ti * 16, kk, lane);
#pragma unroll
          for (int jj = 0; jj < 2; ++jj) { const bf16x8 bfr = frag16(lds + BS, 272, (sj0 + jj) * 16, kk, lane); ga[jj] = __builtin_amdgcn_mfma_f32_16x16x32_bf16(af, bfr, ga[jj], 0, 0, 0); } }
#pragma unroll
      for (int jj = 0; jj < 2; ++jj)
#pragma unroll
          for (int r = 0; r < 4; ++r) *(LAS bf16*)(lds + GS + (ti * 16 + 4 * q4 + r) * 144 + ((sj0 + jj) * 16 + c16) * 2) = (bf16)f2bf(ga[jj][r]); }
    LBAR();
    const LAS float* gt = (const LAS float*)(lds + GT) + w * 192;
    f32x4 acc[4][4];
#pragma unroll
    for (int pj = 0; pj < 4; ++pj)
#pragma unroll
        for (int ti = 0; ti < 4; ++ti) acc[pj][ti] = (f32x4){0.f, 0.f, 0.f, 0.f};
    {
#pragma unroll
      for (int kk = 0; kk < 4; ++kk) { bf16x8 bfr[4];
#pragma unroll
          for (int ti = 0; ti < 4; ++ti) bfr[ti] = frag16(lds + CS, 272, ti * 16, kk, lane);
#pragma unroll
          for (int pj = 0; pj < 4; ++pj)
#pragma unroll
              for (int ti = 0; ti < 4; ++ti) acc[pj][ti] = __builtin_amdgcn_mfma_f32_16x16x32_bf16(sf[kk][pj], bfr[ti], acc[pj][ti], 0, 0, 0); } }
#pragma unroll
    for (int ti = 0; ti < 4; ++ti) { const float e = gt[128 + ti * 16 + c16];
#pragma unroll
        for (int pj = 0; pj < 4; ++pj) acc[pj][ti] *= e; }
    { const float Dh = INP(I_SSD_D)[l * 16 + h];
#pragma unroll
      for (int kk = 0; kk < 2; ++kk) { bf16x8 af[4];
#pragma unroll
          for (int pj = 0; pj < 4; ++pj) af[pj] = *(const LAS bf16x8*)(lds + XST + w * 9216 + (pj * 16 + c16) * 144 + (((kk * 4 + q4) ^ ((2 * pj + (c16 >> 3)) & 7)) << 4));
          const int s0 = kk * 32 + q4 * 8; const f32x4 cs0 = *(const LAS f32x4*)(gt + s0), cs1 = *(const LAS f32x4*)(gt + s0 + 4), ds0 = *(const LAS f32x4*)(gt + 64 + s0), ds1 = *(const LAS f32x4*)(gt + 64 + s0 + 4);
          const float csv[8] = {cs0.x, cs0.y, cs0.z, cs0.w, cs1.x, cs1.y, cs1.z, cs1.w}, dsv[8] = {ds0.x, ds0.y, ds0.z, ds0.w, ds1.x, ds1.y, ds1.z, ds1.w};
#pragma unroll
          for (int ti = 2 * kk; ti < 4; ++ti) {
              const int t = ti * 16 + c16; const float ct = gt[t]; const bf16x8 g8 = *(const LAS bf16x8*)(lds + GS + t * 144 + s0 * 2); float mv[8];
#pragma unroll
              for (int j = 0; j < 8; ++j) { const int s = s0 + j; float v = s <= t ? bf2f((bf16)g8[j]) * fexp(ct - csv[j]) * dsv[j] : 0.f; if (s == t) v += Dh; mv[j] = v; }
              const v4u mp = (v4u){pk2(mv[0], mv[1]), pk2(mv[2], mv[3]), pk2(mv[4], mv[5]), pk2(mv[6], mv[7])}; const bf16x8 bfr = __builtin_bit_cast(bf16x8, mp);
#pragma unroll
              for (int pj = 0; pj < 4; ++pj) acc[pj][ti] = __builtin_amdgcn_mfma_f32_16x16x32_bf16(af[pj], bfr, acc[pj][ti], 0, 0, 0); } } }
    { const float* nwp = INP(I_SNW) + l * 1024 + h * 64 + 4 * q4; float nw[4][4];
#pragma unroll
      for (int pj = 0; pj < 4; ++pj) { const f32x4 n4 = *(const f32x4*)(nwp + pj * 16); nw[pj][0] = n4.x; nw[pj][1] = n4.y; nw[pj][2] = n4.z; nw[pj][3] = n4.w; }
      const int voffy = (c16 * MIXW + h * 64 + 4 * q4) * 2; float* SSQ = P_SSQ;
#pragma unroll
      for (int ti = 0; ti < 4; ++ti) { float sq = 0.f;
#pragma unroll
          for (int pj = 0; pj < 4; ++pj) { const v2u z2 = zz[ti][pj]; const float z4[4] = {lo_bf(z2.x), hi_bf(z2.x), lo_bf(z2.y), hi_bf(z2.y)}; float yz[4];
#pragma unroll
              for (int r = 0; r < 4; ++r) { yz[r] = acc[pj][ti][r] * siluf_(z4[r]); sq += yz[r] * yz[r]; }
              __builtin_amdgcn_raw_buffer_store_b64((v2u){pk2(yz[0] * nw[pj][0], yz[1] * nw[pj][1]), pk2(yz[2] * nw[pj][2], yz[3] * nw[pj][3])}, ryc, voffy + pj * 32, (rowbase + t0 + ti * 16) * (MIXW * 2), 0); }
          sq += __shfl_xor(sq, 16); sq += __shfl_xor(sq, 32);
          if (q4 == 0) SSQ[(size_t)(rowbase + t0 + ti * 16 + c16) * 16 + h] = sq; } }
    __syncthreads();
}

__device__ __forceinline__ bf16* ssd_sin_ptr2(int b, int h, int c) { return (bf16*)OUTP() + ((size_t)(b * 16 + h) * 32 + c) * 8192; }
__device__ __forceinline__ void ssd_passA2(Frame& F, int l, int b, int h, int flagset) {
    constexpr int L = 64, NCH = SEQ_P / L;
    constexpr int BST = 0, XST = 18432, GT = 27648;
    const int tid = F.tid, lane = F.lane, w = F.wave, g = h >> 3, rowbase = b * SEQ_P;
    LAS unsigned char* lds = F.lds;
    const bf16* U = P_U; const float* gates = P_GATES;
    const float a = -fexp(INP(I_ALOG)[l * 16 + h]), dtb = INP(I_DTB)[l * 16 + h];
    const int px = tid & 31, gx = tid >> 5, pb = tid & 63, gb = tid >> 6;
    const int colx = UC_XBC + h * 64 + 2 * px;
    float cwx[4][2], cbx[2];
    { const float* cw = INP(I_SCW) + (size_t)l * 4 * CONVD; const float* cb = INP(I_SCB) + (size_t)l * CONVD;
#pragma unroll
      for (int j = 0; j < 4; ++j)
#pragma unroll
          for (int e = 0; e < 2; ++e) cwx[j][e] = cw[j * CONVD + colx - UC_XBC + e];
#pragma unroll
      for (int e = 0; e < 2; ++e) cbx[e] = cb[colx - UC_XBC + e]; }
    unsigned rx[7], rb[8];
    const rsrc_t ru = U_RSRC(); const rsrc_t rbca = mk_rsrc(P_BCA, (unsigned)((size_t)MP * 512 * 2));
    const int voffx = (4 * gx * NU + colx) * 2, voffbc = (8 * gb * 512 + g * 128 + 2 * pb) * 2;
    auto prefetch = [&](int c) {
        const int sb = (rowbase + c * L) * ROWB;
#pragma unroll
        for (int i = 0; i < 7; ++i) { rx[i] = __builtin_amdgcn_raw_buffer_load_b32(ru, voffx, sb + i * ROWB, 0); if (c == 0 && 4 * gx + i < 3) rx[i] = 0u; }
#pragma unroll
        for (int i = 0; i < 8; ++i) rb[i] = __builtin_amdgcn_raw_buffer_load_b32(rbca, voffbc, (rowbase + c * L + i) * 1024, 0);
    };
    for (int c = w; c < NCH; c += NWAVES) {
        LAS float* gtw = (LAS float*)(lds + GT) + c * 128;
        const float dt = softplusf_(gates[(size_t)(rowbase + c * L + lane) * NG + h] + dtb); float x = dt * a;
#pragma unroll
        for (int o = 1; o < 64; o <<= 1) { const float y = __shfl_up(x, o); if (lane >= o) x += y; }
        const float cl = __shfl(x, 63);
        gtw[lane] = fexp(cl - x) * dt; if (lane == 63) gtw[64] = fexp(x);
    }
    f32x16 S; for (int r = 0; r < 16; ++r) S[r] = 0.f;
    prefetch(0);
    __syncthreads();
    const int pi = w >> 2, ni = w & 3;
    for (int c = 0; c < NCH; ++c) {
        const LAS float* gt = (const LAS float*)(lds + GT) + c * 128;
        { bf16* so = ssd_sin_ptr2(b, h, c);
#pragma unroll
          for (int r = 0; r < 16; ++r) so[(pi * 32 + crow32(r, lane >> 5)) * 128 + ni * 32 + (lane & 31)] = (bf16)f2bf(S[r]); }
        { float o0[4], o1[4];
#pragma unroll
          for (int i = 0; i < 4; ++i) { float a0 = cbx[0], a1 = cbx[1];
#pragma unroll
              for (int j = 0; j < 4; ++j) { a0 += cwx[j][0] * lo_bf(rx[i + j]); a1 += cwx[j][1] * hi_bf(rx[i + j]); }
              o0[i] = siluf_(a0); o1[i] = siluf_(a1); }
          *(LAS v2u*)(lds + XST + (2 * px) * 144 + 8 * gx) = (v2u){pk2(o0[0], o0[1]), pk2(o0[2], o0[3])};
          *(LAS v2u*)(lds + XST + (2 * px + 1) * 144 + 8 * gx) = (v2u){pk2(o1[0], o1[1]), pk2(o1[2], o1[3])}; }
        { float o0[8], o1[8];
#pragma unroll
          for (int i = 0; i < 8; ++i) { const float ws = gt[8 * gb + i]; o0[i] = lo_bf(rb[i]) * ws; o1[i] = hi_bf(rb[i]) * ws; }
          *(LAS v4u*)(lds + BST + (2 * pb) * 144 + 16 * gb) = (v4u){pk2(o0[0], o0[1]), pk2(o0[2], o0[3]), pk2(o0[4], o0[5]), pk2(o0[6], o0[7])};
          *(LAS v4u*)(lds + BST + (2 * pb + 1) * 144 + 16 * gb) = (v4u){pk2(o1[0], o1[1]), pk2(o1[2], o1[3]), pk2(o1[4], o1[5]), pk2(o1[6], o1[7])}; }
        if (c + 1 < NCH) prefetch(c + 1);
        LBAR();
        { const float dal = gt[64];
#pragma unroll
          for (int r = 0; r < 16; ++r) S[r] *= dal;
#pragma unroll
          for (int kk = 0; kk < 4; ++kk) { const bf16x8 af = frag32(lds + XST, 144, pi * 32, kk, lane); const bf16x8 bfr = frag32(lds + BST, 144, ni * 32, kk, lane);
              S = __builtin_amdgcn_mfma_f32_32x32x16_bf16(af, bfr, S, 0, 0, 0); } }
        LBAR();
    }
    { float* so = OUTP() + O_P_SSM + (((size_t)l * NB_P + b) * 16 + h) * 8192;
#pragma unroll
      for (int r = 0; r < 16; ++r) so[(pi * 32 + crow32(r, lane >> 5)) * 128 + ni * 32 + (lane & 31)] = S[r]; }
    if (h == 0) { float* co = OUTP() + O_P_SCONV + ((size_t)l * NB_P + b) * 3 * CONVD;
        for (int idx = tid; idx < 3 * CONVD; idx += NTHR) { const int j = idx / CONVD, cc = idx % CONVD; co[idx] = bf2f(U[(size_t)(rowbase + SEQ_P - 3 + j) * NU + UC_XBC + cc]); } }
    asm volatile("s_waitcnt vmcnt(0)" ::: "memory");
    __syncthreads();
    if (tid == 0) { __builtin_amdgcn_fence(__ATOMIC_RELEASE, "agent"); asm volatile("s_waitcnt vmcnt(0)" ::: "memory");
        __hip_atomic_store(P_CTL + CW_FLAG2 + 16 * ((flagset * 2 + l) * 128 + b * 16 + h), 1u, __ATOMIC_RELAXED, __HIP_MEMORY_SCOPE_AGENT); }
    __syncthreads();
}

__device__ __forceinline__ void ssd_passB2(Frame& F, int l, int b, int c, int g, int flagset) {
    constexpr int L = 64;
    constexpr int CS = 0, BS = 17408, GS = 34816, XST = 44032, GT = 117760;
    const int tid = F.tid, lane = F.lane, w = F.wave, rowbase = b * SEQ_P, t0 = c * L, h = g * 8 + w;
    LAS unsigned char* lds = F.lds;
    const float* gates = P_GATES;
    const rsrc_t ru = U_RSRC(); const rsrc_t ryc = mk_rsrc(P_YCAT, (unsigned)((size_t)MT * MIXW * 2));
    const float* cw = INP(I_SCW) + (size_t)l * 4 * CONVD; const float* cb = INP(I_SCB) + (size_t)l * CONVD;
    const int sb = (rowbase + t0) * ROWB;
    { LAS float* gtw = (LAS float*)(lds + GT) + w * 192;
      const float dt = softplusf_(gates[(size_t)(rowbase + t0 + lane) * NG + h] + INP(I_DTB)[l * 16 + h]); float x = -dt * fexp(INP(I_ALOG)[l * 16 + h]);
#pragma unroll
      for (int o = 1; o < 64; o <<= 1) { const float y = __shfl_up(x, o); if (lane >= o) x += y; }
      gtw[lane] = x; gtw[64 + lane] = dt; gtw[128 + lane] = fexp(x); }
    if (tid == 0) { unsigned spins = 0;
        for (int hh = 0; hh < 8; ++hh) { unsigned* fl = P_CTL + CW_FLAG2 + 16 * ((flagset * 2 + l) * 128 + b * 16 + g * 8 + hh);
            while (__hip_atomic_load(fl, __ATOMIC_RELAXED, __HIP_MEMORY_SCOPE_AGENT) == 0u) { __builtin_amdgcn_s_sleep(8); if (++spins > (1u << 22)) break; } }
        __builtin_amdgcn_fence(__ATOMIC_ACQUIRE, "agent"); asm volatile("s_waitcnt vmcnt(0)" ::: "memory"); }
    __syncthreads();
    { const v4u* bca = (const v4u*)P_BCA;
#pragma unroll
      for (int i = 0; i < 2; ++i) { const int id = tid + NTHR * i, row = id >> 4, pc = id & 15; const size_t rb_ = (size_t)(rowbase + t0 + row) * 64;
          *(LAS v4u*)(lds + BS + row * 272 + pc * 16) = bca[rb_ + g * 16 + pc]; *(LAS v4u*)(lds + CS + row * 272 + pc * 16) = bca[rb_ + 32 + g * 16 + pc]; } }
    { const int cx = tid & 63, gx8 = tid >> 6, colx = UC_XBC + g * 512 + 8 * cx, hh = cx >> 3, p0 = 8 * (cx & 7);
      v4u rx[11];
#pragma unroll
      for (int i = 0; i < 11; ++i) { rx[i] = __builtin_amdgcn_raw_buffer_load_b128(ru, (8 * gx8 * NU + colx) * 2, sb + i * ROWB, 0); if (c == 0 && 8 * gx8 + i < 3) rx[i] = (v4u){0u, 0u, 0u, 0u}; }
#pragma unroll
      for (int e2 = 0; e2 < 4; ++e2) {
          float w0[4], w1[4];
#pragma unroll
          for (int j = 0; j < 4; ++j) { w0[j] = cw[j * CONVD + colx - UC_XBC + 2 * e2]; w1[j] = cw[j * CONVD + colx - UC_XBC + 2 * e2 + 1]; }
          const float b0 = cb[colx - UC_XBC + 2 * e2], b1 = cb[colx - UC_XBC + 2 * e2 + 1];
          float o0[8], o1[8];
#pragma unroll
          for (int i = 0; i < 8; ++i) { float a0 = b0, a1 = b1;
#pragma unroll
              for (int j = 0; j < 4; ++j) { const unsigned u = rx[i + j][e2]; a0 += w0[j] * lo_bf(u); a1 += w1[j] * hi_bf(u); }
              o0[i] = siluf_(a0); o1[i] = siluf_(a1); }
          *(LAS v4u*)(lds + XST + hh * 9216 + (p0 + 2 * e2) * 144 + ((gx8 ^ (cx & 7)) << 4)) = (v4u){pk2(o0[0], o0[1]), pk2(o0[2], o0[3]), pk2(o0[4], o0[5]), pk2(o0[6], o0[7])};
          *(LAS v4u*)(lds + XST + hh * 9216 + (p0 + 2 * e2 + 1) * 144 + ((gx8 ^ (cx & 7)) << 4)) = (v4u){pk2(o1[0], o1[1]), pk2(o1[2], o1[3]), pk2(o1[4], o1[5]), pk2(o1[6], o1[7])}; } }
    const int q4 = lane >> 4, c16 = lane & 15;
    v2u zz[4][4];
    { const int voffz = ((c16 + 3) * NU + UC_Z + h * 64 + 4 * q4) * 2;
#pragma unroll
      for (int ti = 0; ti < 4; ++ti)
#pragma unroll
          for (int pj = 0; pj < 4; ++pj) zz[ti][pj] = __builtin_amdgcn_raw_buffer_load_b64(ru, voffz + pj * 32, sb + ti * 16 * ROWB, 0); }
    bf16x8 sf[4][4];
    { const bf16* sin = ssd_sin_ptr2(b, h, c);
#pragma unroll
      for (int kk = 0; kk < 4; ++kk)
#pragma unroll
          for (int pj = 0; pj < 4; ++pj) sf[kk][pj] = *(const bf16x8*)(sin + (pj * 16 + c16) * 128 + kk * 32 + q4 * 8); }
    LBAR();
    { const int ti = w >> 1, sj0 = 2 * (w & 1); f32x4 ga[2] = {{0.f, 0.f, 0.f, 0.f}, {0.f, 0.f, 0.f, 0.f}};
#pragma unroll
      for (int kk = 0; kk < 4; ++kk) { const bf16x8 af = frag16(lds + CS, 272, ti * 16, kk, lane);
#pragma unroll
          for (int jj = 0; jj < 2; ++jj) { const bf16x8 bfr = frag16(lds + BS, 272, (sj0 + jj) * 16, kk, lane); ga[jj] = __builtin_amdgcn_mfma_f32_16x16x32_bf16(af, bfr, ga[jj], 0, 0, 0); } }
#pragma unroll
      for (int jj = 0; jj < 2; ++jj)
#pragma unroll
          for (int r = 0; r < 4; ++r) *(LAS bf16*)(lds + GS + (ti * 16 + 4 * q4 + r) * 144 + ((sj0 + jj) * 16 + c16) * 2) = (bf16)f2bf(ga[jj][r]); }
    LBAR();
    const LAS float* gt = (const LAS float*)(lds + GT) + w * 192;
    f32x4 acc[4][4];
#pragma unroll
    for (int pj = 0; pj < 4; ++pj)
#pragma unroll
        for (int ti = 0; ti < 4; ++ti) acc[pj][ti] = (f32x4){0.f, 0.f, 0.f, 0.f};
    {
#pragma unroll
      for (int kk = 0; kk < 4; ++kk) { bf16x8 bfr[4];
#pragma unroll
          for (int ti = 0; ti < 4; ++ti) bfr[ti] = frag16(lds + CS, 272, ti * 16, kk, lane);
#pragma unroll
          for (int pj = 0; pj < 4; ++pj)
#pragma unroll
              for (int ti = 0; ti < 4; ++ti) acc[pj][ti] = __builtin_amdgcn_mfma_f32_16x16x32_bf16(sf[kk][pj], bfr[ti], acc[pj][ti], 0, 0, 0); } }
#pragma unroll
    for (int ti = 0; ti < 4; ++ti) { const float e = gt[128 + ti * 16 + c16];
#pragma unroll
        for (int pj = 0; pj < 4; ++pj) acc[pj][ti] *= e; }
    { const float Dh = INP(I_SSD_D)[l * 16 + h];
#pragma unroll
      for (int kk = 0; kk < 2; ++kk) { bf16x8 af[4];
#pragma unroll
          for (int pj = 0; pj < 4; ++pj) af[pj] = *(const LAS bf16x8*)(lds + XST + w * 9216 + (pj * 16 + c16) * 144 + (((kk * 4 + q4) ^ ((2 * pj + (c16 >> 3)) & 7)) << 4));
          const int s0 = kk * 32 + q4 * 8; const f32x4 cs0 = *(const LAS f32x4*)(gt + s0), cs1 = *(const LAS f32x4*)(gt + s0 + 4), ds0 = *(const LAS f32x4*)(gt + 64 + s0), ds1 = *(const LAS f32x4*)(gt + 64 + s0 + 4);
          const float csv[8] = {cs0.x, cs0.y, cs0.z, cs0.w, cs1.x, cs1.y, cs1.z, cs1.w}, dsv[8] = {ds0.x, ds0.y, ds0.z, ds0.w, ds1.x, ds1.y, ds1.z, ds1.w};
#pragma unroll
          for (int ti = 2 * kk; ti < 4; ++ti) {
              const int t = ti * 16 + c16; const float ct = gt[t]; const bf16x8 g8 = *(const LAS bf16x8*)(lds + GS + t * 144 + s0 * 2); float mv[8];
#pragma unroll
              for (int j = 0; j < 8; ++j) { const int s = s0 + j; float v = s <= t ? bf2f((bf16)g8[j]) * fexp(ct - csv[j]) * dsv[j] : 0.f; if (s == t) v += Dh; mv[j] = v; }
              const v4u mp = (v4u){pk2(mv[0], mv[1]), pk2(mv[2], mv[3]), pk2(mv[4], mv[5]), pk2(mv[6], mv[7])}; const bf16x8 bfr = __builtin_bit_cast(bf16x8, mp);
#pragma unroll
              for (int pj = 0; pj < 4; ++pj) acc[pj][ti] = __builtin_amdgcn_mfma_f32_16x16x32_bf16(af[pj], bfr, acc[pj][ti], 0, 0, 0); } } }
    { const float* nwp = INP(I_SNW) + l * 1024 + h * 64 + 4 * q4; float nw[4][4];
#pragma unroll
      for (int pj = 0; pj < 4; ++pj) { const f32x4 n4 = *(const f32x4*)(nwp + pj * 16); nw[pj][0] = n4.x; nw[pj][1] = n4.y; nw[pj][2] = n4.z; nw[pj][3] = n4.w; }
      const int voffy = (c16 * MIXW + h * 64 + 4 * q4) * 2; float* SSQ = P_SSQ;
#pragma unroll
      for (int ti = 0; ti < 4; ++ti) { float sq = 0.f;
#pragma unroll
          for (int pj = 0; pj < 4; ++pj) { const v2u z2 = zz[ti][pj]; const float z4[4] = {lo_bf(z2.x), hi_bf(z2.x), lo_bf(z2.y), hi_bf(z2.y)}; float yz[4];
#pragma unroll
              for (int r = 0; r < 4; ++r) { yz[r] = acc[pj][ti][r] * siluf_(z4[r]); sq += yz[r] * yz[r]; }
              __builtin_amdgcn_raw_buffer_store_b64((v2u){pk2(yz[0] * nw[pj][0], yz[1] * nw[pj][1]), pk2(yz[2] * nw[pj][2], yz[3] * nw[pj][3])}, ryc, voffy + pj * 32, (rowbase + t0 + ti * 16) * (MIXW * 2), 0); }
          sq += __shfl_xor(sq, 16); sq += __shfl_xor(sq, 32);
          if (q4 == 0) SSQ[(size_t)(rowbase + t0 + ti * 16 + c16) * 16 + h] = sq; } }
    __syncthreads();
}

__device__ __forceinline__ void mlstm_prompt_item(Frame& F, int l, int b, int h) {
    constexpr int L = 64, NCH = SEQ_P / L;
    constexpr int QS = 0, KS = 17408, KST = 34816, VST = 53248, WS = 71680, CBF = 80896, GT = 115712, GSUM = GT + NCH * 768, NN = GSUM + 512, SSQP = NN + 1024;
    static_assert(SSQP + 512 <= MISC_OFF, "mLSTM LDS map");
    constexpr float KSCALE = 0.08838834764831845f;
    const int tid = F.tid, lane = F.lane, w = F.wave, rowbase = b * SEQ_P;
    LAS unsigned char* lds = F.lds;
    const bf16* U = P_U; const float* gates = P_GATES; bf16* YC = P_YCAT;
    const float ib = INP(I_MIB)[l * 4 + h], fb = INP(I_MFB)[l * 4 + h];
    const int dp = tid & 63, sg = tid >> 6;
    v4u rq[2], rk4[2]; unsigned rkt[8], rvt[8];
    const rsrc_t ru = U_RSRC(); const rsrc_t ryc = mk_rsrc(YC, (unsigned)((size_t)MT * MIXW * 2));
    const int voffq = (((tid >> 4) + 3) * NU + UC_Q + h * 128 + (tid & 15) * 8) * 2, voffk = ((8 * sg + 3) * NU + UC_K + h * 128 + 2 * dp) * 2;
    auto prefetch = [&](int c) {
        const int sb = (rowbase + c * L) * ROWB;
#pragma unroll
        for (int i = 0; i < 2; ++i) { rq[i] = __builtin_amdgcn_raw_buffer_load_b128(ru, voffq, sb + 32 * i * ROWB, 0); rk4[i] = __builtin_amdgcn_raw_buffer_load_b128(ru, voffq + 1024, sb + 32 * i * ROWB, 0); }
#pragma unroll
        for (int i = 0; i < 8; ++i) { rkt[i] = __builtin_amdgcn_raw_buffer_load_b32(ru, voffk, sb + i * ROWB, 0); rvt[i] = __builtin_amdgcn_raw_buffer_load_b32(ru, voffk + 1024, sb + i * ROWB, 0); }
    };
    for (int c = w; c < NCH; c += NWAVES) {
        LAS float* gtw = (LAS float*)(lds + GT) + c * 192; LAS float* gs = (LAS float*)(lds + GSUM);
        const size_t row = (size_t)(rowbase + c * L + lane);
        const float ig = gates[row * NG + 16 + h] + ib, lf = -softplusf_(-(gates[row * NG + 20 + h] + fb));
        float bc = lf;
#pragma unroll
        for (int o = 1; o < 64; o <<= 1) { const float y = __shfl_up(bc, o); if (lane >= o) bc += y; }
        const float e = ig - bc; float pm = e;
#pragma unroll
        for (int o = 1; o < 64; o <<= 1) { const float y = __shfl_up(pm, o); if (lane >= o) pm = fmaxf(pm, y); }
        gtw[lane] = e; gtw[64 + lane] = bc; gtw[128 + lane] = pm;
        if (lane == 63) { gs[c] = bc; gs[32 + c] = pm; }
    }
    __syncthreads();
    if (tid == 0) { LAS float* gs = (LAS float*)(lds + GSUM); float mp = 0.f; for (int c = 0; c < NCH; ++c) { gs[64 + c] = mp; mp = gs[c] + fmaxf(mp, gs[32 + c]); } gs[64 + NCH] = mp; }
    f32x16 c0, c1; for (int r = 0; r < 16; ++r) { c0[r] = 0.f; c1[r] = 0.f; }
    for (int i = tid; i < 34816 / 4; i += NTHR) ((LAS unsigned*)(lds + CBF))[i] = 0u;
    if (tid < 256) ((LAS float*)(lds + NN))[tid] = 0.f;
    prefetch(0);
    __syncthreads();
    const int ti = w >> 1, sj0 = 2 * (w & 1), vbase = (w & 1) * 64, vi = w >> 1, di0 = 2 * (w & 1), q4 = lane >> 4, c16 = lane & 15;
    const float* nw = INP(I_MNW) + l * 512 + h * 128;
    const int voffo = ((ti * 16 + 4 * q4 + 3) * NU + UC_O + h * 128 + vbase + c16) * 2, voffyc = ((ti * 16 + 4 * q4) * MIXW + 1024 + h * 128 + vbase + c16) * 2;
    unsigned orr[4][4];
#pragma unroll
    for (int vj = 0; vj < 4; ++vj)
#pragma unroll
        for (int r = 0; r < 4; ++r) orr[vj][r] = __builtin_amdgcn_raw_buffer_load_b16(ru, voffo + vj * 32, (rowbase + r) * ROWB, 0);
    for (int c = 0; c < NCH; ++c) {
        const int t0 = c * L; const LAS float* gt = (const LAS float*)(lds + GT) + c * 192;
        const float mpv = ((const LAS float*)(lds + GSUM))[64 + c], pml = fmaxf(mpv, ((const LAS float*)(lds + GSUM))[32 + c]);
        const LAS float* nn = (const LAS float*)(lds + NN) + (c & 1) * 128; LAS float* nn_next = (LAS float*)(lds + NN) + ((c + 1) & 1) * 128;
#pragma unroll
        for (int i = 0; i < 2; ++i) { const int id = tid + NTHR * i, row = id >> 4, ch = id & 15; *(LAS v4u*)(lds + QS + row * 272 + ch * 16) = rq[i]; *(LAS v4u*)(lds + KS + row * 272 + ch * 16) = rk4[i]; }
        { float k0[8], k1[8];
#pragma unroll
          for (int i = 0; i < 8; ++i) { const float ws = fexp(gt[8 * sg + i] - pml) * KSCALE; k0[i] = lo_bf(rkt[i]) * ws; k1[i] = hi_bf(rkt[i]) * ws; }
          *(LAS v4u*)(lds + KST + (2 * dp) * 144 + 16 * sg) = (v4u){pk2(k0[0], k0[1]), pk2(k0[2], k0[3]), pk2(k0[4], k0[5]), pk2(k0[6], k0[7])};
          *(LAS v4u*)(lds + KST + (2 * dp + 1) * 144 + 16 * sg) = (v4u){pk2(k1[0], k1[1]), pk2(k1[2], k1[3]), pk2(k1[4], k1[5]), pk2(k1[6], k1[7])};
          *(LAS v4u*)(lds + VST + (2 * dp) * 144 + 16 * sg) = (v4u){(rvt[0] & 0xffffu) | (rvt[1] << 16), (rvt[2] & 0xffffu) | (rvt[3] << 16), (rvt[4] & 0xffffu) | (rvt[5] << 16), (rvt[6] & 0xffffu) | (rvt[7] << 16)};
          *(LAS v4u*)(lds + VST + (2 * dp + 1) * 144 + 16 * sg) = (v4u){(rvt[0] >> 16) | (rvt[1] & 0xffff0000u), (rvt[2] >> 16) | (rvt[3] & 0xffff0000u), (rvt[4] >> 16) | (rvt[5] & 0xffff0000u), (rvt[6] >> 16) | (rvt[7] & 0xffff0000u)}; }
        if (c + 1 < NCH) prefetch(c + 1);
        LBAR();
        { f32x4 sa[2] = {{0.f, 0.f, 0.f, 0.f}, {0.f, 0.f, 0.f, 0.f}};
#pragma unroll
          for (int kk = 0; kk < 4; ++kk) { const bf16x8 af = frag16(lds + QS, 272, ti * 16, kk, lane);
#pragma unroll
              for (int jj = 0; jj < 2; ++jj) { const bf16x8 bfr = frag16(lds + KS, 272, (sj0 + jj) * 16, kk, lane); sa[jj] = __builtin_amdgcn_mfma_f32_16x16x32_bf16(af, bfr, sa[jj], 0, 0, 0); } }
          float pt[4];
#pragma unroll
          for (int r = 0; r < 4; ++r) pt[r] = fmaxf(mpv, gt[128 + ti * 16 + 4 * q4 + r]);
#pragma unroll
          for (int jj = 0; jj < 2; ++jj) { const int s = (sj0 + jj) * 16 + c16; const float es = gt[s];
#pragma unroll
              for (int r = 0; r < 4; ++r) { const int t = ti * 16 + 4 * q4 + r; const float v = s <= t ? sa[jj][r] * KSCALE * fexp(es - pt[r]) : 0.f;
                  *(LAS bf16*)(lds + WS + t * 144 + s * 2) = (bf16)f2bf(v); } } }
        LBAR();
        f32x4 ha[4];
        { const int trow = ti * 16 + c16;
          float dsum = 0.f, qn = 0.f;
          { const LAS bf16x8* wp = (const LAS bf16x8*)(lds + WS + trow * 144 + q4 * 32);
#pragma unroll
            for (int i = 0; i < 2; ++i) { const bf16x8 v8 = wp[i];
#pragma unroll
                for (int e = 0; e < 8; ++e) dsum += bf2f((bf16)v8[e]); }
            const LAS bf16x8* qp = (const LAS bf16x8*)(lds + QS + trow * 272 + q4 * 64); const LAS f32x4* np = (const LAS f32x4*)(nn + q4 * 32);
#pragma unroll
            for (int i = 0; i < 4; ++i) { const bf16x8 v8 = qp[i]; const f32x4 n0 = np[2 * i], n1 = np[2 * i + 1];
                qn += bf2f((bf16)v8[0]) * n0.x + bf2f((bf16)v8[1]) * n0.y + bf2f((bf16)v8[2]) * n0.z + bf2f((bf16)v8[3]) * n0.w
                    + bf2f((bf16)v8[4]) * n1.x + bf2f((bf16)v8[5]) * n1.y + bf2f((bf16)v8[6]) * n1.z + bf2f((bf16)v8[7]) * n1.w; } }
          dsum += __shfl_xor(dsum, 16); dsum += __shfl_xor(dsum, 32); qn += __shfl_xor(qn, 16); qn += __shfl_xor(qn, 32);
          const float pmt = fmaxf(mpv, gt[128 + trow]); const float dfull = dsum + fexp(mpv - pmt) * qn, dent = fmaxf(fabsf(dfull), fexp(-(gt[64 + trow] + pmt)));
          float dr[4], it4[4];
#pragma unroll
          for (int r = 0; r < 4; ++r) { dr[r] = frcp(__shfl(dent, 4 * q4 + r)); it4[r] = fexp(mpv - fmaxf(mpv, gt[128 + ti * 16 + 4 * q4 + r])); }
#pragma unroll
          for (int vj = 0; vj < 4; ++vj) ha[vj] = (f32x4){0.f, 0.f, 0.f, 0.f};
#pragma unroll
          for (int kk = 0; kk < 4; ++kk) { const bf16x8 af = frag16(lds + QS, 272, ti * 16, kk, lane);
#pragma unroll
              for (int vj = 0; vj < 4; ++vj) { const bf16x8 bfr = frag16(lds + CBF, 272, vbase + vj * 16, kk, lane); ha[vj] = __builtin_amdgcn_mfma_f32_16x16x32_bf16(af, bfr, ha[vj], 0, 0, 0); } }
#pragma unroll
          for (int vj = 0; vj < 4; ++vj)
#pragma unroll
              for (int r = 0; r < 4; ++r) ha[vj][r] *= it4[r];
#pragma unroll
          for (int kk = 0; kk < 2; ++kk) { const bf16x8 af = frag16(lds + WS, 144, ti * 16, kk, lane);
#pragma unroll
              for (int vj = 0; vj < 4; ++vj) { const bf16x8 bfr = frag16(lds + VST, 144, vbase + vj * 16, kk, lane); ha[vj] = __builtin_amdgcn_mfma_f32_16x16x32_bf16(af, bfr, ha[vj], 0, 0, 0); } }
          float sq[4] = {0.f, 0.f, 0.f, 0.f};
#pragma unroll
          for (int vj = 0; vj < 4; ++vj)
#pragma unroll
              for (int r = 0; r < 4; ++r) { ha[vj][r] = ha[vj][r] * dr[r]; sq[r] += ha[vj][r] * ha[vj][r]; }
#pragma unroll
          for (int r = 0; r < 4; ++r) { float v = sq[r]; v += __shfl_xor(v, 1); v += __shfl_xor(v, 2); v += __shfl_xor(v, 4); v += __shfl_xor(v, 8);
              if (c16 == 0) ((LAS float*)(lds + SSQP))[(w & 1) * 64 + ti * 16 + 4 * q4 + r] = v; } }
        { const float dc = fexp(mpv - pml);
#pragma unroll
          for (int r = 0; r < 16; ++r) { c0[r] *= dc; c1[r] *= dc; }
#pragma unroll
          for (int kk = 0; kk < 4; ++kk) { const bf16x8 af = frag32(lds + VST, 144, vi * 32, kk, lane);
              const bf16x8 b0 = frag32(lds + KST, 144, di0 * 32, kk, lane), b1 = frag32(lds + KST, 144, (di0 + 1) * 32, kk, lane);
              c0 = __builtin_amdgcn_mfma_f32_32x32x16_bf16(af, b0, c0, 0, 0, 0); c1 = __builtin_amdgcn_mfma_f32_32x32x16_bf16(af, b1, c1, 0, 0, 0); }
          const int d = tid >> 2, part = tid & 3; const LAS bf16x8* kp = (const LAS bf16x8*)(lds + KST + d * 144 + part * 32); float ks = 0.f;
#pragma unroll
          for (int i = 0; i < 2; ++i) { const bf16x8 v8 = kp[i];
#pragma unroll
              for (int e = 0; e < 8; ++e) ks += bf2f((bf16)v8[e]); }
          ks += __shfl_xor(ks, 1); ks += __shfl_xor(ks, 2);
          if (part == 0) nn_next[d] = dc * nn[d] + ks; }
        LBAR();
#pragma unroll
        for (int vj = 0; vj < 4; ++vj)
#pragma unroll
            for (int r = 0; r < 4; ++r) asm volatile("" : "+v"(orr[vj][r]));
#pragma unroll
        for (int r = 0; r < 4; ++r) { const int t = ti * 16 + 4 * q4 + r; const float rstd = __builtin_amdgcn_rsqf((((LAS float*)(lds + SSQP))[t] + ((LAS float*)(lds + SSQP))[64 + t]) * (1.f / 128.f) + EPS);
#pragma unroll
            for (int vj = 0; vj < 4; ++vj) { const int v = vbase + vj * 16 + c16;
                __builtin_amdgcn_raw_buffer_store_b16((bf16)f2bf(ha[vj][r] * rstd * nw[v] * sigmoidf_(bf2f((bf16)orr[vj][r]))), ryc, voffyc + vj * 32, (rowbase + t0 + r) * (MIXW * 2), 0); } }
        if (c + 1 < NCH) {
#pragma unroll
            for (int vj = 0; vj < 4; ++vj)
#pragma unroll
                for (int r = 0; r < 4; ++r) orr[vj][r] = __builtin_amdgcn_raw_buffer_load_b16(ru, voffo + vj * 32, (rowbase + t0 + L + r) * ROWB, 0); }
#pragma unroll
        for (int r = 0; r < 16; ++r) { const int v = vi * 32 + crow32(r, lane >> 5);
            *(LAS bf16*)(lds + CBF + v * 272 + (di0 * 32 + (lane & 31)) * 2) = (bf16)f2bf(c0[r]); *(LAS bf16*)(lds + CBF + v * 272 + ((di0 + 1) * 32 + (lane & 31)) * 2) = (bf16)f2bf(c1[r]); }
    }
    { float* co = OUTP() + O_P_MC + (((size_t)l * NB_P + b) * 4 + h) * 16384;
#pragma unroll
      for (int r = 0; r < 16; ++r) { const int v = vi * 32 + crow32(r, lane >> 5); co[v * 128 + di0 * 32 + (lane & 31)] = c0[r]; co[v * 128 + (di0 + 1) * 32 + (lane & 31)] = c1[r]; }
      if (tid < 128) OUTP()[O_P_MN + (((size_t)l * NB_P + b) * 4 + h) * 128 + tid] = ((LAS float*)(lds + NN))[(NCH & 1) * 128 + tid];
      if (tid == 0) OUTP()[O_P_MM + ((size_t)l * NB_P + b) * 4 + h] = ((const LAS float*)(lds + GSUM))[64 + NCH]; }
    __syncthreads();
}

__device__ __forceinline__ void mlstm_passA(Frame& F, int l, int b, int h, int flagset) {
    constexpr int L = 64, NCH = SEQ_P / L;
    constexpr int KST = 0, VST = 18432, GT = 36864, GSUM = GT + NCH * 768, NN = GSUM + 512;
    constexpr float KSCALE = 0.08838834764831845f;
    const int tid = F.tid, lane = F.lane, w = F.wave, rowbase = b * SEQ_P;
    LAS unsigned char* lds = F.lds;
    const float* gates = P_GATES;
    const float ib = INP(I_MIB)[l * 4 + h], fb = INP(I_MFB)[l * 4 + h];
    const int dp = tid & 63, sg = tid >> 6;
    unsigned rkt[8], rvt[8];
    const rsrc_t ru = U_RSRC();
    const int voffk = ((8 * sg + 3) * NU + UC_K + h * 128 + 2 * dp) * 2;
    auto prefetch = [&](int c) {
        const int sb = (rowbase + c * L) * ROWB;
#pragma unroll
        for (int i = 0; i < 8; ++i) { rkt[i] = __builtin_amdgcn_raw_buffer_load_b32(ru, voffk, sb + i * ROWB, 0); rvt[i] = __builtin_amdgcn_raw_buffer_load_b32(ru, voffk + 1024, sb + i * ROWB, 0); }
    };
    for (int c = w; c < NCH; c += NWAVES) {
        LAS float* gtw = (LAS float*)(lds + GT) + c * 192; LAS float* gs = (LAS float*)(lds + GSUM);
        const size_t row = (size_t)(rowbase + c * L + lane);
        const float ig = gates[row * NG + 16 + h] + ib, lf = -softplusf_(-(gates[row * NG + 20 + h] + fb));
        float bc = lf;
#pragma unroll
        for (int o = 1; o < 64; o <<= 1) { const float y = __shfl_up(bc, o); if (lane >= o) bc += y; }
        const float e = ig - bc; float pm = e;
#pragma unroll
        for (int o = 1; o < 64; o <<= 1) { const float y = __shfl_up(pm, o); if (lane >= o) pm = fmaxf(pm, y); }
        gtw[lane] = e; gtw[64 + lane] = bc; gtw[128 + lane] = pm;
        if (lane == 63) { gs[c] = bc; gs[32 + c] = pm; }
    }
    LBAR();
    if (tid == 0) { LAS float* gs = (LAS float*)(lds + GSUM); float* mg = P_MLG + (size_t)(b * 4 + h) * 40; float mp = 0.f;
        for (int c = 0; c < NCH; ++c) { gs[64 + c] = mp; mg[c] = mp; mp = gs[c] + fmaxf(mp, gs[32 + c]); } gs[64 + NCH] = mp; }
    f32x16 c0, c1; for (int r = 0; r < 16; ++r) { c0[r] = 0.f; c1[r] = 0.f; }
    if (tid < 256) ((LAS float*)(lds + NN))[tid] = 0.f;
    prefetch(0);
    LBAR();
    const int vi = w >> 1, di0 = 2 * (w & 1);
    bf16* cin = P_CIN + (size_t)(b * 4 + h) * NCH * 16384; float* nin = P_NIN + (size_t)(b * 4 + h) * NCH * 128;
    for (int c = 0; c < NCH; ++c) {
        const LAS float* gt = (const LAS float*)(lds + GT) + c * 192;
        const float mpv = ((const LAS float*)(lds + GSUM))[64 + c], pml = fmaxf(mpv, ((const LAS float*)(lds + GSUM))[32 + c]);
        const LAS float* nn = (const LAS float*)(lds + NN) + (c & 1) * 128; LAS float* nn_next = (LAS float*)(lds + NN) + ((c + 1) & 1) * 128;
#pragma unroll
        for (int r = 0; r < 16; ++r) { bf16* cp = cin + (size_t)c * 16384 + (vi * 32 + crow32(r, lane >> 5)) * 128 + di0 * 32 + (lane & 31); cp[0] = (bf16)f2bf(c0[r]); cp[32] = (bf16)f2bf(c1[r]); }
        if (tid < 128) nin[c * 128 + tid] = nn[tid];
        { float k0[8], k1[8];
#pragma unroll
          for (int i = 0; i < 8; ++i) { const float ws = fexp(gt[8 * sg + i] - pml) * KSCALE; k0[i] = lo_bf(rkt[i]) * ws; k1[i] = hi_bf(rkt[i]) * ws; }
          *(LAS v4u*)(lds + KST + (2 * dp) * 144 + 16 * sg) = (v4u){pk2(k0[0], k0[1]), pk2(k0[2], k0[3]), pk2(k0[4], k0[5]), pk2(k0[6], k0[7])};
          *(LAS v4u*)(lds + KST + (2 * dp + 1) * 144 + 16 * sg) = (v4u){pk2(k1[0], k1[1]), pk2(k1[2], k1[3]), pk2(k1[4], k1[5]), pk2(k1[6], k1[7])};
          *(LAS v4u*)(lds + VST + (2 * dp) * 144 + 16 * sg) = (v4u){(rvt[0] & 0xffffu) | (rvt[1] << 16), (rvt[2] & 0xffffu) | (rvt[3] << 16), (rvt[4] & 0xffffu) | (rvt[5] << 16), (rvt[6] & 0xffffu) | (rvt[7] << 16)};
          *(LAS v4u*)(lds + VST + (2 * dp + 1) * 144 + 16 * sg) = (v4u){(rvt[0] >> 16) | (rvt[1] & 0xffff0000u), (rvt[2] >> 16) | (rvt[3] & 0xffff0000u), (rvt[4] >> 16) | (rvt[5] & 0xffff0000u), (rvt[6] >> 16) | (rvt[7] & 0xffff0000u)}; }
        if (c + 1 < NCH) prefetch(c + 1);
        LBAR();
        { const float dc = fexp(mpv - pml);
#pragma unroll
          for (int r = 0; r < 16; ++r) { c0[r] *= dc; c1[r] *= dc; }
#pragma unroll
          for (int kk = 0; kk < 4; ++kk) { const bf16x8 af = frag32(lds + VST, 144, vi * 32, kk, lane);
              const bf16x8 b0 = frag32(lds + KST, 144, di0 * 32, kk, lane), b1 = frag32(lds + KST, 144, (di0 + 1) * 32, kk, lane);
              c0 = __builtin_amdgcn_mfma_f32_32x32x16_bf16(af, b0, c0, 0, 0, 0); c1 = __builtin_amdgcn_mfma_f32_32x32x16_bf16(af, b1, c1, 0, 0, 0); }
          const int d = tid >> 2, part = tid & 3; const LAS bf16x8* kp = (const LAS bf16x8*)(lds + KST + d * 144 + part * 32); float ks = 0.f;
#pragma unroll
          for (int i = 0; i < 2; ++i) { const bf16x8 v8 = kp[i];
#pragma unroll
              for (int e = 0; e < 8; ++e) ks += bf2f((bf16)v8[e]); }
          ks += __shfl_xor(ks, 1); ks += __shfl_xor(ks, 2);
          if (part == 0) nn_next[d] = dc * nn[d] + ks; }
        LBAR();
    }
    { float* co = OUTP() + O_P_MC + (((size_t)l * NB_P + b) * 4 + h) * 16384;
#pragma unroll
      for (int r = 0; r < 16; ++r) { const int v = vi * 32 + crow32(r, lane >> 5); co[v * 128 + di0 * 32 + (lane & 31)] = c0[r]; co[v * 128 + (di0 + 1) * 32 + (lane & 31)] = c1[r]; }
      if (tid < 128) OUTP()[O_P_MN + (((size_t)l * NB_P + b) * 4 + h) * 128 + tid] = ((LAS float*)(lds + NN))[(NCH & 1) * 128 + tid];
      if (tid == 0) OUTP()[O_P_MM + ((size_t)l * NB_P + b) * 4 + h] = ((const LAS float*)(lds + GSUM))[64 + NCH]; }
    asm volatile("s_waitcnt vmcnt(0)" ::: "memory");
    LBAR();
    if (tid == 0) { __builtin_amdgcn_fence(__ATOMIC_RELEASE, "agent"); asm volatile("s_waitcnt vmcnt(0)" ::: "memory");
        __hip_atomic_store(P_CTL + CW_FLAG + 64 * ((flagset * 2 + l) * 32 + b * 4 + h), 1u, __ATOMIC_RELAXED, __HIP_MEMORY_SCOPE_AGENT); }
    LBAR();
}
__device__ __forceinline__ void mlstm_passB(Frame& F, int l, int b, int h, int c, int flagset) {
    constexpr int L = 64, NCH = SEQ_P / L;
    constexpr int QS = 0, KS = 17408, VST = 34816, WS = 53248, CBF = 62464, GT = 97280, NN = 98304, SSQP = 98816;
    constexpr float KSCALE = 0.08838834764831845f;
    const int tid = F.tid, lane = F.lane, w = F.wave, rowbase = b * SEQ_P, t0 = c * L;
    LAS unsigned char* lds = F.lds;
    const float* gates = P_GATES; bf16* YC = P_YCAT;
    const float ib = INP(I_MIB)[l * 4 + h], fb = INP(I_MFB)[l * 4 + h];
    const int dp = tid & 63, sg = tid >> 6;
    const rsrc_t ru = U_RSRC(); const rsrc_t ryc = mk_rsrc(YC, (unsigned)((size_t)MT * MIXW * 2));
    const int voffq = (((tid >> 4) + 3) * NU + UC_Q + h * 128 + (tid & 15) * 8) * 2, voffk = ((8 * sg + 3) * NU + UC_K + h * 128 + 2 * dp) * 2;
    const int ti = w >> 1, sj0 = 2 * (w & 1), vbase = (w & 1) * 64, q4 = lane >> 4, c16 = lane & 15;
    const float* nw = INP(I_MNW) + l * 512 + h * 128;
    const int voffo = ((ti * 16 + 4 * q4 + 3) * NU + UC_O + h * 128 + vbase + c16) * 2, voffyc = ((ti * 16 + 4 * q4) * MIXW + 1024 + h * 128 + vbase + c16) * 2;
    const int sb = (rowbase + t0) * ROWB;
    float nwv[4];
#pragma unroll
    for (int vj = 0; vj < 4; ++vj) nwv[vj] = nw[vbase + vj * 16 + c16];
    if (flagset >= 0) {
        if (tid == 0) { unsigned* fl = P_CTL + CW_FLAG + 64 * ((flagset * 2 + l) * 32 + b * 4 + h); unsigned spins = 0;
            while (__hip_atomic_load(fl, __ATOMIC_RELAXED, __HIP_MEMORY_SCOPE_AGENT) == 0u) { __builtin_amdgcn_s_sleep(8); if (++spins > (1u << 22)) break; }
            __builtin_amdgcn_fence(__ATOMIC_ACQUIRE, "agent"); asm volatile("s_waitcnt vmcnt(0)" ::: "memory"); }
        LBAR(); }
    v4u rq[2], rk4[2], rc[4]; unsigned rvt[8], orr[4][4];
#pragma unroll
    for (int i = 0; i < 2; ++i) { rq[i] = __builtin_amdgcn_raw_buffer_load_b128(ru, voffq, sb + 32 * i * ROWB, 0); rk4[i] = __builtin_amdgcn_raw_buffer_load_b128(ru, voffq + 1024, sb + 32 * i * ROWB, 0); }
#pragma unroll
    for (int i = 0; i < 8; ++i) rvt[i] = __builtin_amdgcn_raw_buffer_load_b32(ru, voffk + 1024, sb + i * ROWB, 0);
    { const v4u* cin = (const v4u*)(P_CIN + ((size_t)(b * 4 + h) * NCH + c) * 16384);
#pragma unroll
      for (int i = 0; i < 4; ++i) rc[i] = cin[tid + NTHR * i]; }
    const float mpv = P_MLG[(size_t)(b * 4 + h) * 40 + c];
    if (w == 0) { LAS float* gtw = (LAS float*)(lds + GT);
        const size_t row = (size_t)(rowbase + t0 + lane);
        const float ig = gates[row * NG + 16 + h] + ib, lf = -softplusf_(-(gates[row * NG + 20 + h] + fb));
        float bc = lf;
#pragma unroll
        for (int o = 1; o < 64; o <<= 1) { const float y = __shfl_up(bc, o); if (lane >= o) bc += y; }
        const float e = ig - bc; float pm = e;
#pragma unroll
        for (int o = 1; o < 64; o <<= 1) { const float y = __shfl_up(pm, o); if (lane >= o) pm = fmaxf(pm, y); }
        gtw[lane] = e; gtw[64 + lane] = bc; gtw[128 + lane] = pm; }
    if (tid < 128) ((LAS float*)(lds + NN))[tid] = P_NIN[((size_t)(b * 4 + h) * NCH + c) * 128 + tid];
#pragma unroll
    for (int vj = 0; vj < 4; ++vj)
#pragma unroll
        for (int r = 0; r < 4; ++r) orr[vj][r] = __builtin_amdgcn_raw_buffer_load_b16(ru, voffo + vj * 32, (rowbase + t0 + r) * ROWB, 0);
#pragma unroll
    for (int i = 0; i < 2; ++i) { const int id = tid + NTHR * i, row = id >> 4, ch = id & 15; *(LAS v4u*)(lds + QS + row * 272 + ch * 16) = rq[i]; *(LAS v4u*)(lds + KS + row * 272 + ch * 16) = rk4[i]; }
    *(LAS v4u*)(lds + VST + (2 * dp) * 144 + 16 * sg) = (v4u){(rvt[0] & 0xffffu) | (rvt[1] << 16), (rvt[2] & 0xffffu) | (rvt[3] << 16), (rvt[4] & 0xffffu) | (rvt[5] << 16), (rvt[6] & 0xffffu) | (rvt[7] << 16)};
    *(LAS v4u*)(lds + VST + (2 * dp + 1) * 144 + 16 * sg) = (v4u){(rvt[0] >> 16) | (rvt[1] & 0xffff0000u), (rvt[2] >> 16) | (rvt[3] & 0xffff0000u), (rvt[4] >> 16) | (rvt[5] & 0xffff0000u), (rvt[6] >> 16) | (rvt[7] & 0xffff0000u)};
#pragma unroll
    for (int i = 0; i < 4; ++i) { const int id = tid + NTHR * i, row = id >> 4, ch = id & 15; *(LAS v4u*)(lds + CBF + row * 272 + ch * 16) = rc[i]; }
    LBAR();
    const LAS float* gt = (const LAS float*)(lds + GT); const LAS float* nn = (const LAS float*)(lds + NN);
    {
        { f32x4 sa[2] = {{0.f, 0.f, 0.f, 0.f}, {0.f, 0.f, 0.f, 0.f}};
#pragma unroll
          for (int kk = 0; kk < 4; ++kk) { const bf16x8 af = frag16(lds + QS, 272, ti * 16, kk, lane);
#pragma unroll
              for (int jj = 0; jj < 2; ++jj) { const bf16x8 bfr = frag16(lds + KS, 272, (sj0 + jj) * 16, kk, lane); sa[jj] = __builtin_amdgcn_mfma_f32_16x16x32_bf16(af, bfr, sa[jj], 0, 0, 0); } }
          float pt[4];
#pragma unroll
          for (int r = 0; r < 4; ++r) pt[r] = fmaxf(mpv, gt[128 + ti * 16 + 4 * q4 + r]);
#pragma unroll
          for (int jj = 0; jj < 2; ++jj) { const int s = (sj0 + jj) * 16 + c16; const float es = gt[s];
#pragma unroll
              for (int r = 0; r < 4; ++r) { const int t = ti * 16 + 4 * q4 + r; const float v = s <= t ? sa[jj][r] * KSCALE * fexp(es - pt[r]) : 0.f;
                  *(LAS bf16*)(lds + WS + t * 144 + s * 2) = (bf16)f2bf(v); } } }
    }
    LBAR();
    f32x4 ha[4];
    {
        { const int trow = ti * 16 + c16;
          float dsum = 0.f, qn = 0.f;
          { const LAS bf16x8* wp = (const LAS bf16x8*)(lds + WS + trow * 144 + q4 * 32);
#pragma unroll
            for (int i = 0; i < 2; ++i) { const bf16x8 v8 = wp[i];
#pragma unroll
                for (int e = 0; e < 8; ++e) dsum += bf2f((bf16)v8[e]); }
            const LAS bf16x8* qp = (const LAS bf16x8*)(lds + QS + trow * 272 + q4 * 64); const LAS f32x4* np = (const LAS f32x4*)(nn + q4 * 32);
#pragma unroll
            for (int i = 0; i < 4; ++i) { const bf16x8 v8 = qp[i]; const f32x4 n0 = np[2 * i], n1 = np[2 * i + 1];
                qn += bf2f((bf16)v8[0]) * n0.x + bf2f((bf16)v8[1]) * n0.y + bf2f((bf16)v8[2]) * n0.z + bf2f((bf16)v8[3]) * n0.w
                    + bf2f((bf16)v8[4]) * n1.x + bf2f((bf16)v8[5]) * n1.y + bf2f((bf16)v8[6]) * n1.z + bf2f((bf16)v8[7]) * n1.w; } }
          dsum += __shfl_xor(dsum, 16); dsum += __shfl_xor(dsum, 32); qn += __shfl_xor(qn, 16); qn += __shfl_xor(qn, 32);
          const float pmt = fmaxf(mpv, gt[128 + trow]); const float dfull = dsum + fexp(mpv - pmt) * qn, dent = fmaxf(fabsf(dfull), fexp(-(gt[64 + trow] + pmt)));
          float dr[4], it4[4];
#pragma unroll
          for (int r = 0; r < 4; ++r) { dr[r] = frcp(__shfl(dent, 4 * q4 + r)); it4[r] = fexp(mpv - fmaxf(mpv, gt[128 + ti * 16 + 4 * q4 + r])); }
#pragma unroll
          for (int vj = 0; vj < 4; ++vj) ha[vj] = (f32x4){0.f, 0.f, 0.f, 0.f};
#pragma unroll
          for (int kk = 0; kk < 4; ++kk) { const bf16x8 af = frag16(lds + QS, 272, ti * 16, kk, lane);
#pragma unroll
              for (int vj = 0; vj < 4; ++vj) { const bf16x8 bfr = frag16(lds + CBF, 272, vbase + vj * 16, kk, lane); ha[vj] = __builtin_amdgcn_mfma_f32_16x16x32_bf16(af, bfr, ha[vj], 0, 0, 0); } }
#pragma unroll
          for (int vj = 0; vj < 4; ++vj)
#pragma unroll
              for (int r = 0; r < 4; ++r) ha[vj][r] *= it4[r];
#pragma unroll
          for (int kk = 0; kk < 2; ++kk) { const bf16x8 af = frag16(lds + WS, 144, ti * 16, kk, lane);
#pragma unroll
              for (int vj = 0; vj < 4; ++vj) { const bf16x8 bfr = frag16(lds + VST, 144, vbase + vj * 16, kk, lane); ha[vj] = __builtin_amdgcn_mfma_f32_16x16x32_bf16(af, bfr, ha[vj], 0, 0, 0); } }
          float sq[4] = {0.f, 0.f, 0.f, 0.f};
#pragma unroll
          for (int vj = 0; vj < 4; ++vj)
#pragma unroll
              for (int r = 0; r < 4; ++r) { ha[vj][r] = ha[vj][r] * dr[r]; sq[r] += ha[vj][r] * ha[vj][r]; }
#pragma unroll
          for (int r = 0; r < 4; ++r) { float v = sq[r]; v += __shfl_xor(v, 1); v += __shfl_xor(v, 2); v += __shfl_xor(v, 4); v += __shfl_xor(v, 8);
              if (c16 == 0) ((LAS float*)(lds + SSQP))[(w & 1) * 64 + ti * 16 + 4 * q4 + r] = v; } }
    }
    LBAR();
    {
#pragma unroll
        for (int vj = 0; vj < 4; ++vj)
#pragma unroll
            for (int r = 0; r < 4; ++r) asm volatile("" : "+v"(orr[vj][r]));
#pragma unroll
        for (int r = 0; r < 4; ++r) { const int t = ti * 16 + 4 * q4 + r; const float rstd = __builtin_amdgcn_rsqf((((LAS float*)(lds + SSQP))[t] + ((LAS float*)(lds + SSQP))[64 + t]) * (1.f / 128.f) + EPS);
#pragma unroll
            for (int vj = 0; vj < 4; ++vj) { const int v = vbase + vj * 16 + c16;
                __builtin_amdgcn_raw_buffer_store_b16((bf16)f2bf(ha[vj][r] * rstd * nwv[vj] * sigmoidf_(bf2f((bf16)orr[vj][r]))), ryc, voffyc + vj * 32, (rowbase + t0 + r) * (MIXW * 2), 0); } }
    }
    LBAR();
}

__device__ __forceinline__ void lru_prompt_item(Frame& F, int l, int b, int kb, int dh) {
    constexpr int L = 128, NCH = SEQ_P / L;
    constexpr int WAT = 0, WXT = 17408, XC = 34816, COMP = 69632;
    const int tid = F.tid, lane = F.lane, w = F.wave, rowbase = b * SEQ_P;
    LAS unsigned char* lds = F.lds;
    const int di = w & 1, tq = w >> 1, hi = lane >> 5, dloc = di * 32 + (lane & 31), ch = kb * 128 + dh * 64 + dloc;
    const rsrc_t ru = U_RSRC(); const rsrc_t ryc = mk_rsrc(P_YCAT, (unsigned)((size_t)MT * MIXW * 2));
    { const int d = tid & 63, cg = tid >> 6; const float* wa = INP(I_LWA) + (((size_t)l * 4 + kb) * 128 + cg * 16) * 128 + dh * 64 + d; const float* wx = INP(I_LWX) + (((size_t)l * 4 + kb) * 128 + cg * 16) * 128 + dh * 64 + d;
      float va[16], vx[16];
#pragma unroll
      for (int i = 0; i < 16; ++i) { va[i] = wa[i * 128]; vx[i] = wx[i * 128]; }
      *(LAS v4u*)(lds + WAT + d * 272 + cg * 32) = (v4u){pk2(va[0], va[1]), pk2(va[2], va[3]), pk2(va[4], va[5]), pk2(va[6], va[7])};
      *(LAS v4u*)(lds + WAT + d * 272 + cg * 32 + 16) = (v4u){pk2(va[8], va[9]), pk2(va[10], va[11]), pk2(va[12], va[13]), pk2(va[14], va[15])};
      *(LAS v4u*)(lds + WXT + d * 272 + cg * 32) = (v4u){pk2(vx[0], vx[1]), pk2(vx[2], vx[3]), pk2(vx[4], vx[5]), pk2(vx[6], vx[7])};
      *(LAS v4u*)(lds + WXT + d * 272 + cg * 32 + 16) = (v4u){pk2(vx[8], vx[9]), pk2(vx[10], vx[11]), pk2(vx[12], vx[13]), pk2(vx[14], vx[15])}; }
    const int pc = tid & 63, gq = tid >> 6;
    float cw[4][2], cb[2];
#pragma unroll
    for (int e = 0; e < 2; ++e) { cb[e] = INP(I_LCB)[l * LRUW + kb * 128 + 2 * pc + e];
#pragma unroll
        for (int j = 0; j < 4; ++j) cw[j][e] = INP(I_LCW)[((size_t)l * 4 + j) * LRUW + kb * 128 + 2 * pc + e]; }
    const float ba = INP(I_LBA)[l * LRUW + ch], bx = INP(I_LBX)[l * LRUW + ch], spl8 = 8.f * softplusf_(-INP(I_LLAM)[l * LRUW + ch]);
    const int voffs = (16 * gq * NU + UC_XR + kb * 128 + 2 * pc) * 2;
    const int voffg = ((tq * 32 + 4 * hi + 3) * NU + UC_GR + ch) * 2, voffy = ((tq * 32 + 4 * hi) * MIXW + 1536 + ch) * 2;
    unsigned rs[19];
    auto prefetch = [&](int c) {
        const int sb = (rowbase + c * L) * ROWB;
#pragma unroll
        for (int i = 0; i < 19; ++i) { rs[i] = __builtin_amdgcn_raw_buffer_load_b32(ru, voffs, sb + i * ROWB, 0); if (c == 0 && 16 * gq + i < 3) rs[i] = 0u; }
    };
    float hcar = 0.f;
    prefetch(0);
    unsigned gr[16];
#pragma unroll
    for (int r = 0; r < 16; ++r) gr[r] = __builtin_amdgcn_raw_buffer_load_b16(ru, voffg, (rowbase + (r & 3) + 8 * (r >> 2)) * ROWB, 0);
    for (int c = 0; c < NCH; ++c) {
        const int t0 = c * L;
#pragma unroll
        for (int i = 0; i < 16; ++i) { float a0 = cb[0], a1 = cb[1];
#pragma unroll
            for (int j = 0; j < 4; ++j) { a0 += cw[j][0] * lo_bf(rs[i + j]); a1 += cw[j][1] * hi_bf(rs[i + j]); }
            *(LAS unsigned*)(lds + XC + (16 * gq + i) * 272 + 4 * pc) = pk2(a0, a1); }
        if (c + 1 < NCH) prefetch(c + 1);
        LBAR();
        f32x16 ra, ri; for (int r = 0; r < 16; ++r) { ra[r] = 0.f; ri[r] = 0.f; }
#pragma unroll
        for (int kk = 0; kk < 8; ++kk) { const bf16x8 af = frag32(lds + XC, 272, tq * 32, kk, lane);
            const bf16x8 b0 = frag32(lds + WAT, 272, di * 32, kk, lane), b1 = frag32(lds + WXT, 272, di * 32, kk, lane);
            ra = __builtin_amdgcn_mfma_f32_32x32x16_bf16(af, b0, ra, 0, 0, 0); ri = __builtin_amdgcn_mfma_f32_32x32x16_bf16(af, b1, ri, 0, 0, 0); }
#pragma unroll
        for (int r = 0; r < 16; ++r) { const int t = tq * 32 + crow32(r, hi);
            const float rg = frcp(1.f + fexp(-(ra[r] + ba))), ig = frcp(1.f + fexp(-(ri[r] + bx))), la = -spl8 * rg, x2 = 2.f * la;
            const float av = fexp(la), om = x2 > -0.03f ? -x2 * (1.f + x2 * (0.5f + x2 * (0.16666667f + x2 * 0.041666668f))) : 1.f - av * av;
            float mult = __builtin_amdgcn_sqrtf(om); if (c == 0 && t == 0) mult = 1.f;
            const float xcv = bf2f(*(const LAS bf16*)(lds + XC + t * 272 + (dh * 64 + dloc) * 2));
            ra[r] = av; ri[r] = mult * ig * xcv; }
        float GA[4], GB[4], OA[4], OB[4], PA[4], PB[4];
#pragma unroll
        for (int g = 0; g < 4; ++g) { const float a0 = ra[4 * g], a1 = ra[4 * g + 1], a2 = ra[4 * g + 2], a3 = ra[4 * g + 3];
            GA[g] = (a0 * a1) * (a2 * a3); GB[g] = ((ri[4 * g] * a1 + ri[4 * g + 1]) * a2 + ri[4 * g + 2]) * a3 + ri[4 * g + 3];
            OA[g] = __shfl_xor(GA[g], 32); OB[g] = __shfl_xor(GB[g], 32); }
        float TA = 1.f, TB = 0.f;
#pragma unroll
        for (int g = 0; g < 4; ++g) {
            const float A0 = hi ? OA[g] : GA[g], B0 = hi ? OB[g] : GB[g], A1 = hi ? GA[g] : OA[g], B1 = hi ? GB[g] : OB[g];
            const float eA = TA, eB = TB; TB = A0 * TB + B0; TA = A0 * TA;
            const float oA = TA, oB = TB; TB = A1 * TB + B1; TA = A1 * TA;
            PA[g] = hi ? oA : eA; PB[g] = hi ? oB : eB; }
        if (hi == 0) { LAS float* cp = (LAS float*)(lds + COMP) + (tq * 64 + dloc) * 2; cp[0] = TA; cp[1] = TB; }
        LBAR();
        float hin = hcar, hall = hcar;
#pragma unroll
        for (int q = 0; q < 4; ++q) { const LAS float* cp = (const LAS float*)(lds + COMP) + (q * 64 + dloc) * 2; const float qa = cp[0], qb = cp[1];
            hall = qa * hall + qb; if (q < tq) hin = hall; }
        hcar = hall;
#pragma unroll
        for (int r = 0; r < 16; ++r) asm volatile("" : "+v"(gr[r]));
#pragma unroll
        for (int g = 0; g < 4; ++g) { float hv = PA[g] * hin + PB[g];
#pragma unroll
            for (int j = 0; j < 4; ++j) { const int r = 4 * g + j; hv = ra[r] * hv + ri[r];
                const float x = bf2f((bf16)gr[r]), u = 0.7978845608028654f * (x + 0.044715f * x * x * x), th = 1.f - 2.f * frcp(fexp(2.f * u) + 1.f);
                __builtin_amdgcn_raw_buffer_store_b16((bf16)f2bf(hv * 0.5f * x * (1.f + th)), ryc, voffy, (rowbase + t0 + (r & 3) + 8 * (r >> 2)) * (MIXW * 2), 0); } }
        if (c + 1 < NCH) {
#pragma unroll
            for (int r = 0; r < 16; ++r) gr[r] = __builtin_amdgcn_raw_buffer_load_b16(ru, voffg, (rowbase + t0 + L + (r & 3) + 8 * (r >> 2)) * ROWB, 0); }
    }
    if (tq == 0 && hi == 0) OUTP()[O_P_LH + ((size_t)l * NB_P + b) * LRUW + ch] = hcar;
    if (tid < 192) { const int j = tid >> 6, dd = tid & 63, cc = kb * 128 + dh * 64 + dd;
        OUTP()[O_P_LCONV + (((size_t)l * NB_P + b) * 3 + j) * LRUW + cc] = bf2f(P_U[(size_t)(rowbase + SEQ_P - 3 + j) * NU + UC_XR + cc]); }
    LBAR();
}

__device__ __forceinline__ void ssd_sample_item(Frame& F, int l, int b, int g) {
    const int tid = F.tid, rowbase = MP + b * SEQ_S, p = tid >> 3, nq = tid & 7, n0 = nq * 16;
    LAS float* xs = (LAS float*)F.lds; LAS float* Bm = xs + 8 * 512; LAS float* Cm = Bm + 1024; LAS float* dts = Cm + 1024; LAS float* dAs = dts + 64; LAS float* ybuf = dAs + 64;
    const bf16* U = P_U; const float* gates = P_GATES; bf16* YC = P_YCAT; const float* snw = INP(I_SNW) + l * 1024;
    { const float* cw = INP(I_SCW) + (size_t)l * 4 * CONVD; const float* cb = INP(I_SCB) + (size_t)l * CONVD; const float* hist = INP(I_SCONV) + ((size_t)l * NB_S + b) * 3 * CONVD;
#pragma unroll
      for (int k = 0; k < 2; ++k) { const int ci = tid + NTHR * k;
          if (ci < 768) { const int c = ci < 512 ? g * 512 + ci : (ci < 640 ? 1024 + g * 128 + (ci - 512) : 1280 + g * 128 + (ci - 640));
              float v[11];
#pragma unroll
              for (int j = 0; j < 3; ++j) v[j] = hist[j * CONVD + c];
#pragma unroll
              for (int t = 0; t < 8; ++t) v[3 + t] = bf2f(U[(size_t)(rowbase + t) * NU + UC_XBC + c]);
              const float w0 = cw[c], w1 = cw[CONVD + c], w2 = cw[2 * CONVD + c], w3 = cw[3 * CONVD + c], bb = cb[c];
#pragma unroll
              for (int t = 0; t < 8; ++t) { const float act = siluf_(bb + w0 * v[t] + w1 * v[t + 1] + w2 * v[t + 2] + w3 * v[t + 3]);
                  if (ci < 512) xs[t * 512 + ci] = act; else if (ci < 640) Bm[t * 128 + ci - 512] = act; else Cm[t * 128 + ci - 640] = act; } } } }
    if (tid < 64) { const int hh = tid >> 3, tt = tid & 7, h = g * 8 + hh; const float dt = softplusf_(gates[(size_t)(rowbase + tt) * NG + h] + INP(I_DTB)[l * 16 + h]);
        dts[tid] = dt; dAs[tid] = fexp(-dt * fexp(INP(I_ALOG)[l * 16 + h])); }
    const f32x4* sin = (const f32x4*)(INP(I_SSM) + ((((size_t)l * NB_S + b) * 16 + g * 8) * 64 + p) * 128) + nq;
    f32x4* sout = (f32x4*)(OUTP() + O_S_SSM + ((((size_t)l * NB_S + b) * 16 + g * 8) * 64 + p) * 128) + nq;
    LAS float* zbuf = ybuf + 4096; LAS float* nwbuf = zbuf + 8 * 512; LAS float* dbuf = nwbuf + 512;
#pragma unroll
    for (int hh = 0; hh < 8; ++hh) zbuf[hh * 512 + tid] = bf2f(U[(size_t)(rowbase + nq) * NU + UC_Z + (g * 8 + hh) * 64 + p]);
    nwbuf[tid] = snw[g * 512 + tid]; if (tid < 8) dbuf[tid] = INP(I_SSD_D)[l * 16 + g * 8 + tid];
    f32x4 Sn[4], Sm[4];
#pragma unroll
    for (int j = 0; j < 4; ++j) { Sn[j] = sin[8 * j]; Sm[j] = sin[2048 + 8 * j]; }
    LBAR();
#pragma unroll 2
    for (int hh = 0; hh < 8; ++hh) {
        const int h = g * 8 + hh;
        float S[16];
#pragma unroll
        for (int j = 0; j < 4; ++j) { S[4 * j] = Sn[j].x; S[4 * j + 1] = Sn[j].y; S[4 * j + 2] = Sn[j].z; S[4 * j + 3] = Sn[j].w; Sn[j] = Sm[j]; }
        if (hh < 6) {
#pragma unroll
            for (int j = 0; j < 4; ++j) Sm[j] = sin[(hh + 2) * 2048 + 8 * j]; }
        const float zv = zbuf[hh * 512 + tid];
        float ymine = 0.f;
#pragma unroll
        for (int tt = 0; tt < 8; ++tt) {
            const float dt = dts[hh * 8 + tt], dA = dAs[hh * 8 + tt], dx = dt * xs[tt * 512 + hh * 64 + p]; float part = 0.f;
#pragma unroll
            for (int j = 0; j < 16; ++j) { const int n = ((j >> 2) * 8 + nq) * 4 + (j & 3); S[j] = dA * S[j] + dx * Bm[tt * 128 + n]; part += Cm[tt * 128 + n] * S[j]; }
            part += __shfl_xor(part, 1); part += __shfl_xor(part, 2); part += __shfl_xor(part, 4);
            ymine = (nq == tt) ? part : ymine; }
        { const float y = ymine + dbuf[hh] * xs[nq * 512 + hh * 64 + p], yz = y * siluf_(zv);
          YC[(size_t)(rowbase + nq) * MIXW + h * 64 + p] = (bf16)f2bf(yz * nwbuf[hh * 64 + p]); ybuf[(hh * 8 + nq) * 64 + p] = yz; }
#pragma unroll
        for (int j = 0; j < 4; ++j) sout[hh * 2048 + 8 * j] = (f32x4){S[4 * j], S[4 * j + 1], S[4 * j + 2], S[4 * j + 3]};
    }
    LBAR();
    { const int pr = tid >> 3, part = tid & 7, hh = pr >> 3, tt = pr & 7; float s = 0.f;
#pragma unroll
      for (int j = 0; j < 8; ++j) { const float y = ybuf[pr * 64 + part * 8 + j]; s += y * y; }
      s += __shfl_xor(s, 1); s += __shfl_xor(s, 2); s += __shfl_xor(s, 4);
      if (part == 0) P_SSQ[(size_t)(rowbase + tt) * 16 + g * 8 + hh] = s; }
    if (g == 0) { float* co = OUTP() + O_S_SCONV + ((size_t)l * NB_S + b) * 3 * CONVD;
        for (int idx = tid; idx < 3 * CONVD; idx += NTHR) { const int j = idx / CONVD, c = idx % CONVD; co[idx] = bf2f(U[(size_t)(rowbase + SEQ_S - 3 + j) * NU + UC_XBC + c]); } }
    LBAR();
}

__device__ __forceinline__ void mlstm_sample_item(Frame& F, int l, int b, int h) {
    const int tid = F.tid, rowbase = MP + b * SEQ_S, v = tid >> 3, dq = tid & 7;
    LAS float* q = (LAS float*)F.lds; LAS float* k = q + 1024; LAS float* vv = k + 1024; LAS float* oo = vv + 1024; LAS float* igs = oo + 1024; LAS float* lfs = igs + 8; LAS float* hbuf = lfs + 8;
    const bf16* U = P_U; const float* gates = P_GATES;
    const f32x4* cpa = (const f32x4*)(INP(I_MC) + ((((size_t)l * NB_S + b) * 4 + h) * 128 + v) * 128) + dq; const f32x4* cpb = cpa + 64 * 32;
    const f32x4* np = (const f32x4*)(INP(I_MN) + (((size_t)l * NB_S + b) * 4 + h) * 128) + dq;
    f32x4 ca[4], cb[4], n4[4];
#pragma unroll
    for (int j = 0; j < 4; ++j) { ca[j] = cpa[8 * j]; cb[j] = cpb[8 * j]; n4[j] = np[8 * j]; }
    float m = INP(I_MM)[((size_t)l * NB_S + b) * 4 + h];
    { float vals[8];
#pragma unroll
      for (int j8 = 0; j8 < 8; ++j8) { const int idx = tid + NTHR * j8, arr = idx >> 10, tt = (idx >> 7) & 7, d = idx & 127; vals[j8] = bf2f(U[(size_t)(rowbase + tt) * NU + UC_Q + arr * 512 + h * 128 + d]); }
#pragma unroll
      for (int j8 = 0; j8 < 8; ++j8) { const int idx = tid + NTHR * j8; q[idx] = (idx >> 10) == 1 ? vals[j8] * 0.08838834764831845f : vals[j8]; } }
    if (tid < 8) { const size_t row = (size_t)(rowbase + tid); igs[tid] = gates[row * NG + 16 + h] + INP(I_MIB)[l * 4 + h]; lfs[tid] = -softplusf_(-(gates[row * NG + 20 + h] + INP(I_MFB)[l * 4 + h])); }
    LBAR();
#pragma unroll 2
    for (int tt = 0; tt < 8; ++tt) {
        const float igv = igs[tt], lfv = lfs[tt], mn = fmaxf(lfv + m, igv), al = fexp(lfv + m - mn), be = fexp(igv - mn); m = mn;
        const float bva = be * vv[tt * 128 + v], bvb = be * vv[tt * 128 + 64 + v]; f32x4 pa = {0.f, 0.f, 0.f, 0.f}, pb = pa, pd = pa;
#pragma unroll
        for (int j = 0; j < 4; ++j) { const f32x4 k4 = *(const LAS f32x4*)(k + tt * 128 + (dq + 8 * j) * 4), q4 = *(const LAS f32x4*)(q + tt * 128 + (dq + 8 * j) * 4);
            ca[j] = ca[j] * al + k4 * bva; cb[j] = cb[j] * al + k4 * bvb; n4[j] = n4[j] * al + k4 * be; pa += ca[j] * q4; pb += cb[j] * q4; pd += n4[j] * q4; }
        float sa = (pa.x + pa.y) + (pa.z + pa.w), sb = (pb.x + pb.y) + (pb.z + pb.w), sd = (pd.x + pd.y) + (pd.z + pd.w);
        sa += __shfl_xor(sa, 1); sa += __shfl_xor(sa, 2); sa += __shfl_xor(sa, 4); sb += __shfl_xor(sb, 1); sb += __shfl_xor(sb, 2); sb += __shfl_xor(sb, 4); sd += __shfl_xor(sd, 1); sd += __shfl_xor(sd, 2); sd += __shfl_xor(sd, 4);
        if (dq == 0) { const float rd = frcp(fmaxf(fabsf(sd), fexp(-m))); hbuf[tt * 128 + v] = sa * rd; hbuf[tt * 128 + 64 + v] = sb * rd; }
    }
    const float* nwp = INP(I_MNW) + l * 512 + h * 128; const float nwa = nwp[F.lane], nwb = nwp[64 + F.lane];
    { f32x4* coa = (f32x4*)(OUTP() + O_S_MC + ((((size_t)l * NB_S + b) * 4 + h) * 128 + v) * 128) + dq; f32x4* cob = coa + 64 * 32;
#pragma unroll
      for (int j = 0; j < 4; ++j) { coa[8 * j] = ca[j]; cob[8 * j] = cb[j]; }
      if (v == 0) { f32x4* no = (f32x4*)(OUTP() + O_S_MN + (((size_t)l * NB_S + b) * 4 + h) * 128) + dq;
#pragma unroll
          for (int j = 0; j < 4; ++j) no[8 * j] = n4[j]; }
      if (tid == 0) OUTP()[O_S_MM + ((size_t)l * NB_S + b) * 4 + h] = m; }
    LBAR();
    { const int tt = F.wave; const size_t row = (size_t)(rowbase + tt); const float h0 = hbuf[tt * 128 + F.lane], h1 = hbuf[tt * 128 + 64 + F.lane];
      const float rstd = __builtin_amdgcn_rsqf(wave_sum(h0 * h0 + h1 * h1) * (1.f / 128.f) + EPS);
      bf16* yo = P_YCAT + row * MIXW + 1024 + h * 128;
      yo[F.lane] = (bf16)f2bf(h0 * rstd * nwa * sigmoidf_(oo[tt * 128 + F.lane])); yo[64 + F.lane] = (bf16)f2bf(h1 * rstd * nwb * sigmoidf_(oo[tt * 128 + 64 + F.lane])); }
    LBAR();
}

__device__ __forceinline__ void lru_sample_item(Frame& F, int l, int kb, int dh, int bg) {
    constexpr int WAT = 0, WXT = 17408, XC = 34816;
    const int tid = F.tid, lane = F.lane, w = F.wave, rowbase = MP + bg * 128;
    LAS unsigned char* lds = F.lds;
    const int di = w & 1, tq = w >> 1, hi = lane >> 5, dloc = di * 32 + (lane & 31), ch = kb * 128 + dh * 64 + dloc;
    const bf16* U = P_U; bf16* YC = P_YCAT;
    { const int d = tid & 63, cg = tid >> 6; const float* wa = INP(I_LWA) + (((size_t)l * 4 + kb) * 128 + cg * 16) * 128 + dh * 64 + d; const float* wx = INP(I_LWX) + (((size_t)l * 4 + kb) * 128 + cg * 16) * 128 + dh * 64 + d;
      float va[16], vx[16];
#pragma unroll
      for (int i = 0; i < 16; ++i) { va[i] = wa[i * 128]; vx[i] = wx[i * 128]; }
      *(LAS v4u*)(lds + WAT + d * 272 + cg * 32) = (v4u){pk2(va[0], va[1]), pk2(va[2], va[3]), pk2(va[4], va[5]), pk2(va[6], va[7])};
      *(LAS v4u*)(lds + WAT + d * 272 + cg * 32 + 16) = (v4u){pk2(va[8], va[9]), pk2(va[10], va[11]), pk2(va[12], va[13]), pk2(va[14], va[15])};
      *(LAS v4u*)(lds + WXT + d * 272 + cg * 32) = (v4u){pk2(vx[0], vx[1]), pk2(vx[2], vx[3]), pk2(vx[4], vx[5]), pk2(vx[6], vx[7])};
      *(LAS v4u*)(lds + WXT + d * 272 + cg * 32 + 16) = (v4u){pk2(vx[8], vx[9]), pk2(vx[10], vx[11]), pk2(vx[12], vx[13]), pk2(vx[14], vx[15])}; }
    { const int pc = tid & 63, gq = tid >> 6, c0 = kb * 128 + 2 * pc;
      float cw[4][2], cb[2];
#pragma unroll
      for (int e = 0; e < 2; ++e) { cb[e] = INP(I_LCB)[l * LRUW + c0 + e];
#pragma unroll
          for (int j = 0; j < 4; ++j) cw[j][e] = INP(I_LCW)[((size_t)l * 4 + j) * LRUW + c0 + e]; }
#pragma unroll
      for (int bb = 0; bb < 2; ++bb) { const int batch = bg * 16 + 2 * gq + bb; const float* hist = INP(I_LCONV) + ((size_t)l * NB_S + batch) * 3 * LRUW + c0;
          float v0[11], v1[11];
#pragma unroll
          for (int j = 0; j < 3; ++j) { v0[j] = hist[j * LRUW]; v1[j] = hist[j * LRUW + 1]; }
#pragma unroll
          for (int t = 0; t < 8; ++t) { const unsigned u = *(const unsigned*)(U + (size_t)(MP + batch * 8 + t) * NU + UC_XR + c0); v0[3 + t] = lo_bf(u); v1[3 + t] = hi_bf(u); }
#pragma unroll
          for (int t = 0; t < 8; ++t) { const float a0 = cb[0] + cw[0][0] * v0[t] + cw[1][0] * v0[t + 1] + cw[2][0] * v0[t + 2] + cw[3][0] * v0[t + 3], a1 = cb[1] + cw[0][1] * v1[t] + cw[1][1] * v1[t + 1] + cw[2][1] * v1[t + 2] + cw[3][1] * v1[t + 3];
              *(LAS unsigned*)(lds + XC + (16 * gq + 8 * bb + t) * 272 + 4 * pc) = pk2(a0, a1); } } }
    const float ba = INP(I_LBA)[l * LRUW + ch], bx = INP(I_LBX)[l * LRUW + ch], spl8 = 8.f * softplusf_(-INP(I_LLAM)[l * LRUW + ch]);
    float gr[16], h0[4];
#pragma unroll
    for (int r = 0; r < 16; ++r) gr[r] = bf2f(U[(size_t)(rowbase + tq * 32 + crow32(r, hi)) * NU + UC_GR + ch]);
#pragma unroll
    for (int g = 0; g < 4; ++g) h0[g] = INP(I_LH)[((size_t)l * NB_S + bg * 16 + tq * 4 + g) * LRUW + ch];
    LBAR();
    f32x16 ra, ri; for (int r = 0; r < 16; ++r) { ra[r] = 0.f; ri[r] = 0.f; }
#pragma unroll
    for (int kk = 0; kk < 8; ++kk) { const bf16x8 af = frag32(lds + XC, 272, tq * 32, kk, lane);
        const bf16x8 b0 = frag32(lds + WAT, 272, di * 32, kk, lane), b1 = frag32(lds + WXT, 272, di * 32, kk, lane);
        ra = __builtin_amdgcn_mfma_f32_32x32x16_bf16(af, b0, ra, 0, 0, 0); ri = __builtin_amdgcn_mfma_f32_32x32x16_bf16(af, b1, ri, 0, 0, 0); }
#pragma unroll
    for (int r = 0; r < 16; ++r) { const int t = tq * 32 + crow32(r, hi);
        const float rg = frcp(1.f + fexp(-(ra[r] + ba))), ig = frcp(1.f + fexp(-(ri[r] + bx))), la = -spl8 * rg, x2 = 2.f * la;
        const float av = fexp(la), om = x2 > -0.03f ? -x2 * (1.f + x2 * (0.5f + x2 * (0.16666667f + x2 * 0.041666668f))) : 1.f - av * av;
        const float xcv = bf2f(*(const LAS bf16*)(lds + XC + t * 272 + (dh * 64 + dloc) * 2));
        ra[r] = av; ri[r] = __builtin_amdgcn_sqrtf(om) * ig * xcv; }
#pragma unroll
    for (int g = 0; g < 4; ++g) {
        float hv = h0[g], lo4[4], hi4[4];
#pragma unroll
        for (int j = 0; j < 4; ++j) { hv = ra[4 * g + j] * hv + ri[4 * g + j]; lo4[j] = hv; }
        float hx = __shfl_xor(hv, 32);
#pragma unroll
        for (int j = 0; j < 4; ++j) { hx = ra[4 * g + j] * hx + ri[4 * g + j]; hi4[j] = hx; }
#pragma unroll
        for (int j = 0; j < 4; ++j) { const float hh = hi ? hi4[j] : lo4[j], x = gr[4 * g + j], u = 0.7978845608028654f * (x + 0.044715f * x * x * x), th = 1.f - 2.f * frcp(fexp(2.f * u) + 1.f);
            YC[(size_t)(rowbase + tq * 32 + 8 * g + 4 * hi + j) * MIXW + 1536 + ch] = (bf16)f2bf(hh * 0.5f * x * (1.f + th)); }
        if (hi) OUTP()[O_S_LH + ((size_t)l * NB_S + bg * 16 + tq * 4 + g) * LRUW + ch] = hx;
    }
    for (int idx = tid; idx < 16 * 3 * 64; idx += NTHR) { const int bb = idx / 192, j = (idx >> 6) % 3, dd = idx & 63, batch = bg * 16 + bb, cc = kb * 128 + dh * 64 + dd;
        OUTP()[O_S_LCONV + (((size_t)l * NB_S + batch) * 3 + j) * LRUW + cc] = bf2f(U[(size_t)(MP + batch * 8 + 5 + j) * NU + UC_XR + cc]); }
    LBAR();
}

__device__ __forceinline__ void mixer_phase(Frame& F, int l, int rep) {
    constexpr int NCV = (CONV_ALL - CONV_EARLY) / NWAVES;
    static_assert((CONV_ALL - CONV_EARLY) % NWAVES == 0, "conversion items per block");
    const int ncv = l == 0 ? NCV : 0;
    constexpr int N0 = 32, N1 = N0 + 128, N2 = N1 + 64, N3 = N2 + 256, N4 = N3 + 512, N5 = N4 + 64;
    volatile LAS int* slot = (volatile LAS int*)(F.lds + 65536);
    for (;;) {
        if (F.tid == 0) *slot = (int)atomicAdd(P_CTL + CW_Q + 64 * l + 128 * rep, 1u);
        LBAR();
        const int q = __builtin_amdgcn_readfirstlane(*slot);
        LBAR();
#ifndef DUPMIX
#define DUPMIX 0
#endif
        constexpr int DUP_LO = DUPMIX == 5 ? 0 : DUPMIX == 6 ? N0 : DUPMIX == 7 ? N1 : DUPMIX == 2 ? N2 : DUPMIX == 3 ? N2 : DUPMIX == 4 ? N3 : DUPMIX == 8 ? N4 : 0, DUP_N = DUPMIX == 5 ? N0 : DUPMIX == 6 ? N1 - N0 : DUPMIX == 7 ? N2 - N1 : DUPMIX == 2 ? N5 - N2 : DUPMIX == 3 ? N3 - N2 : DUPMIX == 4 ? N4 - N3 : DUPMIX == 8 ? N5 - N4 : 0;
        constexpr int NSB2 = SSD2F ? NB_P * 32 * 2 : 0, NPB = (MERGEB && !SSD2PASS) ? NSB2 + NB_P * 4 * 32 : 0;
        if (q >= N5 + ncv + NPB + DUP_N) break;
#ifndef QORDER
#define QORDER 0
#endif
        constexpr int NS = N5 - N2;
        const bool conv = QORDER == 1 ? (q >= N5 && q < N5 + ncv) : (q >= N2 && q < N2 + ncv);
        const bool passb = q >= N5 + ncv && q < N5 + ncv + NPB;
        const int it = q >= N5 + ncv + NPB ? q - (N5 + ncv + NPB) + DUP_LO : QORDER == 1 ? (q < NS ? N2 + q : q - NS) : (q < N2 ? q : q - ncv);
        { int wv_ = F.wave; asm volatile("" : "+s"(wv_)); int t_ = wv_ * 64 + (int)__builtin_amdgcn_mbcnt_hi(~0u, __builtin_amdgcn_mbcnt_lo(~0u, 0u)); asm volatile("" : "+v"(t_)); F.tid = t_; F.lane = t_ & 63; F.wave = __builtin_amdgcn_readfirstlane(t_ >> 6); }
#ifndef ITEMMASK
#define ITEMMASK 63
#endif
        if (passb) { const int j0 = q - (N5 + ncv); if (j0 < NSB2) ssd_passB2(F, l, j0 >> 6, (j0 >> 1) & 31, j0 & 1, rep); else { const int j = j0 - NSB2; mlstm_passB(F, l, j >> 7, (j >> 5) & 3, j & 31, rep); } }
        else if (conv) { convert_item(F, CONV_EARLY + (q - N2) * NWAVES + F.wave); LBAR(); }
        else if (it < N0) { if (ITEMMASK & 1) mlstm_passA(F, l, it >> 2, it & 3, rep); }
        else if (it < N1) { if (ITEMMASK & 2) { if (SSD2F) ssd_passA2(F, l, (it - N0) >> 4, (it - N0) & 15, rep); else if (SSD2PASS) ssd_passA(F, l, (it - N0) >> 4, (it - N0) & 15); else ssd_prompt_item(F, l, (it - N0) >> 4, (it - N0) & 15); } }
        else if (it < N2) { if (ITEMMASK & 4) lru_prompt_item(F, l, (it - N1) >> 3, ((it - N1) >> 1) & 3, (it - N1) & 1); }
        else if (it < N3) { if (ITEMMASK & 8) ssd_sample_item(F, l, (it - N2) >> 1, (it - N2) & 1); }
        else if (it < N4) { if (ITEMMASK & 16) mlstm_sample_item(F, l, (it - N3) >> 2, (it - N3) & 3); }
        else { if (ITEMMASK & 32) lru_sample_item(F, l, (it - N4) >> 4, ((it - N4) >> 3) & 1, (it - N4) & 7); }
    }
}

__device__ __forceinline__ void mixerB_phase(Frame& F, int l, int rep) {
    constexpr int NSB = SSD2PASS ? NB_P * 32 * 2 : 0, NSM = NSB, NB = NSM + NB_P * 4 * 32;
    volatile LAS int* slot = (volatile LAS int*)(F.lds + MISC_OFF + 64);
    for (;;) {
        if (F.tid == 0) *slot = (int)atomicAdd(P_CTL + CW_Q + 64 * l + 256 + 128 * rep, 1u);
        __syncthreads();
        int it = __builtin_amdgcn_readfirstlane(*slot);
        __syncthreads();
#ifndef DUPB
#define DUPB 0
#endif
        if (it >= NB + (DUPB == 1 ? NSB : DUPB == 2 ? NB - NSM : 0)) break;
        if (it >= NB) it = DUPB == 1 ? it - NB : it - NB + NSM;
        { int wv_ = F.wave; asm volatile("" : "+s"(wv_)); int t_ = wv_ * 64 + (int)__builtin_amdgcn_mbcnt_hi(~0u, __builtin_amdgcn_mbcnt_lo(~0u, 0u)); asm volatile("" : "+v"(t_)); F.tid = t_; F.lane = t_ & 63; F.wave = __builtin_amdgcn_readfirstlane(t_ >> 6); }
        if (it < NSB) ssd_passB(F, l, it >> 6, (it >> 1) & 31, it & 1);
        else if (it < NSM) mlstm_sample_item(F, l, (it - NSB) >> 2, (it - NSB) & 3);
        else { const int j = it - NSM; mlstm_passB(F, l, j >> 7, (j >> 5) & 3, j & 31, -1); }
    }
}

#ifndef PHMASK
#define PHMASK 1023
#endif
constexpr int NPH = 18;
__global__ void __launch_bounds__(NTHR, 2) mega(Args args) {
    extern __shared__ __attribute__((aligned(16))) unsigned char lds_raw[];
    Frame F;
    F.lds = (LAS unsigned char*)lds_raw;
    const int wave_s = __builtin_amdgcn_readfirstlane((int)threadIdx.x >> 6);
    F.wave = wave_s; F.lane = (int)__builtin_amdgcn_mbcnt_hi(~0u, __builtin_amdgcn_mbcnt_lo(~0u, 0u)); F.tid = wave_s * 64 + F.lane; F.G = gridDim.x;
    volatile LAS unsigned* MISC = (volatile LAS unsigned*)(F.lds + MISC_OFF);
    for (int u = F.tid; u < (LDS_BYTES - LDSCTL_OFF) / 4; u += NTHR) ((LAS unsigned*)(F.lds + LDSCTL_OFF))[u] = 0u;
    __syncthreads();
    XcdBarrier bar; bar.bar = nullptr; bar.x = 0; bar.st = nullptr;
    const bool multi = (args.ph_hi - args.ph_lo) > 1;
    if (multi) bar = xcd_barrier_post(P_CTL + CW_BAR, MISC + 8, F.tid);
#ifndef DUPPH
#define DUPPH -1
#endif
    int rep = 0;
    for (int ph = args.ph_lo; ph < args.ph_hi; ++ph) {
        { int wv_ = wave_s; asm volatile("" : "+s"(wv_)); int t_ = wv_ * 64 + (int)__builtin_amdgcn_mbcnt_hi(~0u, __builtin_amdgcn_mbcnt_lo(~0u, 0u)); asm volatile("" : "+v"(t_)); F.tid = t_; F.lane = t_ & 63; F.wave = __builtin_amdgcn_readfirstlane(t_ >> 6); }
        if (ph == 0) { if (PHMASK & 256) p0_prologue(F); }
        else if (ph == NPH - 1) { if (PHMASK & 512) final_norm_phase(F); }
        else {
            constexpr bool PREP = !SSD2PASS && MERGEB;
            const int l = (ph - 1) >> 3, sub_ = (ph - 1) & 7, sub = PREP ? (sub_ < 2 ? sub_ : sub_ - 1) : (sub_ < 3 ? sub_ : sub_ - 1);
            if (PREP && sub_ == 2) { if (PHMASK & 4) bca_prepass(F, l); }
            else if (!PREP && sub_ == 3) { if (PHMASK & 4) mixerB_phase(F, l, rep); } else
            if (sub == 0) { if (PHMASK & 1) norm_phase<true>(F, l, 1); }
            else if (sub == 1) { if (PHMASK & 2) { pg8::Gemm g{P_HN, P_WINT + (size_t)l * NU * DM, MT, NU, DM}; pg8::StaticOrder S; S.init(MT, NU, F.G, (int)blockIdx.x);
                pg8::EpiBf16<0> E{P_U, NU}; pg8::gemm_phase<pg8::EpiBf16<0>, pg8::StaticOrder, true, true>(F.lds, g, S, E, F.tid); } }
            else if (sub == 2) { if (PHMASK & 4) mixer_phase(F, l, rep); }
            else if (sub == 3) { if (PHMASK & 16) { pg8::Gemm g{P_YCAT, P_WOUTT + (size_t)l * DM * MIXW, MT, DM, MIXW}; pg8::MidkOrder S; S.init(MP, DM, MIXW, F.G, (int)blockIdx.x, 16);
                const float* xp = l == 0 ? INP(I_XP) : P_XW; const float* xs = l == 0 ? INP(I_XS) : P_XW + (size_t)MP * DM; const float* gate = P_MOD + (size_t)l * MODROWS * MODLD + 2048;
                pg8::EpiResid<true> E{xp, xs, P_XW, gate, P_SSQ, 16, 1.f / 1024.f, EPS}; pg8::gemm_phase<pg8::EpiResid<true>, pg8::MidkOrder, true, true>(F.lds, g, S, E, F.tid);
                { pg8::SampleSplitOrder S2; S2.init(DM, MIXW, (int)blockIdx.x, 4, 16); pg8::EpiAtomic<true> E2{P_XW, gate, P_SSQ, 16, 1.f / 1024.f, EPS}; pg8::gemm_phase<pg8::EpiAtomic<true>, pg8::SampleSplitOrder, true, true>(F.lds, g, S2, E2, F.tid); } } }
            else if (sub == 4) { if (PHMASK & 32) norm_phase<false>(F, l, 2); }
            else if (sub == 5) { if (PHMASK & 64) { pg8::Gemm g{P_HN, P_WUPT + (size_t)l * DFF * DM, MT, DFF, DM}; pg8::StaticOrder S; S.init(MT, DFF, F.G, (int)blockIdx.x);
                pg8::EpiBf16<1> E{P_HID, DFF}; pg8::gemm_phase<pg8::EpiBf16<1>, pg8::StaticOrder, true, true>(F.lds, g, S, E, F.tid); } }
            else { if (PHMASK & 128) { pg8::Gemm g{P_HID, P_WDNT + (size_t)l * DM * DFF, MT, DM, DFF}; pg8::StaticOrder S; S.init(MP, DM, F.G, (int)blockIdx.x); const float* gate = P_MOD + (size_t)l * MODROWS * MODLD + 5120;
                pg8::EpiResid<false> E{P_XW, P_XW + (size_t)MP * DM, P_XW, gate, nullptr, 0, 0.f, 0.f}; pg8::gemm_phase<pg8::EpiResid<false>, pg8::StaticOrder, true, true>(F.lds, g, S, E, F.tid);
                { pg8::SampleSplitOrder S2; S2.init(DM, DFF, (int)blockIdx.x, 4, 0); pg8::EpiAtomic<false> E2{P_XW, gate, nullptr, 0, 0.f, 0.f}; pg8::gemm_phase<pg8::EpiAtomic<false>, pg8::SampleSplitOrder, true, true>(F.lds, g, S2, E2, F.tid); } } }
        }
        if (ph + 1 < args.ph_hi) xcd_barrier(bar, F.tid);
        if (ph == DUPPH && rep == 0) { rep = 1; --ph; }
    }
}

extern "C" void kernel_launch(void* const* d_in, const int* in_sizes, int n_in, void* d_out, int out_size, void* d_ws, size_t ws_size, hipStream_t stream) {
    static int grid = 0;
    if (grid == 0) {
        if (n_in != 36 || out_size != (int)O_END || ws_size < WS_END) { fprintf(stderr, "kernel_launch: unexpected shapes: n_in %d out %d ws %zu; nothing launched\n", n_in, out_size, ws_size); grid = -1; return; }
        int dev = 0, cus = 0, per_cu = 0;
        if (hipGetDevice(&dev) != hipSuccess || hipDeviceGetAttribute(&cus, hipDeviceAttributeMultiprocessorCount, dev) != hipSuccess) { grid = -1; return; }
        if (hipFuncSetAttribute((const void*)mega, hipFuncAttributeMaxDynamicSharedMemorySize, LDS_BYTES) != hipSuccess) { fprintf(stderr, "kernel_launch: hipFuncSetAttribute failed\n"); grid = -1; return; }
        if (hipOccupancyMaxActiveBlocksPerMultiprocessor(&per_cu, (const void*)mega, NTHR, LDS_BYTES) != hipSuccess || per_cu < 1) { fprintf(stderr, "kernel_launch: occupancy query says %d\n", per_cu); per_cu = 1; }
        (void)hipGetLastError();
        grid = cus;
    }
    if (grid < 0) return;
    if (hipMemsetAsync((char*)d_ws + WS_CTL, 0, CTL_ZERO_BYTES, stream) != hipSuccess) { fprintf(stderr, "kernel_launch: memset failed\n"); return; }
    Args a{};
    for (int i = 0; i < 36; ++i) a.in[i] = (const float*)d_in[i];
    a.out = (float*)d_out; a.ws = (unsigned char*)d_ws;
#if MK_ONE
    a.ph_lo = 0; a.ph_hi = NPH;
    { void* kargs[] = {&a}; hipError_t e = hipLaunchCooperativeKernel((const void*)mega, dim3(grid), dim3(NTHR), kargs, LDS_BYTES, stream);
      if (e != hipSuccess) fprintf(stderr, "kernel_launch: cooperative launch failed: %s (grid %d)\n", hipGetErrorString(e), grid); }
#else
    for (int ph = 0; ph < NPH; ++ph) { a.ph_lo = ph; a.ph_hi = ph + 1; hipLaunchKernelGGL(mega, dim3(grid), dim3(NTHR), LDS_BYTES, stream, a); }
#endif
}
```

```cpp
#include <hip/hip_runtime.h>
#include <cstdio>
#include <cstdint>
namespace pg8 {
#define PG8_LAS __attribute__((address_space(3)))
typedef unsigned short bf16_t;
typedef short bf16x8 __attribute__((ext_vector_type(8)));
typedef float f32x4 __attribute__((ext_vector_type(4)));
typedef unsigned u32x4 __attribute__((ext_vector_type(4)));
constexpr int BM = 256, BK = 64, HALF = 128, HTB = HALF * BK * 2  , STAGE_BYTES = 8 * HTB, NXCD = 8, WGM = 6;

__host__ __device__ __forceinline__ int lds_byte(int r, int c) { const int st = (r >> 4) * 2 + (c >> 5), rr = r & 15, cc = c & 31, ob = rr * 64 + cc * 2; return st * 1024 + (ob ^ (((ob >> 9) & 1) << 5)); }
__host__ __device__ __forceinline__ void stage_rc(int b, int& R, int& C) { const int st = b / 1024, sb = b % 1024, swz = sb ^ (((sb >> 9) & 1) << 5); R = (st >> 1) * 16 + swz / 64; C = (st & 1) * 32 + (swz % 64) / 2; }
__host__ __device__ __forceinline__ int perm32(int rho) { const int n = rho >> 4, i = rho & 15; return 8 * (i >> 2) + 4 * n + (i & 3); }

struct Unit { int pm, pn, k0, nt, flags; };
struct Gemm { const bf16_t* A; const bf16_t* Bt; int M, N, K; };

struct StaticOrder {
    int nM, nN, nwg, G, c;
    __host__ __device__ void init(int M, int N, int G_, int c_) { nM = M / BM; nN = N / BM; nwg = nM * nN; G = G_; c = c_; }
    __host__ __device__ bool next(int i, Unit& u) const {
        const long L = (long)i * G + c; if (L >= nwg) return false;
        int wgid = (int)L; { const int q = nwg / NXCD, r = nwg % NXCD, xcd = wgid % NXCD, off = wgid / NXCD; wgid = (xcd < r ? xcd * (q + 1) : r * (q + 1) + (xcd - r) * q) + off; }
        const int nig = WGM * nN, gid = wgid / nig, fm = gid * WGM, gsz = (nM - fm) < WGM ? (nM - fm) : WGM;
        u.pm = fm + ((wgid % nig) % gsz); u.pn = (wgid % nig) / gsz; u.k0 = 0; u.nt = 0; u.flags = 0; return true;
    }
    __device__ __forceinline__ void a_ready(const Unit&) const {}
    __device__ __forceinline__ void done(const Unit&) const {}
};

__device__ __forceinline__ unsigned cvt_pk_bf16(float lo, float hi) { unsigned r; asm volatile("v_cvt_pk_bf16_f32 %0, %1, %2" : "=v"(r) : "v"(lo), "v"(hi)); return r; }

template <int ACT> struct EpiBf16 {
    static constexpr bool PERM = true, AFTER_DRAIN = false, MIDK = false;
    bf16_t* O; int ldc;
    __device__ __forceinline__ bool deferred(const Unit&) const { return false; }
    __device__ __forceinline__ void fused(const f32x4 (&)[2][2][4][2], const Unit&, int, int, int, int, PG8_LAS unsigned char*, int, int) const {}
    __device__ __forceinline__ void operator()(const f32x4 (&acc)[2][2][4][2], const Unit& u, int wr, int wc, int fr, int fq) const {
        const int row0 = u.pm * BM + wr * 64 + fr; const int col0 = u.pn * BM + wc * 32 + 8 * fq;
#pragma unroll
        for (int ai = 0; ai < 2; ++ai)
#pragma unroll
            for (int m = 0; m < 4; ++m) { bf16_t* rowp = O + (size_t)(row0 + ai * HALF + m * 16) * ldc + col0;
#pragma unroll
                for (int bj = 0; bj < 2; ++bj) { f32x4 v0 = acc[ai][bj][m][0], v1 = acc[ai][bj][m][1];
                    if (ACT == 1) {
#pragma unroll
                        for (int e = 0; e < 4; ++e) { const float a0 = fmaxf(v0[e], 0.f), a1 = fmaxf(v1[e], 0.f); v0[e] = a0 * a0; v1[e] = a1 * a1; } }
                    u32x4 w; w.x = cvt_pk_bf16(v0[0], v0[1]); w.y = cvt_pk_bf16(v0[2], v0[3]); w.z = cvt_pk_bf16(v1[0], v1[1]); w.w = cvt_pk_bf16(v1[2], v1[3]);
                    *(u32x4*)(rowp + bj * HALF) = w; } }
    }
};
template <bool MIDK_> struct EpiResid {
    static constexpr bool PERM = true, AFTER_DRAIN = false, MIDK = MIDK_;
    const bf16_t* xb; bf16_t* outb; const float* gate; const float* ssq; int midk_kt; float inv_n, eps;
    __device__ __forceinline__ bool deferred(const Unit&) const { return false; }
    __device__ __forceinline__ void fused(const f32x4 (&)[2][2][4][2], const Unit&, int, int, int, int, PG8_LAS unsigned char*, int, int) const {}
    __device__ __forceinline__ void operator()(const f32x4 (&acc)[2][2][4][2], const Unit& u, int wr, int wc, int fr, int fq) const {
        const int col0 = u.pn * BM + wc * 32 + 8 * fq, row00 = u.pm * BM + wr * 64 + fr;
        const int mr = row00 >> 11; const float* gp = gate + (size_t)mr * 6144;
        f32x4 g4[2][2]; u32x4 xa[2], xb2[2];
#pragma unroll
        for (int bj = 0; bj < 2; ++bj)
#pragma unroll
            for (int n = 0; n < 2; ++n) g4[bj][n] = *(const f32x4*)(gp + col0 + bj * HALF + n * 4);
        auto ldx = [&](int k, u32x4 (&x)[2]) { const int row = row00 + (k >> 2) * HALF + (k & 3) * 16; const bf16_t* xin = xb + (size_t)row * 1024;
#pragma unroll
            for (int bj = 0; bj < 2; ++bj) x[bj] = *(const u32x4*)(xin + col0 + bj * HALF); };
        auto stx = [&](int k, const u32x4 (&x)[2]) { const int ai = k >> 2, m = k & 3, row = row00 + ai * HALF + m * 16; bf16_t* op = outb + (size_t)row * 1024;
#pragma unroll
            for (int bj = 0; bj < 2; ++bj) { u32x4 w;
#pragma unroll
                for (int n = 0; n < 2; ++n) { const unsigned lo = x[bj][2 * n], hi = x[bj][2 * n + 1];
                    const f32x4 xv = {__uint_as_float(lo << 16), __uint_as_float(lo & 0xffff0000u), __uint_as_float(hi << 16), __uint_as_float(hi & 0xffff0000u)};
                    const f32x4 v = xv + g4[bj][n] * acc[ai][bj][m][n]; w[2 * n] = cvt_pk_bf16(v[0], v[1]); w[2 * n + 1] = cvt_pk_bf16(v[2], v[3]); }
                *(u32x4*)(op + col0 + bj * HALF) = w; } };
        ldx(0, xa);
#pragma unroll
        for (int k = 0; k < 8; k += 2) { ldx(k + 1, xb2); stx(k, xa); asm volatile("" ::: "memory"); if (k + 2 < 8) ldx(k + 2, xa); stx(k + 1, xb2); asm volatile("" ::: "memory"); }
    }
};
template <bool MIDK_> struct EpiAtomic {
    static constexpr bool PERM = false, AFTER_DRAIN = false, MIDK = MIDK_;
    float* out; const float* gate; const float* ssq; int midk_kt; float inv_n, eps;
    __device__ __forceinline__ bool deferred(const Unit&) const { return true; }
    __device__ __forceinline__ void operator()(const f32x4 (&)[2][2][4][2], const Unit&, int, int, int, int) const {}
    __device__ __forceinline__ void fused(const f32x4 (&acc)[2][2][4][2], const Unit& u, int wr, int wc, int fr, int fq, PG8_LAS unsigned char* lds, int wid, int lane) const {
#pragma unroll
        for (int ai = 0; ai < 2; ++ai) {
#pragma unroll
            for (int m = 0; m < 4; ++m) { const int row = wr * 64 + m * 16 + fr;
#pragma unroll
                for (int bj = 0; bj < 2; ++bj)
#pragma unroll
                    for (int n = 0; n < 2; ++n) { const int chunk = (bj * HALF + wc * 32 + n * 16 + 4 * fq) >> 2; *(PG8_LAS f32x4*)(lds + row * 1024 + ((chunk ^ (row & 15)) << 4)) = acc[ai][bj][m][n]; } }
            asm volatile("s_waitcnt lgkmcnt(0)" ::: "memory"); __builtin_amdgcn_s_barrier(); asm volatile("" ::: "memory");
#pragma unroll
            for (int hb = 0; hb < 2; ++hb) {
                const int grow0 = u.pm * BM + ai * HALF + wid * 16 + 8 * hb; const int mr = grow0 < 16384 ? (grow0 >> 11) : 8 + ((grow0 - 16384) >> 3);
                const float* gp = gate + (size_t)mr * 6144 + u.pn * BM; float gv[4];
#pragma unroll
                for (int j = 0; j < 4; ++j) gv[j] = gp[lane + 64 * j];
#pragma unroll
                for (int r8 = 0; r8 < 8; ++r8) { const int row = wid * 16 + 8 * hb + r8; float* op = out + (size_t)(grow0 + r8) * 1024 + u.pn * BM;
#pragma unroll
                    for (int j = 0; j < 4; ++j) { const int col = lane + 64 * j; const float v = *(const PG8_LAS float*)(lds + row * 1024 + (((col >> 2) ^ (row & 15)) << 4) + (col & 3) * 4);
                        __hip_atomic_fetch_add(op + col, gv[j] * v, __ATOMIC_RELAXED, __HIP_MEMORY_SCOPE_AGENT); } } }
            asm volatile("s_waitcnt lgkmcnt(0)" ::: "memory"); __builtin_amdgcn_s_barrier(); asm volatile("" ::: "memory");
        }
    }
};
struct SampleSplitOrder {
    int nN, c, ntk, SPLIT, midk_kt;
    __device__ void init(int N, int K, int c_, int split, int midk) { nN = N / BM; c = c_; ntk = K / BK; SPLIT = split; midk_kt = midk; }
    __device__ bool next(int i, Unit& u) const {
        if (i != 0 || c >= 4 * nN * SPLIT) return false;
        const int tile = c / SPLIT, sp = c % SPLIT; u.pm = 64 + tile / nN; u.pn = tile % nN; u.nt = ntk / SPLIT; u.k0 = sp * u.nt; u.flags = (u.k0 + u.nt <= midk_kt) ? 2 : 0; return true;
    }
    __device__ __forceinline__ void a_ready(const Unit&) const {}
    __device__ __forceinline__ void done(const Unit&) const {}
};
struct MidkOrder {
    StaticOrder P; int ntk, midk_kt;
    __device__ void init(int M, int N, int K, int G_, int c_, int midk) { P.init(M, N, G_, c_); ntk = K / BK; midk_kt = midk; }
    __device__ bool next(int i, Unit& u) const {
        if (!P.next(i >> 1, u)) return false;
        if (i & 1) { u.k0 = midk_kt; u.nt = ntk - midk_kt; u.flags = 0; } else { u.k0 = 0; u.nt = midk_kt; u.flags = 1; }
        return true;
    }
    __device__ __forceinline__ void a_ready(const Unit&) const {}
    __device__ __forceinline__ void done(const Unit&) const {}
};
template <class Epi, class Sched, bool ALIGN_EPI = false, bool SP2 = false>
__device__ __forceinline__ void gemm_phase(PG8_LAS unsigned char* lds, const Gemm g, const Sched& S, const Epi& E, int tid_in) {
    int tid_ = tid_in; asm volatile("" : "+v"(tid_));
    const int tid = tid_, wid = __builtin_amdgcn_readfirstlane(tid >> 6), lane = tid & 63, wr = wid >> 2, wc = wid & 3, fr = lane & 15, fq = lane >> 4;
    const int K = g.K; int nt = K / BK;
    unsigned voffA[2], voffB[2];
#pragma unroll
    for (int i = 0; i < 2; ++i) { int R, C; stage_rc(tid * 16 + i * 8192, R, C); const int Rb = Epi::PERM ? ((R & ~31) + perm32(R & 31)) : R;
        voffA[i] = (unsigned)(R * K + C) * 2u; voffB[i] = (unsigned)(Rb * K + C) * 2u; }
    const size_t kstep = (size_t)(BK * 2);
    const size_t hstep = (size_t)HALF * K * 2;
    const size_t tstep = 2 * hstep;
    const unsigned ldsw = (unsigned)wid * 1024u;
    const int aoff = lds_byte(wr * 64 + fr, fq * 8), boff = lds_byte(wc * 32 + fr, fq * 8);
#define PG8_SA(b, h) (((b) * 2 + (h)) * HTB)
#define PG8_SB(b, h) ((4 + (b) * 2 + (h)) * HTB)
#define PG8_STAGE(bufoff, gbase, voff) do { _Pragma("unroll") for (int _i = 0; _i < 2; ++_i) \
        __builtin_amdgcn_global_load_lds((const unsigned*)((const char*)(gbase) + (voff)[_i]), (PG8_LAS unsigned*)(lds + (bufoff) + ldsw + _i * 8192), 16, 0, 0); } while (0)
#define PG8_LDA(dst, b, h) do { _Pragma("unroll") for (int m = 0; m < 4; ++m) _Pragma("unroll") for (int k = 0; k < 2; ++k) dst[m][k] = *(const PG8_LAS bf16x8*)(lds + PG8_SA(b, h) + aoff + m * 2048 + k * 1024); } while (0)
#define PG8_LDB(dst, b, h) do { _Pragma("unroll") for (int n = 0; n < 2; ++n) _Pragma("unroll") for (int k = 0; k < 2; ++k) dst[n][k] = *(const PG8_LAS bf16x8*)(lds + PG8_SB(b, h) + boff + n * 2048 + k * 1024); } while (0)
#define PG8_MMA(ai, bj, At, Bt) do { __builtin_amdgcn_s_setprio(1); _Pragma("unroll") for (int m = 0; m < 4; ++m) _Pragma("unroll") for (int n = 0; n < 2; ++n) _Pragma("unroll") for (int k = 0; k < 2; ++k) \
        acc[ai][bj][m][n] = __builtin_amdgcn_mfma_f32_16x16x32_bf16(Bt[n][k], At[m][k], acc[ai][bj][m][n], 0, 0, 0); __builtin_amdgcn_s_setprio(0); } while (0)
#define PG8_WAIT_V(n) asm volatile("s_waitcnt vmcnt(" #n ")" ::: "memory")
#define PG8_WAIT_L(n) asm volatile("s_waitcnt lgkmcnt(" #n ")" ::: "memory")
#define PG8_BAR __builtin_amdgcn_s_barrier()
#define PG8_SCHED __builtin_amdgcn_sched_barrier(0)
    Unit cur, nxt; int ui = 0;
    if (!S.next(0, cur)) return;
    PG8_LAS float* rsb = (PG8_LAS float*)(lds + STAGE_BYTES + 1024);
#define PG8_RS_UNIT(u_) do { if constexpr (Epi::MIDK) { const int r_ = tid >> 1, hh_ = tid & 1; const float* sp_ = E.ssq + ((size_t)(u_).pm * BM + r_) * 16 + hh_ * 8; \
        const f32x4 s0_ = *(const f32x4*)sp_, s1_ = *(const f32x4*)(sp_ + 4); float s_ = (s0_[0] + s0_[1]) + (s0_[2] + s0_[3]) + (s1_[0] + s1_[1]) + (s1_[2] + s1_[3]); s_ += __shfl_xor(s_, 1); \
        if (hh_ == 0) rsb[r_] = __builtin_amdgcn_rsqf(s_ * E.inv_n + E.eps); } } while (0)
#define PG8_RS_APPLY() do { _Pragma("unroll") for (int a_ = 0; a_ < 2; ++a_) _Pragma("unroll") for (int m_ = 0; m_ < 4; ++m_) { const float rs_ = rsb[a_ * HALF + wr * 64 + m_ * 16 + fr]; \
        _Pragma("unroll") for (int b_ = 0; b_ < 2; ++b_) _Pragma("unroll") for (int n_ = 0; n_ < 2; ++n_) acc[a_][b_][m_][n_] *= rs_; } } while (0)
    if constexpr (Epi::MIDK) { PG8_RS_UNIT(cur); }
    f32x4 acc[2][2][4][2];
#pragma unroll
    for (int a = 0; a < 2; ++a)
#pragma unroll
        for (int b = 0; b < 2; ++b)
#pragma unroll
            for (int m = 0; m < 4; ++m)
#pragma unroll
                for (int n = 0; n < 2; ++n) acc[a][b][m][n] = (f32x4){0.f, 0.f, 0.f, 0.f};
    bf16x8 At[4][2], B0[2][2], B1[2][2];
    if (cur.nt) nt = cur.nt;
    const char* cA = (const char*)g.A + (size_t)cur.pm * tstep + (size_t)cur.k0 * kstep; const char* cB = (const char*)g.Bt + (size_t)cur.pn * tstep + (size_t)cur.k0 * kstep;
    S.a_ready(cur);
    if constexpr (SP2) {
        PG8_STAGE(PG8_SB(0, 0), cB, voffB); PG8_STAGE(PG8_SB(0, 1), cB + hstep, voffB); PG8_STAGE(PG8_SA(0, 0), cA, voffA); PG8_STAGE(PG8_SA(0, 1), cA + hstep, voffA);
        if (wr == 1) PG8_BAR;
        PG8_WAIT_V(2); PG8_BAR;
        PG8_STAGE(PG8_SB(1, 0), cB + kstep, voffB); PG8_STAGE(PG8_SA(1, 0), cA + kstep, voffA); PG8_STAGE(PG8_SB(1, 1), cB + hstep + kstep, voffB);
        PG8_WAIT_V(6); PG8_BAR;
    } else {
        PG8_STAGE(PG8_SB(0, 0), cB, voffB); PG8_STAGE(PG8_SA(0, 0), cA, voffA); PG8_STAGE(PG8_SB(0, 1), cB + hstep, voffB); PG8_STAGE(PG8_SA(0, 1), cA + hstep, voffA);
        if (wr == 1) PG8_BAR;
        PG8_WAIT_V(4); PG8_BAR;
        PG8_STAGE(PG8_SB(1, 0), cB + kstep, voffB); PG8_STAGE(PG8_SA(1, 0), cA + kstep, voffA); PG8_STAGE(PG8_SB(1, 1), cB + hstep + kstep, voffB);
        PG8_WAIT_V(6); PG8_BAR;
    }
    for (;;) {
        const bool has_next = S.next(ui + 1, nxt);
        const char* nA = has_next ? (const char*)g.A + (size_t)nxt.pm * tstep + (size_t)nxt.k0 * kstep : cA; const char* nB = has_next ? (const char*)g.Bt + (size_t)nxt.pn * tstep + (size_t)nxt.k0 * kstep : cB;
        for (int t = 0; t < nt; t += 2) {
            const bool last = (t == nt - 2);
            const char* a1 = cA + (size_t)(t + 1) * kstep;
            const char* a2 = last ? nA : cA + (size_t)(t + 2) * kstep; const char* b2 = last ? nB : cB + (size_t)(t + 2) * kstep;
            const char* a3 = a2 + kstep; const char* b3 = b2 + kstep;
            if (last && has_next) S.a_ready(nxt);
            if constexpr (SP2) {
            PG8_LDB(B0, 0, 0); PG8_LDB(B1, 0, 1); PG8_SCHED; PG8_LDA(At, 0, 0); PG8_STAGE(PG8_SA(1, 1), a1 + hstep, voffA);
            PG8_WAIT_V(8); PG8_WAIT_L(0); PG8_BAR; PG8_MMA(0, 0, At, B0); PG8_MMA(0, 1, At, B1); PG8_BAR; PG8_SCHED;
            PG8_LDA(At, 0, 1); PG8_STAGE(PG8_SB(0, 0), b2, voffB); PG8_STAGE(PG8_SB(0, 1), b2 + hstep, voffB); PG8_STAGE(PG8_SA(0, 0), a2, voffA);
            PG8_WAIT_V(8); PG8_WAIT_L(0); PG8_BAR; PG8_MMA(1, 0, At, B0); PG8_MMA(1, 1, At, B1); PG8_BAR; PG8_SCHED;
            PG8_LDB(B0, 1, 0); PG8_LDB(B1, 1, 1); PG8_SCHED; PG8_LDA(At, 1, 0); PG8_STAGE(PG8_SA(0, 1), a2 + hstep, voffA);
            PG8_WAIT_V(8); PG8_WAIT_L(0); PG8_BAR; PG8_MMA(0, 0, At, B0); PG8_MMA(0, 1, At, B1); PG8_BAR; PG8_SCHED;
            PG8_LDA(At, 1, 1); PG8_STAGE(PG8_SB(1, 0), b3, voffB); PG8_STAGE(PG8_SB(1, 1), b3 + hstep, voffB); PG8_STAGE(PG8_SA(1, 0), a3, voffA);
            PG8_WAIT_V(8); PG8_WAIT_L(0); PG8_BAR; PG8_MMA(1, 0, At, B0); PG8_MMA(1, 1, At, B1); PG8_BAR; PG8_SCHED;
            } else {
            PG8_LDB(B0, 0, 0); PG8_SCHED; PG8_LDA(At, 0, 0); PG8_STAGE(PG8_SA(1, 1), a1 + hstep, voffA);
            PG8_WAIT_L(8); PG8_BAR; PG8_WAIT_L(0); PG8_MMA(0, 0, At, B0); PG8_BAR; PG8_SCHED;
            PG8_LDB(B1, 0, 1); PG8_STAGE(PG8_SB(0, 0), b2, voffB);
            PG8_BAR; PG8_WAIT_L(0); PG8_MMA(0, 1, At, B1); PG8_BAR;
            PG8_LDA(At, 0, 1); PG8_STAGE(PG8_SA(0, 0), a2, voffA);
            PG8_BAR; PG8_WAIT_L(0); PG8_MMA(1, 0, At, B0); PG8_BAR; PG8_SCHED;
            PG8_STAGE(PG8_SB(0, 1), b2 + hstep, voffB);
            PG8_WAIT_V(6); PG8_BAR; PG8_MMA(1, 1, At, B1); PG8_BAR;
            PG8_LDB(B0, 1, 0); PG8_SCHED; PG8_LDA(At, 1, 0); PG8_STAGE(PG8_SA(0, 1), a2 + hstep, voffA);
            PG8_WAIT_L(8); PG8_BAR; PG8_WAIT_L(0); PG8_MMA(0, 0, At, B0); PG8_BAR; PG8_SCHED;
            PG8_LDB(B1, 1, 1); PG8_STAGE(PG8_SB(1, 0), b3, voffB);
            PG8_BAR; PG8_WAIT_L(0); PG8_MMA(0, 1, At, B1); PG8_BAR;
            PG8_LDA(At, 1, 1); PG8_STAGE(PG8_SA(1, 0), a3, voffA);
            PG8_BAR; PG8_WAIT_L(0); PG8_MMA(1, 0, At, B0); PG8_BAR; PG8_SCHED;
            PG8_STAGE(PG8_SB(1, 1), b3 + hstep, voffB);
            PG8_WAIT_V(6); PG8_BAR; PG8_MMA(1, 1, At, B1); PG8_BAR;
            }
        }
        bool partial = false;
        if constexpr (Epi::MIDK) { if (cur.flags & 3) PG8_RS_APPLY(); partial = (cur.flags & 1) != 0; }
        if (!partial) {
        if constexpr (ALIGN_EPI) { if (wr == 0) PG8_BAR; }
        if constexpr (!Epi::AFTER_DRAIN) { if (!E.deferred(cur)) E(acc, cur, wr, wc, fr, fq); S.done(cur); }
        }
        if (!has_next) break;
        if (!partial) {
#pragma unroll
        for (int a = 0; a < 2; ++a)
#pragma unroll
            for (int b = 0; b < 2; ++b)
#pragma unroll
                for (int m = 0; m < 4; ++m)
#pragma unroll
                    for (int n = 0; n < 2; ++n) acc[a][b][m][n] = (f32x4){0.f, 0.f, 0.f, 0.f};
        }
        cur = nxt; cA = nA; cB = nB; ++ui; nt = cur.nt ? cur.nt : K / BK;
        if (!partial) {
        if constexpr (Epi::MIDK) { PG8_RS_UNIT(cur); }
        if constexpr (ALIGN_EPI) { if (wr == 1) PG8_BAR; }
        }
    }
    PG8_WAIT_V(0);
    if constexpr (!ALIGN_EPI) { if (wr == 0) PG8_BAR; }
    PG8_BAR;
    if constexpr (Epi::AFTER_DRAIN) { E.fused(acc, cur, wr, wc, fr, fq, lds, wid, lane); S.done(cur); }
    else { if (E.deferred(cur)) E.fused(acc, cur, wr, wc, fr, fq, lds, wid, lane); }
#undef PG8_RS_UNIT
#undef PG8_RS_APPLY
#undef PG8_SA
#undef PG8_SB
#undef PG8_STAGE
#undef PG8_LDA
#undef PG8_LDB
#undef PG8_MMA
#undef PG8_WAIT_V
#undef PG8_WAIT_L
#undef PG8_BAR
#undef PG8_SCHED
}
}

#ifndef SSD2PASS
#define SSD2PASS 0
#endif
#ifndef SSD2F
#define SSD2F 0
#endif
#ifndef MERGEB
#define MERGEB 1
#endif
#ifndef MK_ONE
#define MK_ONE 1
#endif
constexpr int DM = 1024, NB_P = 8, SEQ_P = 2048, NB_S = 128, SEQ_S = 8, DEPTH = 2;
constexpr int MP = NB_P * SEQ_P, MS = NB_S * SEQ_S, MT = MP + MS;
constexpr int IN_DIM = 5656, NU = 5632, NG = 24, DFF = 4096, MIXW = 2048, CONVD = 1536, LRUW = 512;
constexpr int MODLD = 6144, MODROWS = 160;
constexpr float EPS = 1e-6f;
constexpr int UC_Z = 0, UC_XBC = 1024, UC_Q = 2560, UC_K = 3072, UC_V = 3584, UC_O = 4096, UC_XR = 4608, UC_GR = 5120;
constexpr size_t O_YP = 0, O_YS = O_YP + (size_t)MP * DM;
constexpr size_t O_P_SSM = O_YS + (size_t)MS * DM, O_P_SCONV = O_P_SSM + (size_t)DEPTH * NB_P * 16 * 64 * 128, O_P_MC = O_P_SCONV + (size_t)DEPTH * NB_P * 3 * CONVD,
                 O_P_MN = O_P_MC + (size_t)DEPTH * NB_P * 4 * 128 * 128, O_P_MM = O_P_MN + (size_t)DEPTH * NB_P * 4 * 128, O_P_LH = O_P_MM + (size_t)DEPTH * NB_P * 4,
                 O_P_LCONV = O_P_LH + (size_t)DEPTH * NB_P * LRUW;
constexpr size_t O_S_SSM = O_P_LCONV + (size_t)DEPTH * NB_P * 3 * LRUW, O_S_SCONV = O_S_SSM + (size_t)DEPTH * NB_S * 16 * 64 * 128, O_S_MC = O_S_SCONV + (size_t)DEPTH * NB_S * 3 * CONVD,
                 O_S_MN = O_S_MC + (size_t)DEPTH * NB_S * 4 * 128 * 128, O_S_MM = O_S_MN + (size_t)DEPTH * NB_S * 4 * 128, O_S_LH = O_S_MM + (size_t)DEPTH * NB_S * 4,
                 O_S_LCONV = O_S_LH + (size_t)DEPTH * NB_S * LRUW, O_END = O_S_LCONV + (size_t)DEPTH * NB_S * 3 * LRUW;
static_assert(O_END == 73253952, "output size");
constexpr size_t MiB = 1u << 20;
constexpr size_t WS_CTL = 0, CTL_ZERO_BYTES = 131072;
constexpr size_t WS_WG = 1 * MiB, WS_MOD = 2 * MiB, WS_WIN = 10 * MiB, WS_WOUT = 32 * MiB, WS_WUP = 40 * MiB, WS_WDN = 56 * MiB;
constexpr size_t WS_GATES = 72 * MiB, WS_SSQ = 74 * MiB, WS_HN = 76 * MiB, WS_XW = 110 * MiB, WS_YCAT = 178 * MiB, WS_YZ = 246 * MiB, WS_U = 315 * MiB, WS_END = 503 * MiB;
constexpr size_t WS_HID = WS_U;
static_assert(WS_U + (size_t)MT * NU * 2 <= WS_END && (size_t)MT * DFF * 2 <= (size_t)MT * NU * 2 && WS_MOD + (size_t)DEPTH * MODROWS * MODLD * 4 <= WS_WIN, "ws map");
static_assert((size_t)DEPTH * NU * DM * 2 == WS_WOUT - WS_WIN && (size_t)MT * DM * 2 == WS_XW - WS_HN && (size_t)MT * DM * 4 == WS_YCAT - WS_XW && (size_t)MT * MIXW * 2 == WS_YZ - WS_YCAT, "ws map 2");
constexpr int CW_Q = 64;
constexpr int CW_BAR = 4096;
constexpr int CW_FLAG2 = 16384;
constexpr int CW_FLAG = 8192;
static_assert((CW_FLAG + 64 * 128) <= CW_FLAG2 && (CW_FLAG2 + 16 * 512) * 4 <= (int)CTL_ZERO_BYTES, "flags inside the per-call memset");
constexpr int RING_BYTES = 131072, LDS_BYTES = 147456, MISC_OFF = LDS_BYTES - 128, LDSCTL_OFF = MISC_OFF;
constexpr int NWAVES = 8, NTHR = 512;

#define GAS __attribute__((address_space(1)))
#define LAS __attribute__((address_space(3)))
typedef unsigned short bf16;
typedef unsigned v4u __attribute__((ext_vector_type(4)));
typedef unsigned v2u __attribute__((ext_vector_type(2)));
typedef float f32x4 __attribute__((ext_vector_type(4)));
typedef float f32x16 __attribute__((ext_vector_type(16)));
#define LDS_WAIT() asm volatile("s_waitcnt lgkmcnt(0)" ::: "memory")
#define LBAR() do { asm volatile("s_waitcnt lgkmcnt(0)" ::: "memory"); __builtin_amdgcn_s_barrier(); asm volatile("" ::: "memory"); } while (0)
__device__ __forceinline__ float bf2f(bf16 h) { return __uint_as_float((unsigned)h << 16); }
typedef short bf16x8 __attribute__((ext_vector_type(8)));
__device__ __forceinline__ float lo_bf(unsigned u) { return __uint_as_float(u << 16); }
__device__ __forceinline__ float hi_bf(unsigned u) { return __uint_as_float(u & 0xffff0000u); }
template <int CTRL> __device__ __forceinline__ float dppf(float v) { return __builtin_bit_cast(float, __builtin_amdgcn_update_dpp(0, __builtin_bit_cast(int, v), CTRL, 0xF, 0xF, false)); }
__device__ __forceinline__ float row16_sum(float v) { v += dppf<0xB1>(v); v += dppf<0x4E>(v); v += dppf<0x141>(v); v += dppf<0x140>(v); return v; }
__device__ __forceinline__ float row8_sum(float v) { v += dppf<0xB1>(v); v += dppf<0x4E>(v); v += dppf<0x141>(v); return v; }
__device__ __forceinline__ float xchg16(float v, int lane) { const auto r = __builtin_amdgcn_permlane16_swap(__float_as_uint(v), __float_as_uint(v), false, false); return __uint_as_float((lane & 16) ? r[0] : r[1]); }
__device__ __forceinline__ float xchg32(float v, int lane) { const auto r = __builtin_amdgcn_permlane32_swap(__float_as_uint(v), __float_as_uint(v), false, false); return __uint_as_float((lane & 32) ? r[0] : r[1]); }
__device__ __forceinline__ float xsum16(float v) { const auto r = __builtin_amdgcn_permlane16_swap(__float_as_uint(v), __float_as_uint(v), false, false); return __uint_as_float(r[0]) + __uint_as_float(r[1]); }
__device__ __forceinline__ float xsum32(float v) { const auto r = __builtin_amdgcn_permlane32_swap(__float_as_uint(v), __float_as_uint(v), false, false); return __uint_as_float(r[0]) + __uint_as_float(r[1]); }
__device__ __forceinline__ float wave_sum(float v) { v = row16_sum(v); v += __shfl_xor(v, 16); v += __shfl_xor(v, 32); return v; }
__device__ __forceinline__ float fexp(float x) { return __builtin_amdgcn_exp2f(x * 1.4426950408889634f); }
__device__ __forceinline__ float frcp(float x) { return __builtin_amdgcn_rcpf(x); }
__device__ __forceinline__ float sigmoidf_(float x) { return frcp(1.f + fexp(-x)); }
__device__ __forceinline__ float siluf_(float x) { return x * frcp(1.f + fexp(-x)); }
__device__ __forceinline__ float softplusf_(float x) { return fmaxf(x, 0.f) + 0.6931471805599453f * __builtin_amdgcn_logf(1.f + fexp(-fabsf(x))); }
__device__ __forceinline__ float gelu_tanhf_(float x) { const float u = 0.7978845608028654f * (x + 0.044715f * x * x * x); return 0.5f * x * (2.f - 2.f * frcp(fexp(2.f * u) + 1.f)); }
typedef float f32x2_t __attribute__((ext_vector_type(2))); typedef __bf16 bf16x2_t __attribute__((ext_vector_type(2)));
__device__ __forceinline__ unsigned pk2(float lo, float hi) { f32x2_t v = {lo, hi}; bf16x2_t b = __builtin_convertvector(v, bf16x2_t); return __builtin_bit_cast(unsigned, b); }
__device__ __forceinline__ unsigned f2bf(float f) { return pk2(f, 0.f) & 0xffffu; }
__device__ __forceinline__ int modrow(int row) { return row < MP ? (row >> 11) : NB_P + ((row - MP) >> 3); }

#define XB_TMO      128
#define XB_XCNT(j)  (256  + 64 * (j))
#define XB_XSUB(j)  (1280 + 64 * (j))
#define XB_XGEN(j)  (2304 + 64 * (j))
#define XB_TOP      3328
#define XB_TOPGEN   3392
#define XCD_BAR_WORDS 3456
#define XB_SPIN_CAP (1u << 18)
__device__ __forceinline__ unsigned xb_ld(unsigned* p)              { return __hip_atomic_load(p, __ATOMIC_RELAXED, __HIP_MEMORY_SCOPE_AGENT); }
__device__ __forceinline__ unsigned xb_add(unsigned* p, unsigned v) { return __hip_atomic_fetch_add(p, v, __ATOMIC_RELAXED, __HIP_MEMORY_SCOPE_AGENT); }
__device__ __forceinline__ unsigned xb_xcc_id() { return (unsigned)__builtin_amdgcn_s_getreg((3 << 11) | 20) & 0xFu; }
#define XB_SPIN(cond, bar) do { unsigned _sp = 0; while (cond) { __builtin_amdgcn_s_sleep(1); \
    if ((++_sp & 255u) == 0u) { if (xb_ld(&(bar)[XB_TMO])) break; if (_sp > XB_SPIN_CAP) { atomicAdd(&(bar)[XB_TMO], 1u); break; } } } } while (0)
struct XcdBarrier { unsigned* bar; unsigned x; volatile LAS unsigned* st; };
__device__ __forceinline__ XcdBarrier xcd_barrier_post(unsigned* bar, volatile LAS unsigned* st, int tid) {
    XcdBarrier b; b.bar = bar; b.x = xb_xcc_id(); b.st = st;
    if (tid == 0) (void)xb_add(&bar[XB_XCNT(b.x)], 1u);
    return b;
}
__device__ __forceinline__ void xcd_barrier_complete(unsigned* bar, unsigned x, unsigned& nloc, unsigned& nx) {
    const unsigned G = gridDim.x * gridDim.y * gridDim.z;
    unsigned sum, cnt, mine, sp = 0u;
    for (;;) {
        sum = 0u; cnt = 0u; mine = 0u;
#pragma unroll
        for (unsigned j = 0; j < 16; ++j) { const unsigned c = xb_ld(&bar[XB_XCNT(j)]); sum += c; cnt += (c > 0u) ? 1u : 0u; mine = (j == x) ? c : mine; }
        if (sum == G) break;
        __builtin_amdgcn_s_sleep(1);
        if ((++sp & 255u) == 0u) { if (xb_ld(&bar[XB_TMO])) break; if (sp > XB_SPIN_CAP) { atomicAdd(&bar[XB_TMO], 1u); break; } }
    }
    nloc = mine > 0u ? mine : 1u; nx = cnt > 0u ? cnt : 1u;
}
__device__ __forceinline__ void xcd_barrier(const XcdBarrier& b, int tid) {
    asm volatile("s_waitcnt vmcnt(0)" ::: "memory");
    __syncthreads();
    if (tid == 0) {
        unsigned* bar = b.bar;
        __builtin_amdgcn_s_waitcnt(0);
        unsigned nloc = b.st[0], nx = b.st[1];
        if (nloc == 0u) { xcd_barrier_complete(bar, b.x, nloc, nx); b.st[0] = nloc; b.st[1] = nx; }
        const unsigned old = xb_add(&bar[XB_XSUB(b.x)], 1u);
        const unsigned gen = old / nloc;
        if (old + 1u == (gen + 1u) * nloc) {
            __builtin_amdgcn_fence(__ATOMIC_RELEASE, "agent");
            asm volatile("s_waitcnt vmcnt(0)" ::: "memory");
            const unsigned og = xb_add(&bar[XB_TOP], 1u);
            const unsigned tg = og / nx;
            if (og + 1u == (tg + 1u) * nx) xb_add(&bar[XB_TOPGEN], 1u);
            else XB_SPIN(xb_ld(&bar[XB_TOPGEN]) == tg, bar);
            __builtin_amdgcn_fence(__ATOMIC_ACQUIRE, "agent");
            xb_add(&bar[XB_XGEN(b.x)], 1u);
            asm volatile("s_waitcnt vmcnt(0)" ::: "memory");
        } else {
            XB_SPIN(xb_ld(&bar[XB_XGEN(b.x)]) == gen, bar);
            __builtin_amdgcn_fence(__ATOMIC_ACQUIRE, "agent");
            asm volatile("s_waitcnt vmcnt(0)" ::: "memory");
        }
    }
    __syncthreads();
}

struct Args { const float* in[36]; float* out; unsigned char* ws; int ph_lo, ph_hi; };
enum { I_XP = 0, I_XS, I_CP, I_CS, I_SSM, I_SCONV, I_MC, I_MN, I_MM, I_LH, I_LCONV, I_ADAW, I_ADAB, I_N1W, I_N2W, I_WIN, I_SCW, I_SCB, I_DTB, I_ALOG, I_SSD_D, I_SNW,
       I_MIB, I_MFB, I_MNW, I_LCW, I_LCB, I_LWA, I_LBA, I_LWX, I_LBX, I_LLAM, I_WOUT, I_WUP, I_WDN, I_FNW };
struct Frame { LAS unsigned char* lds; int tid, lane, wave, G; };
typedef const __attribute__((address_space(4))) unsigned char* kargp_t;
__device__ __forceinline__ const float* INP(int i) { asm volatile("" : "+s"(i)); return *(const float* const __attribute__((address_space(4)))*)((kargp_t)__builtin_amdgcn_kernarg_segment_ptr() + 8 * i); }
__device__ __forceinline__ float* OUTP() { int o = 288; asm volatile("" : "+s"(o)); return *(float* const __attribute__((address_space(4)))*)((kargp_t)__builtin_amdgcn_kernarg_segment_ptr() + o); }
__device__ __forceinline__ unsigned char* WSP(size_t off) { int o = 296; asm volatile("" : "+s"(o)); unsigned char* w = *(unsigned char* const __attribute__((address_space(4)))*)((kargp_t)__builtin_amdgcn_kernarg_segment_ptr() + o); return w + off; }
static_assert(offsetof(Args, out) == 288 && offsetof(Args, ws) == 296, "kernarg layout");
#define P_CTL   ((unsigned*)WSP(WS_CTL))
#define P_WG    ((float*)WSP(WS_WG))
#define P_MOD   ((float*)WSP(WS_MOD))
#define P_WINT  ((bf16*)WSP(WS_WIN))
#define P_WOUTT ((bf16*)WSP(WS_WOUT))
#define P_WUPT  ((bf16*)WSP(WS_WUP))
#define P_WDNT  ((bf16*)WSP(WS_WDN))
#define P_GATES ((float*)WSP(WS_GATES))
#define P_SSQ   ((float*)WSP(WS_SSQ))
#define P_HN    ((bf16*)WSP(WS_HN))
#define P_XW    ((float*)WSP(WS_XW))
#define P_XWB   ((bf16*)WSP(WS_XW))
#define P_YCAT  ((bf16*)WSP(WS_YCAT))
#define P_YZ    ((float*)WSP(WS_YZ))
#define P_CIN   ((bf16*)WSP(WS_YZ))
#define P_NIN   ((float*)WSP(WS_YZ + 32 * MiB))
#define P_MLG   ((float*)WSP(WS_YZ + 33 * MiB))
#define P_BCA   ((bf16*)WSP(WS_YZ + 34 * MiB))
#define P_U     ((bf16*)WSP(WS_U))
#define P_HID   ((bf16*)WSP(WS_HID))

__device__ __forceinline__ void transpose_item(const float* W, int ldw, int ncs, bf16* WT, int K, int n0, int k0, LAS float* scr, int lane) {
    f32x4 v[8];
#pragma unroll
    for (int i = 0; i < 8; ++i) v[i] = __builtin_nontemporal_load((const f32x4*)(W + (size_t)(k0 + 8 * i + (lane >> 3)) * ldw + ncs + 4 * (lane & 7)));
#pragma unroll
    for (int i = 0; i < 8; ++i) { LAS float* s = scr + (8 * i + (lane >> 3)) * 33 + 4 * (lane & 7); s[0] = v[i].x; s[1] = v[i].y; s[2] = v[i].z; s[3] = v[i].w; }
    LDS_WAIT(); asm volatile("" ::: "memory");
    const int c = lane & 7;
#pragma unroll
    for (int j = 0; j < 4; ++j) { const int n = (lane >> 3) + 8 * j; const LAS float* s = scr + (8 * c) * 33 + n;
        v4u o; o.x = pk2(s[0 * 33], s[1 * 33]); o.y = pk2(s[2 * 33], s[3 * 33]); o.z = pk2(s[4 * 33], s[5 * 33]); o.w = pk2(s[6 * 33], s[7 * 33]);
        *(GAS v4u*)(WT + (size_t)(n0 + n) * K + k0 + 8 * c) = o; }
    LDS_WAIT(); asm volatile("" ::: "memory");
}
constexpr int CI_IN = 16 * 176, CI_OUT = 32 * 32, CI_UP = 16 * 128, CI_DN = 64 * 32, CI_L = CI_IN + CI_OUT + CI_UP + CI_DN, CONV_EARLY = CI_IN, CONV_ALL = DEPTH * CI_L;
__device__ __forceinline__ void convert_item(Frame& F, int it) {
    LAS float* scr = (LAS float*)(F.lds + F.wave * 16384);
    const int l = it / CI_L; int r = it % CI_L;
    if (r < CI_IN) { const int kb = r / 176, nb = r % 176, n0 = nb * 32, ncs = n0 + (n0 >= 2560 ? 16 : 0) + (n0 >= 4608 ? 8 : 0);
        transpose_item(INP(I_WIN) + (size_t)l * 1024 * IN_DIM, IN_DIM, ncs, P_WINT + (size_t)l * NU * 1024, 1024, n0, kb * 64, scr, F.lane); return; } r -= CI_IN;
    if (r < CI_OUT) { const int kb = r / 32, nb = r % 32; transpose_item(INP(I_WOUT) + (size_t)l * MIXW * DM, DM, nb * 32, P_WOUTT + (size_t)l * DM * MIXW, MIXW, nb * 32, kb * 64, scr, F.lane); return; } r -= CI_OUT;
    if (r < CI_UP) { const int kb = r / 128, nb = r % 128; transpose_item(INP(I_WUP) + (size_t)l * DM * DFF, DFF, nb * 32, P_WUPT + (size_t)l * DFF * DM, DM, nb * 32, kb * 64, scr, F.lane); return; } r -= CI_UP;
    { const int kb = r / 32, nb = r % 32; transpose_item(INP(I_WDN) + (size_t)l * DFF * DM, DM, nb * 32, P_WDNT + (size_t)l * DM * DFF, DFF, nb * 32, kb * 64, scr, F.lane); }
}
__device__ __forceinline__ void p0_prologue(Frame& F) {
    const float* c_p = INP(I_CP); const float* c_s = INP(I_CS); const float* ada_w = INP(I_ADAW); const float* ada_b = INP(I_ADAB);
    constexpr int ASTR = 2064;
    static_assert(2 * 32 * ASTR <= MISC_OFF && RING_BYTES + 2048 <= MISC_OFF, "mod A images / GEMM rs table fit below MISC");
    LAS unsigned char* ahi = F.lds; LAS unsigned char* alo = F.lds + 32 * ASTR;
    const bool sw = F.G == 256;
    for (int it0 = blockIdx.x; it0 < (sw ? 256 : DEPTH * 5 * 24); it0 += F.G) {
        int it = it0;
        if (sw) { const int xcd = it0 & 7, s = it0 >> 3; if (s >= 30) break; it = (xcd * 6 + s / 5) * 5 + s % 5; }
        const int rb = it % 5, cg = (it / 5) % 24, l = it / 120;
        const int j0 = cg * 256 + F.wave * 32; const float* wl = ada_w + (size_t)l * 1024 * MODLD + j0 + (F.lane & 31) + (size_t)(8 * (F.lane >> 5)) * MODLD;
        float wA[4][8], wB[4][8];
        auto ldw = [&](int ks, float (&w)[8]) {
#pragma unroll
            for (int jj = 0; jj < 8; ++jj) w[jj] = wl[(size_t)(ks * 16 + jj) * MODLD]; };
#pragma unroll
        for (int j = 0; j < 4; ++j) ldw(j, wA[j]);
        asm volatile("" ::: "memory");
        { f32x4 cv[16];
#pragma unroll
          for (int i = 0; i < 16; ++i) { const int idx = F.tid + NTHR * i, rr = idx >> 8, k = 4 * (idx & 255), r = rb * 32 + rr, rc = r < NB_P + NB_S ? r : NB_P + NB_S - 1;
              const float* cp = rc < NB_P ? c_p + rc * 1024 + k : c_s + (rc - NB_P) * 1024 + k; cv[i] = *(const f32x4*)cp; }
#pragma unroll
          for (int i = 0; i < 16; ++i) { const int idx = F.tid + NTHR * i, rr = idx >> 8, k = 4 * (idx & 255), r = rb * 32 + rr; const bool ok = r < NB_P + NB_S;
              const float v0 = ok ? siluf_(cv[i].x) : 0.f, v1 = ok ? siluf_(cv[i].y) : 0.f, v2 = ok ? siluf_(cv[i].z) : 0.f, v3 = ok ? siluf_(cv[i].w) : 0.f;
              v2u h, lo; h.x = pk2(v0, v1); h.y = pk2(v2, v3); lo.x = pk2(v0 - lo_bf(h.x), v1 - hi_bf(h.x)); lo.y = pk2(v2 - lo_bf(h.y), v3 - hi_bf(h.y));
              *(LAS v2u*)(ahi + rr * ASTR + k * 2) = h; *(LAS v2u*)(alo + rr * ASTR + k * 2) = lo; } }
        LBAR();
        f32x16 acc; for (int r = 0; r < 16; ++r) acc[r] = 0.f;
        const int aoff = (F.lane & 31) * ASTR + (F.lane >> 5) * 16;
        auto cmp = [&](int ks, const float (&wv)[8]) {
            const bf16x8 ah = *(const LAS bf16x8*)(ahi + aoff + ks * 32), al = *(const LAS bf16x8*)(alo + aoff + ks * 32);
            v4u bh, bl;
#pragma unroll
            for (int e = 0; e < 4; ++e) { const unsigned h2 = pk2(wv[2 * e], wv[2 * e + 1]); bh[e] = h2; bl[e] = pk2(wv[2 * e] - lo_bf(h2), wv[2 * e + 1] - hi_bf(h2)); }
            const bf16x8 bhf = __builtin_bit_cast(bf16x8, bh), blf = __builtin_bit_cast(bf16x8, bl);
            acc = __builtin_amdgcn_mfma_f32_32x32x16_bf16(ah, bhf, acc, 0, 0, 0); acc = __builtin_amdgcn_mfma_f32_32x32x16_bf16(al, bhf, acc, 0, 0, 0); acc = __builtin_amdgcn_mfma_f32_32x32x16_bf16(ah, blf, acc, 0, 0, 0); };
#pragma unroll 1
        for (int ks = 0; ks < 56; ks += 8) {
#pragma unroll
            for (int j = 0; j < 4; ++j) ldw(ks + 4 + j, wB[j]);
            asm volatile("" ::: "memory");
#pragma unroll
            for (int j = 0; j < 4; ++j) cmp(ks + j, wA[j]);
#pragma unroll
            for (int j = 0; j < 4; ++j) ldw(ks + 8 + j, wA[j]);
            asm volatile("" ::: "memory");
#pragma unroll
            for (int j = 0; j < 4; ++j) cmp(ks + 4 + j, wB[j]);
        }
#pragma unroll
        for (int j = 0; j < 4; ++j) ldw(60 + j, wB[j]);
        asm volatile("" ::: "memory");
#pragma unroll
        for (int j = 0; j < 4; ++j) cmp(56 + j, wA[j]);
#pragma unroll
        for (int j = 0; j < 4; ++j) cmp(60 + j, wB[j]);
        const int col = j0 + (F.lane & 31); const float bb = ada_b[l * MODLD + col];
#pragma unroll
        for (int r = 0; r < 16; ++r) { const int row = rb * 32 + (r & 3) + 8 * (r >> 2) + 4 * (F.lane >> 5); P_MOD[((size_t)l * MODROWS + row) * MODLD + col] = acc[r] + bb; }
        __syncthreads();
    }
    { const float* w_in = INP(I_WIN);
      for (int idx = blockIdx.x * NTHR + F.tid; idx < DEPTH * NG * 1024; idx += F.G * NTHR) { const int k = idx & 1023, j = (idx >> 10) % NG, l = idx / (NG * 1024);
          const int col = j < 16 ? 2560 + j : 4624 + (j - 16); P_WG[idx] = w_in[((size_t)l * 1024 + k) * IN_DIM + col]; } }
    for (int it = blockIdx.x * NWAVES + F.wave; it < CONV_EARLY; it += F.G * NWAVES) convert_item(F, it);
}

template <bool GATESP>
__device__ __forceinline__ void norm_phase(Frame& F, int l, int which) {
    LAS float* wg = (LAS float*)F.lds;
    if (GATESP) { for (int i = F.tid; i < NG * 1024 / 4; i += NTHR) ((LAS f32x4*)wg)[i] = ((const f32x4*)(P_WG + (size_t)l * NG * 1024))[i]; __syncthreads(); }
    const int gw = blockIdx.x * NWAVES + F.wave, NGW = F.G * NWAVES;
    const float* nwp = (which == 1 ? INP(I_N1W) : INP(I_N2W)) + l * DM;
    f32x4 nw4[4];
#pragma unroll
    for (int j = 0; j < 4; ++j) nw4[j] = *(const f32x4*)(nwp + 4 * F.lane + 256 * j);
    constexpr int RPW = GATESP ? 2 : 1;
    const bool first = (which == 1 && l == 0);
    constexpr bool PFMOD = !GATESP;
    f32x4 xn[RPW][4], shn[RPW][4], scn[RPW][4];
    auto load_mod = [&](int row0) {
#pragma unroll
        for (int rr = 0; rr < RPW; ++rr) { const float* mrow = P_MOD + ((size_t)l * MODROWS + modrow(row0 + rr)) * MODLD + (which == 1 ? 0 : 3072);
#pragma unroll
            for (int j = 0; j < 4; ++j) { shn[rr][j] = *(const f32x4*)(mrow + 4 * F.lane + 256 * j); scn[rr][j] = *(const f32x4*)(mrow + 1024 + 4 * F.lane + 256 * j); } }
    };
    auto load_rows = [&](int row0) {
#pragma unroll
        for (int rr = 0; rr < RPW; ++rr) { const int row = row0 + rr;
            if (!first && row < MP) { const unsigned long long* xr = (const unsigned long long*)(P_XWB + (size_t)row * DM) + F.lane;
#pragma unroll
                for (int j = 0; j < 4; ++j) { const unsigned long long t = xr[64 * j]; xn[rr][j].x = __uint_as_float((unsigned)t); xn[rr][j].y = __uint_as_float((unsigned)(t >> 32)); } }
            else { const float* xrow = first ? (row < MP ? INP(I_XP) + (size_t)row * DM : INP(I_XS) + (size_t)(row - MP) * DM) : P_XW + (size_t)row * DM;
#pragma unroll
                for (int j = 0; j < 4; ++j) xn[rr][j] = *((const f32x4*)xrow + F.lane + 64 * j); } }
        if (PFMOD) load_mod(row0);
    };
    if (gw * RPW < MT) load_rows(gw * RPW);
    for (int row0 = gw * RPW; row0 < MT; row0 += NGW * RPW) {
        f32x4 va[4], vb[4];
        f32x4 xv[RPW][4], shv[RPW][4], scv[RPW][4];
        if (!PFMOD) load_mod(row0);
#pragma unroll
        for (int rr = 0; rr < RPW; ++rr)
#pragma unroll
            for (int j = 0; j < 4; ++j) { xv[rr][j] = xn[rr][j]; shv[rr][j] = shn[rr][j]; scv[rr][j] = scn[rr][j]; }
        if (row0 + NGW * RPW < MT) load_rows(row0 + NGW * RPW);
#pragma unroll
        for (int rr = 0; rr < RPW; ++rr) { const int row = row0 + rr; f32x4 v[4]; float s = 0.f;
#pragma unroll
            for (int j = 0; j < 4; ++j) { v[j] = xv[rr][j];
                if (!first && row < MP) { const unsigned lo = __float_as_uint(v[j].x), hi = __float_as_uint(v[j].y); v[j] = (f32x4){lo_bf(lo), hi_bf(lo), lo_bf(hi), hi_bf(hi)}; }
                s += (v[j].x * v[j].x + v[j].y * v[j].y) + (v[j].z * v[j].z + v[j].w * v[j].w); }
            const float rstd = rsqrtf(wave_sum(s) * (1.f / DM) + EPS);
            if (first && row >= MP) { f32x4* xo = (f32x4*)(P_XW + (size_t)row * DM) + F.lane;
#pragma unroll
                for (int j = 0; j < 4; ++j) xo[64 * j] = v[j]; }
            if (first && row < MP) { unsigned long long* xo = (unsigned long long*)(P_XWB + (size_t)row * DM) + F.lane;
#pragma unroll
                for (int j = 0; j < 4; ++j) xo[64 * j] = (unsigned long long)pk2(v[j].x, v[j].y) | ((unsigned long long)pk2(v[j].z, v[j].w) << 32); }
            unsigned long long* o8 = (unsigned long long*)(P_HN + (size_t)row * DM) + F.lane;
#pragma unroll
            for (int j = 0; j < 4; ++j) { v[j] = v[j] * rstd * nw4[j] * (scv[rr][j] + 1.f) + shv[rr][j];
                o8[64 * j] = (unsigned long long)pk2(v[j].x, v[j].y) | ((unsigned long long)pk2(v[j].z, v[j].w) << 32);
                if (rr == 0) va[j] = v[j]; else vb[j] = v[j]; } }
        if (GATESP) {
            const bool b5 = F.lane & 32, b4 = F.lane & 16, b3 = F.lane & 8, b2 = F.lane & 4;
            float p[NG];
            f32x4 wq[4];
#pragma unroll
            for (int j = 0; j < 4; ++j) wq[j] = *(const LAS f32x4*)(wg + 4 * F.lane + 256 * j);
#pragma unroll
            for (int g = 0; g < NG; ++g) { f32x2_t c0 = {0.f, 0.f}, c1 = {0.f, 0.f};
                f32x4 wc[4];
#pragma unroll
                for (int j = 0; j < 4; ++j) wc[j] = wq[j];
                if (g + 1 < NG) {
#pragma unroll
                    for (int j = 0; j < 4; ++j) wq[j] = *(const LAS f32x4*)(wg + (g + 1) * 1024 + 4 * F.lane + 256 * j); }
                asm volatile("" : "+v"(wc[0]), "+v"(wc[1]), "+v"(wc[2]), "+v"(wc[3]) :: "memory");
#pragma unroll
                for (int j = 0; j < 4; ++j) { const f32x4 w4 = wc[j];
                    const f32x2_t wl = __builtin_shufflevector(w4, w4, 0, 1), wh = __builtin_shufflevector(w4, w4, 2, 3);
                    c0 = __builtin_elementwise_fma(__builtin_shufflevector(va[j], va[j], 0, 1), wl, c0); c0 = __builtin_elementwise_fma(__builtin_shufflevector(va[j], va[j], 2, 3), wh, c0);
                    c1 = __builtin_elementwise_fma(__builtin_shufflevector(vb[j], vb[j], 0, 1), wl, c1); c1 = __builtin_elementwise_fma(__builtin_shufflevector(vb[j], vb[j], 2, 3), wh, c1); }
                const float a0 = c0.x + c0.y, a1 = c1.x + c1.y;
                const float send = b5 ? a0 : a1, keep = b5 ? a1 : a0; p[g] = keep + __shfl_xor(send, 32); }
            float q[12], r6[6], s3[3];
#pragma unroll
            for (int g = 0; g < 12; ++g) { const float send = b4 ? p[g] : p[g + 12], keep = b4 ? p[g + 12] : p[g]; q[g] = keep + __shfl_xor(send, 16); }
#pragma unroll
            for (int g = 0; g < 6; ++g) { const float send = b3 ? q[g] : q[g + 6], keep = b3 ? q[g + 6] : q[g]; r6[g] = keep + __shfl_xor(send, 8); }
#pragma unroll
            for (int g = 0; g < 3; ++g) { const float send = b2 ? r6[g] : r6[g + 3], keep = b2 ? r6[g + 3] : r6[g]; float s = keep + __shfl_xor(send, 4);
                s += __shfl_xor(s, 2); s += __shfl_xor(s, 1); s3[g] = s; }
            if ((F.lane & 3) == 0) { float* go = P_GATES + (size_t)(row0 + (b5 ? 1 : 0)) * NG + (b4 ? 12 : 0) + (b3 ? 6 : 0) + (b2 ? 3 : 0); go[0] = s3[0]; go[1] = s3[1]; go[2] = s3[2]; }
        }
    }
}
typedef __bf16 bf2_t __attribute__((ext_vector_type(2)));
__device__ __forceinline__ float dot2bf(unsigned a, unsigned b, float c) { return __builtin_amdgcn_fdot2_f32_bf16(__builtin_bit_cast(bf2_t, a), __builtin_bit_cast(bf2_t, b), c, false); }
template <int NP>
__device__ __forceinline__ void norm1g_block(Frame& F, int l, bool active, bool prompt, int blk, int part, int aoff, int shoff, int sxo, int dxo) {
    constexpr int WSTR = 2064, WLO = NG * WSTR, NS = 32 / NP, CW = 1024 / NP;
    LAS unsigned char* lds = F.lds; const bool first = l == 0;
    const int lane = F.lane, r = lane & 15, kg = lane >> 4, row = blk * 16 + r, cb = CW * part;
    LAS float* sx = (LAS float*)(lds + sxo); LAS f32x4* dx = (LAS f32x4*)(lds + dxo);
    v4u xp[NS];
    if (active) {
        if (!first && prompt) { const v4u* src = (const v4u*)(P_XWB + (size_t)row * DM + cb) + kg;
#pragma unroll
            for (int j = 0; j < NS; ++j) xp[j] = src[4 * j]; }
        else { const float* src = (first ? (prompt ? INP(I_XP) + (size_t)row * DM : INP(I_XS) + (size_t)(row - MP) * DM) : P_XW + (size_t)row * DM) + cb;
            constexpr int QS = NS < 8 ? NS : 8;
#pragma unroll
            for (int q = 0; q < NS / QS; ++q) { f32x4 t[QS][2];
#pragma unroll
                for (int s8 = 0; s8 < QS; ++s8) { const int cc = 32 * (QS * q + s8) + 8 * kg;
                    if (first) { t[s8][0] = __builtin_nontemporal_load((const f32x4*)(src + cc)); t[s8][1] = __builtin_nontemporal_load((const f32x4*)(src + cc + 4)); }
                    else { t[s8][0] = *(const f32x4*)(src + cc); t[s8][1] = *(const f32x4*)(src + cc + 4); } }
#pragma unroll
                for (int s8 = 0; s8 < QS; ++s8) { const int j = QS * q + s8, cc = cb + 32 * j + 8 * kg;
                    xp[j] = (v4u){pk2(t[s8][0].x, t[s8][0].y), pk2(t[s8][0].z, t[s8][0].w), pk2(t[s8][1].x, t[s8][1].y), pk2(t[s8][1].z, t[s8][1].w)};
                    if (first && !prompt) { *(f32x4*)(P_XW + (size_t)row * DM + cc) = t[s8][0]; *(f32x4*)(P_XW + (size_t)row * DM + cc + 4) = t[s8][1]; } } }
            if (first && prompt) {
#pragma unroll
                for (int j = 0; j < NS; ++j) *(v4u*)(P_XWB + (size_t)row * DM + cb + 32 * j + 8 * kg) = xp[j]; } }
        float ss = 0.f;
#pragma unroll
        for (int j = 0; j < NS; ++j)
#pragma unroll
            for (int e = 0; e < 4; ++e) ss = dot2bf(xp[j][e], xp[j][e], ss);
        ss += __shfl_xor(ss, 16); ss += __shfl_xor(ss, 32);
        if (kg == 0) sx[part * 16 + r] = ss;
    }
    LBAR();
    f32x4 d0 = {0.f, 0.f, 0.f, 0.f}, d1 = {0.f, 0.f, 0.f, 0.f};
    if (active) {
        float st = 0.f;
#pragma unroll
        for (int p = 0; p < NP; ++p) st += sx[p * 16 + r];
        const float rstd = rsqrtf(st * (1.f / DM) + EPS);
        const int g1 = 16 + (r < 8 ? r : 7);
        bf16* hrow = P_HN + (size_t)row * DM;
#pragma unroll
        for (int j = 0; j < NS; ++j) { const int cc = cb + 32 * j + 8 * kg;
            const f32x4 a0 = *(const LAS f32x4*)(lds + aoff + cc * 4), a1 = *(const LAS f32x4*)(lds + aoff + cc * 4 + 16), s0 = *(const LAS f32x4*)(lds + aoff + shoff + cc * 4), s1 = *(const LAS f32x4*)(lds + aoff + shoff + cc * 4 + 16);
            const f32x4 x0 = {lo_bf(xp[j][0]), hi_bf(xp[j][0]), lo_bf(xp[j][1]), hi_bf(xp[j][1])}, x1 = {lo_bf(xp[j][2]), hi_bf(xp[j][2]), lo_bf(xp[j][3]), hi_bf(xp[j][3])};
            const f32x4 h0 = x0 * rstd * a0 + s0, h1 = x1 * rstd * a1 + s1;
            v4u H; H[0] = pk2(h0.x, h0.y); H[1] = pk2(h0.z, h0.w); H[2] = pk2(h1.x, h1.y); H[3] = pk2(h1.z, h1.w);
            *(v4u*)(hrow + cc) = H;
            v4u Lo; Lo[0] = pk2(h0.x - lo_bf(H[0]), h0.y - hi_bf(H[0])); Lo[1] = pk2(h0.z - lo_bf(H[1]), h0.w - hi_bf(H[1])); Lo[2] = pk2(h1.x - lo_bf(H[2]), h1.y - hi_bf(H[2])); Lo[3] = pk2(h1.z - lo_bf(H[3]), h1.w - hi_bf(H[3]));
            const bf16x8 ah = __builtin_bit_cast(bf16x8, H), al = __builtin_bit_cast(bf16x8, Lo);
            const bf16x8 bh0 = *(const LAS bf16x8*)(lds + r * WSTR + cc * 2), bl0 = *(const LAS bf16x8*)(lds + WLO + r * WSTR + cc * 2);
            const bf16x8 bh1 = *(const LAS bf16x8*)(lds + g1 * WSTR + cc * 2), bl1 = *(const LAS bf16x8*)(lds + WLO + g1 * WSTR + cc * 2);
            d0 = __builtin_amdgcn_mfma_f32_16x16x32_bf16(ah, bh0, d0, 0, 0, 0); d1 = __builtin_amdgcn_mfma_f32_16x16x32_bf16(ah, bh1, d1, 0, 0, 0);
            d0 = __builtin_amdgcn_mfma_f32_16x16x32_bf16(al, bh0, d0, 0, 0, 0); d1 = __builtin_amdgcn_mfma_f32_16x16x32_bf16(al, bh1, d1, 0, 0, 0);
            d0 = __builtin_amdgcn_mfma_f32_16x16x32_bf16(ah, bl0, d0, 0, 0, 0); d1 = __builtin_amdgcn_mfma_f32_16x16x32_bf16(ah, bl1, d1, 0, 0, 0); }
        if (part > 0) { dx[((part - 1) * 64 + lane) * 2] = d0; dx[((part - 1) * 64 + lane) * 2 + 1] = d1; }
    }
    LBAR();
    if (active && part == 0) {
#pragma unroll
        for (int p = 1; p < NP; ++p) { d0 += dx[((p - 1) * 64 + lane) * 2]; d1 += dx[((p - 1) * 64 + lane) * 2 + 1]; }
#pragma unroll
        for (int e = 0; e < 4; ++e) { float* go = P_GATES + (size_t)(blk * 16 + 4 * kg + e) * NG; go[r] = d0[e]; if (r < 8) go[16 + r] = d1[e]; } }
}
__device__ __forceinline__ void norm1g_phase(Frame& F, int l) {
    constexpr int WSTR = 2064, WLO = NG * WSTR, AM = 2 * NG * WSTR, AMS = AM + 8192, SSQX = AMS + 16384, DX = SSQX + 1024;
    static_assert(DX + 8192 + 7 * 64 * 32 <= MISC_OFF, "norm1g LDS map");
    LAS unsigned char* lds = F.lds;
    const int c = (int)blockIdx.x, w = F.wave;
    const float* nwp = INP(I_N1W) + l * DM;
    { const f32x2_t* wsrc = (const f32x2_t*)(P_WG + (size_t)l * NG * 1024);
#pragma unroll
      for (int h = 0; h < 2; ++h) { f32x2_t t[12];
#pragma unroll
          for (int i = 0; i < 12; ++i) t[i] = wsrc[F.tid + NTHR * (12 * h + i)];
#pragma unroll
          for (int i = 0; i < 12; ++i) { const int p = F.tid + NTHR * (12 * h + i), g = p >> 9, k2 = p & 511; const unsigned hi2 = pk2(t[i].x, t[i].y);
              *(LAS unsigned*)(lds + g * WSTR + 4 * k2) = hi2; *(LAS unsigned*)(lds + WLO + g * WSTR + 4 * k2) = pk2(t[i].x - lo_bf(hi2), t[i].y - hi_bf(hi2)); } }
      const float* mrow = P_MOD + ((size_t)l * MODROWS + (c >> 5)) * MODLD;
#pragma unroll
      for (int i = 0; i < 2; ++i) { const int k = F.tid + NTHR * i; ((LAS float*)(lds + AM))[k] = nwp[k] * (mrow[1024 + k] + 1.f); ((LAS float*)(lds + AM + 4096))[k] = mrow[k]; }
      if (c < 64) {
#pragma unroll
          for (int i = 0; i < 4; ++i) { const int idx = F.tid + NTHR * i, hb = idx >> 10, k = idx & 1023; const float* ms = P_MOD + ((size_t)l * MODROWS + NB_P + 2 * c + hb) * MODLD;
              ((LAS float*)(lds + AMS))[hb * 1024 + k] = nwp[k] * (ms[1024 + k] + 1.f); ((LAS float*)(lds + AMS + 8192))[hb * 1024 + k] = ms[k]; } } }
    __syncthreads();
    norm1g_block<2>(F, l, true, true, 4 * c + (w & 3), w >> 2, AM, 4096, SSQX + (w & 3) * 128, DX + (w & 3) * 2048);
    if (c < 64) norm1g_block<8>(F, l, true, false, MP / 16 + c, w, AMS + ((F.lane & 15) >> 3) * 4096, 8192, SSQX + 512, DX + 8192);
}
__device__ __forceinline__ void final_norm_phase(Frame& F) {
    const int gw = blockIdx.x * NWAVES + F.wave, NGW = F.G * NWAVES; const float* nw = INP(I_FNW);
    f32x4 nw4[4], xn[4];
#pragma unroll
    for (int j = 0; j < 4; ++j) nw4[j] = *(const f32x4*)(nw + 4 * F.lane + 256 * j);
    auto ld = [&](int row) {
        if (row < MP) { const unsigned long long* xr = (const unsigned long long*)(P_XWB + (size_t)row * DM) + F.lane;
#pragma unroll
            for (int j = 0; j < 4; ++j) { const unsigned long long t = xr[64 * j]; xn[j].x = __uint_as_float((unsigned)t); xn[j].y = __uint_as_float((unsigned)(t >> 32)); } }
        else {
#pragma unroll
            for (int j = 0; j < 4; ++j) xn[j] = *((const f32x4*)(P_XW + (size_t)row * DM) + F.lane + 64 * j); } };
    if (gw < MT) ld(gw);
    for (int row = gw; row < MT; row += NGW) {
        f32x4* o = (f32x4*)(OUTP() + (size_t)row * DM) + F.lane;
        f32x4 v[4]; float s = 0.f;
#pragma unroll
        for (int j = 0; j < 4; ++j) { v[j] = xn[j];
            if (row < MP) { const unsigned lo = __float_as_uint(v[j].x), hi = __float_as_uint(v[j].y); v[j] = (f32x4){lo_bf(lo), hi_bf(lo), lo_bf(hi), hi_bf(hi)}; }
            s += (v[j].x * v[j].x + v[j].y * v[j].y) + (v[j].z * v[j].z + v[j].w * v[j].w); }
        if (row + NGW < MT) ld(row + NGW);
        const float rstd = rsqrtf(wave_sum(s) * (1.f / DM) + EPS);
#pragma unroll
        for (int j = 0; j < 4; ++j) o[64 * j] = v[j] * rstd * nw4[j];
    }
}
__device__ __forceinline__ void yscale_phase(Frame& F, int l) {
    const int gw = blockIdx.x * NWAVES + F.wave, NGW = F.G * NWAVES; const float* nw = INP(I_SNW) + l * 1024;
    for (int row = gw; row < MT; row += NGW) {
        float s = P_SSQ[(size_t)row * 16 + (F.lane & 15)];
        s += __shfl_xor(s, 1); s += __shfl_xor(s, 2); s += __shfl_xor(s, 4); s += __shfl_xor(s, 8);
        const float rs = rsqrtf(s * (1.f / 1024.f) + EPS);
        const f32x4* yr = (const f32x4*)(P_YZ + (size_t)row * 1024) + F.lane; unsigned long long* o8 = (unsigned long long*)(P_YCAT + (size_t)row * MIXW) + F.lane;
#pragma unroll
        for (int j = 0; j < 4; ++j) { const f32x4 w4 = *(const f32x4*)(nw + 4 * F.lane + 256 * j); const f32x4 y = yr[64 * j] * rs * w4;
            o8[64 * j] = (unsigned long long)pk2(y.x, y.y) | ((unsigned long long)pk2(y.z, y.w) << 32); }
    }
}

__device__ __forceinline__ void ssd_item(Frame& F, int l, int grp, int b, int h) {
    const int T = grp ? SEQ_S : SEQ_P, rowbase = grp ? MP + b * SEQ_S : b * SEQ_P, Bn = grp ? NB_S : NB_P, g = h >> 3;
    const int tid = F.tid, p = tid >> 3, nq = tid & 7, n0 = nq * 16;
    LAS float* xs = (LAS float*)F.lds; LAS float* Bm = xs + 512; LAS float* Cm = Bm + 1024; LAS float* dts = Cm + 1024; LAS float* dAs = dts + 8; LAS float* ybuf = dAs + 8;
    float S[16];
    if (grp) { const float* sp = INP(I_SSM) + ((((size_t)l * NB_S + b) * 16 + h) * 64 + p) * 128 + n0;
#pragma unroll
        for (int j = 0; j < 16; ++j) S[j] = sp[j]; }
    else {
#pragma unroll
        for (int j = 0; j < 16; ++j) S[j] = 0.f; }
    const float a = -fexp(INP(I_ALOG)[l * 16 + h]), dtb = INP(I_DTB)[l * 16 + h], Dh = INP(I_SSD_D)[l * 16 + h];
    const float* cw = INP(I_SCW) + (size_t)l * 4 * CONVD; const float* cb = INP(I_SCB) + (size_t)l * CONVD;
    const float* hist = INP(I_SCONV) + ((size_t)l * NB_S + b) * 3 * CONVD;
    for (int t0 = 0; t0 < T; t0 += 8) {
#pragma unroll
        for (int j5 = 0; j5 < 5; ++j5) { const int idx = tid + NTHR * j5, ci = idx % 320, tt = idx / 320, t = t0 + tt;
            const int c = ci < 64 ? h * 64 + ci : (ci < 192 ? 1024 + g * 128 + (ci - 64) : 1280 + g * 128 + (ci - 192));
            float acc = cb[c];
#pragma unroll
            for (int j = 0; j < 4; ++j) { const int tp = t - 3 + j; float val;
                if (tp >= 0) val = bf2f(P_U[(size_t)(rowbase + tp) * NU + UC_XBC + c]); else val = grp ? hist[(tp + 3) * CONVD + c] : 0.f;
                acc += cw[j * CONVD + c] * val; }
            const float act = siluf_(acc);
            if (ci < 64) xs[tt * 64 + ci] = act; else if (ci < 192) Bm[tt * 128 + ci - 64] = act; else Cm[tt * 128 + ci - 192] = act; }
        if (tid < 8) { const float dt = softplusf_(P_GATES[(size_t)(rowbase + t0 + tid) * NG + h] + dtb); dts[tid] = dt; dAs[tid] = fexp(dt * a); }
        __syncthreads();
        for (int tt = 0; tt < 8; ++tt) {
            const float dt = dts[tt], dA = dAs[tt], xv = xs[tt * 64 + p], dx = dt * xv; float part = 0.f;
#pragma unroll
            for (int j = 0; j < 16; ++j) { S[j] = dA * S[j] + dx * Bm[tt * 128 + n0 + j]; part += Cm[tt * 128 + n0 + j] * S[j]; }
            part += __shfl_xor(part, 1); part += __shfl_xor(part, 2); part += __shfl_xor(part, 4);
            if (nq == 0) { const size_t row = (size_t)(rowbase + t0 + tt); const float y = part + Dh * xv, z = bf2f(P_U[row * NU + UC_Z + h * 64 + p]), yz = y * siluf_(z);
                P_YZ[row * 1024 + h * 64 + p] = yz; ybuf[tt * 64 + p] = yz; }
        }
        __syncthreads();
        if (tid < 8) { float s = 0.f; for (int q = 0; q < 64; ++q) { const float y = ybuf[tid * 64 + q]; s += y * y; } P_SSQ[(size_t)(rowbase + t0 + tid) * 16 + h] = s; }
    }
    { float* so = OUTP() + (grp ? O_S_SSM : O_P_SSM) + ((((size_t)l * Bn + b) * 16 + h) * 64 + p) * 128 + n0;
#pragma unroll
      for (int j = 0; j < 16; ++j) so[j] = S[j]; }
    if (h == 0) { float* co = OUTP() + (grp ? O_S_SCONV : O_P_SCONV) + ((size_t)l * Bn + b) * 3 * CONVD;
        for (int idx = tid; idx < 3 * CONVD; idx += NTHR) { const int j = idx / CONVD, c = idx % CONVD; co[idx] = bf2f(P_U[(size_t)(rowbase + T - 3 + j) * NU + UC_XBC + c]); } }
    __syncthreads();
}
__device__ __forceinline__ void mlstm_item(Frame& F, int l, int grp, int b, int h) {
    const int T = grp ? SEQ_S : SEQ_P, rowbase = grp ? MP + b * SEQ_S : b * SEQ_P, Bn = grp ? NB_S : NB_P;
    const int tid = F.tid, v = tid >> 2, dq = tid & 3, d0 = dq * 32;
    LAS float* q = (LAS float*)F.lds; LAS float* k = q + 1024; LAS float* vv = k + 1024; LAS float* oo = vv + 1024; LAS float* igs = oo + 1024; LAS float* lfs = igs + 8; LAS float* hbuf = lfs + 8;
    float c[32], nn[32], m;
    if (grp) { const float* cp = INP(I_MC) + ((((size_t)l * NB_S + b) * 4 + h) * 128 + v) * 128 + d0; const float* np = INP(I_MN) + (((size_t)l * NB_S + b) * 4 + h) * 128 + d0;
#pragma unroll
        for (int j = 0; j < 32; ++j) { c[j] = cp[j]; nn[j] = np[j]; }
        m = INP(I_MM)[((size_t)l * NB_S + b) * 4 + h]; }
    else {
#pragma unroll
        for (int j = 0; j < 32; ++j) { c[j] = 0.f; nn[j] = 0.f; }
        m = 0.f; }
    const float ib = INP(I_MIB)[l * 4 + h], fb = INP(I_MFB)[l * 4 + h];
    const float* nw = INP(I_MNW) + l * 512 + h * 128;
    for (int t0 = 0; t0 < T; t0 += 8) {
#pragma unroll
        for (int j8 = 0; j8 < 8; ++j8) { const int idx = tid + NTHR * j8, arr = idx >> 10, tt = (idx >> 7) & 7, d = idx & 127;
            float val = bf2f(P_U[(size_t)(rowbase + t0 + tt) * NU + UC_Q + arr * 512 + h * 128 + d]); if (arr == 1) val *= 0.08838834764831845f;
            q[idx] = val; }
        if (tid < 8) { const size_t row = (size_t)(rowbase + t0 + tid); igs[tid] = P_GATES[row * NG + 16 + h] + ib; lfs[tid] = -softplusf_(-(P_GATES[row * NG + 20 + h] + fb)); }
        __syncthreads();
        for (int tt = 0; tt < 8; ++tt) {
            const float igv = igs[tt], lfv = lfs[tt], mn = fmaxf(lfv + m, igv), al = fexp(lfv + m - mn), be = fexp(igv - mn); m = mn;
            const float bv = be * vv[tt * 128 + v]; float pn = 0.f, pd = 0.f;
#pragma unroll
            for (int j = 0; j < 32; ++j) { const float kj = k[tt * 128 + d0 + j], qj = q[tt * 128 + d0 + j]; c[j] = al * c[j] + bv * kj; nn[j] = al * nn[j] + be * kj; pn += c[j] * qj; pd += nn[j] * qj; }
            pn += __shfl_xor(pn, 1); pn += __shfl_xor(pn, 2); pd += __shfl_xor(pd, 1); pd += __shfl_xor(pd, 2);
            if (dq == 0) hbuf[tt * 128 + v] = pn / fmaxf(fabsf(pd), fexp(-m));
        }
        __syncthreads();
        { const int tt = F.wave; const size_t row = (size_t)(rowbase + t0 + tt); const float h0 = hbuf[tt * 128 + F.lane], h1 = hbuf[tt * 128 + 64 + F.lane];
          const float rstd = rsqrtf(wave_sum(h0 * h0 + h1 * h1) * (1.f / 128.f) + EPS);
          bf16* yo = P_YCAT + row * MIXW + 1024 + h * 128;
          yo[F.lane] = (bf16)f2bf(h0 * rstd * nw[F.lane] * sigmoidf_(oo[tt * 128 + F.lane])); yo[64 + F.lane] = (bf16)f2bf(h1 * rstd * nw[64 + F.lane] * sigmoidf_(oo[tt * 128 + 64 + F.lane])); }
        __syncthreads();
    }
    { float* co = OUTP() + (grp ? O_S_MC : O_P_MC) + ((((size_t)l * Bn + b) * 4 + h) * 128 + v) * 128 + d0;
#pragma unroll
      for (int j = 0; j < 32; ++j) co[j] = c[j];
      if (v == 0) { float* no = OUTP() + (grp ? O_S_MN : O_P_MN) + (((size_t)l * Bn + b) * 4 + h) * 128 + d0;
#pragma unroll
          for (int j = 0; j < 32; ++j) no[j] = nn[j]; }
      if (tid == 0) OUTP()[(grp ? O_S_MM : O_P_MM) + ((size_t)l * Bn + b) * 4 + h] = m; }
    __syncthreads();
}
__device__ __forceinline__ void lru_item(Frame& F, int l, int grp, int b, int kb) {
    const int T = grp ? SEQ_S : SEQ_P, rowbase = grp ? MP + b * SEQ_S : b * SEQ_P, Bn = grp ? NB_S : NB_P;
    const int tid = F.tid, d = tid & 127, tg = tid >> 7, ch = kb * 128 + d;
    LAS float* xc = (LAS float*)F.lds; LAS float* as = xc + 1024; LAS float* bs = as + 1024;
    float hreg = grp ? INP(I_LH)[((size_t)l * NB_S + b) * LRUW + ch] : 0.f;
    const float spl = softplusf_(-INP(I_LLAM)[l * LRUW + ch]), cb = INP(I_LCB)[l * LRUW + ch], ba = INP(I_LBA)[l * LRUW + ch], bx = INP(I_LBX)[l * LRUW + ch];
    float cw[4];
#pragma unroll
    for (int j = 0; j < 4; ++j) cw[j] = INP(I_LCW)[((size_t)l * 4 + j) * LRUW + ch];
    const float* hist = INP(I_LCONV) + ((size_t)l * NB_S + b) * 3 * LRUW;
    const float* wa = INP(I_LWA) + ((size_t)l * 4 + kb) * 128 * 128 + d; const float* wx = INP(I_LWX) + ((size_t)l * 4 + kb) * 128 * 128 + d;
    for (int t0 = 0; t0 < T; t0 += 8) {
#pragma unroll
        for (int e = 0; e < 2; ++e) { const int tt = tg * 2 + e, t = t0 + tt; float acc = cb;
#pragma unroll
            for (int j = 0; j < 4; ++j) { const int tp = t - 3 + j; float val;
                if (tp >= 0) val = bf2f(P_U[(size_t)(rowbase + tp) * NU + UC_XR + ch]); else val = grp ? hist[(tp + 3) * LRUW + ch] : 0.f;
                acc += cw[j] * val; }
            xc[tt * 128 + d] = acc; }
        __syncthreads();
        float ra0 = ba, ra1 = ba, ri0 = bx, ri1 = bx;
#pragma unroll 4
        for (int cc = 0; cc < 128; ++cc) { const float a_ = wa[cc * 128], x_ = wx[cc * 128], x0 = xc[(tg * 2) * 128 + cc], x1 = xc[(tg * 2 + 1) * 128 + cc];
            ra0 += x0 * a_; ra1 += x1 * a_; ri0 += x0 * x_; ri1 += x1 * x_; }
#pragma unroll
        for (int e = 0; e < 2; ++e) { const int tt = tg * 2 + e; const float r = sigmoidf_(e ? ra1 : ra0), ii = sigmoidf_(e ? ri1 : ri0), la = -8.f * r * spl;
            float mult = sqrtf(-expm1f(2.f * la)); if (!grp && t0 + tt == 0) mult = 1.f;
            as[tt * 128 + d] = fexp(la); bs[tt * 128 + d] = mult * ii * xc[tt * 128 + d]; }
        __syncthreads();
        if (tid < 128) {
            for (int tt = 0; tt < 8; ++tt) { hreg = as[tt * 128 + d] * hreg + bs[tt * 128 + d]; const size_t row = (size_t)(rowbase + t0 + tt);
                P_YCAT[row * MIXW + 1536 + ch] = (bf16)f2bf(hreg * gelu_tanhf_(bf2f(P_U[row * NU + UC_GR + ch]))); } }
    }
    if (tid < 128) OUTP()[(grp ? O_S_LH : O_P_LH) + ((size_t)l * Bn + b) * LRUW + ch] = hreg;
    { float* co = OUTP() + (grp ? O_S_LCONV : O_P_LCONV) + ((size_t)l * Bn + b) * 3 * LRUW;
      for (int idx = tid; idx < 3 * 128; idx += NTHR) { const int j = idx / 128, dd = idx % 128; co[j * LRUW + kb * 128 + dd] = bf2f(P_U[(size_t)(rowbase + T - 3 + j) * NU + UC_XR + kb * 128 + dd]); } }
    __syncthreads();
}

__device__ __forceinline__ int crow32(int r, int hi) { return (r & 3) + 8 * (r >> 2) + 4 * hi; }
__device__ __forceinline__ bf16x8 frag16(LAS const unsigned char* base, int stride, int r0, int kk, int lane) { return *(const LAS bf16x8*)(base + (r0 + (lane & 15)) * stride + kk * 64 + (lane >> 4) * 16); }
__device__ __forceinline__ bf16x8 frag32(LAS const unsigned char* base, int stride, int r0, int kk, int lane) { return *(const LAS bf16x8*)(base + (r0 + (lane & 31)) * stride + kk * 32 + (lane >> 5) * 16); }

typedef __amdgpu_buffer_rsrc_t rsrc_t;
__device__ __forceinline__ rsrc_t mk_rsrc(const void* p, unsigned bytes) { return __builtin_amdgcn_make_buffer_rsrc((void*)p, (short)0, (int)bytes, 0x00020000); }
#define U_RSRC() mk_rsrc((const unsigned char*)P_U - 3 * NU * 2, (unsigned)((MT + 3) * (size_t)NU * 2))
constexpr int ROWB = NU * 2;

__device__ __forceinline__ void ssd_prompt_item(Frame& F, int l, int b, int h) {
    constexpr int L = 64, NCH = SEQ_P / L;
    constexpr int CS = 0, BS = 17408, BST = 34816, XST = 53248, MS = 62464, SBF = 71680, GT = 89088, SSQP = GT + NCH * 1024, ZS = SSQP + 512;
    const int tid = F.tid, lane = F.lane, w = F.wave, g = h >> 3, rowbase = b * SEQ_P;
    LAS unsigned char* lds = F.lds;
    const bf16* U = P_U; const float* gates = P_GATES; float* SSQ = P_SSQ;
    const float a = -fexp(INP(I_ALOG)[l * 16 + h]), dtb = INP(I_DTB)[l * 16 + h], Dh = INP(I_SSD_D)[l * 16 + h];
    const int px = tid & 31, gx = tid >> 5, pb = tid & 63, gb = tid >> 6;
    const int colx = UC_XBC + h * 64 + 2 * px;
    float cwx[4][2], cbx[2];
    { const float* cw = INP(I_SCW) + (size_t)l * 4 * CONVD; const float* cb = INP(I_SCB) + (size_t)l * CONVD;
#pragma unroll
      for (int j = 0; j < 4; ++j)
#pragma unroll
          for (int e = 0; e < 2; ++e) cwx[j][e] = cw[j * CONVD + colx - UC_XBC + e];
#pragma unroll
      for (int e = 0; e < 2; ++e) cbx[e] = cb[colx - UC_XBC + e]; }
    struct Pre { unsigned rx[7], rb[8], rc[8]; v4u rz; };
    Pre PA, PB;
    const rsrc_t ru = U_RSRC(); const rsrc_t ryz = mk_rsrc(P_YCAT, (unsigned)((size_t)MT * MIXW * 2)); const rsrc_t rbca = mk_rsrc(P_BCA, (unsigned)((size_t)MP * 512 * 2));
    const int voffbc = (8 * gb * 512 + g * 128 + 2 * pb) * 2;
    const int voffx = (4 * gx * NU + colx) * 2, voffzt = (((tid >> 3) + 3) * NU + UC_Z + h * 64 + 8 * (tid & 7)) * 2;
    auto prefetch = [&](int c, Pre& P) {
        const int sb = (rowbase + c * L) * ROWB;
#pragma unroll
        for (int i = 0; i < 7; ++i) { P.rx[i] = __builtin_amdgcn_raw_buffer_load_b32(ru, voffx, sb + i * ROWB, 0); if (c == 0 && 4 * gx + i < 3) P.rx[i] = 0u; }
#pragma unroll
        for (int i = 0; i < 8; ++i) { P.rb[i] = __builtin_amdgcn_raw_buffer_load_b32(rbca, voffbc, (rowbase + c * L + i) * 1024, 0); P.rc[i] = __builtin_amdgcn_raw_buffer_load_b32(rbca, voffbc + 512, (rowbase + c * L + i) * 1024, 0); }
        P.rz = __builtin_amdgcn_raw_buffer_load_b128(ru, voffzt, sb, 0);
    };
    for (int c = w; c < NCH; c += NWAVES) {
        LAS float* gtw = (LAS float*)(lds + GT) + c * 256;
        const float dt = softplusf_(gates[(size_t)(rowbase + c * L + lane) * NG + h] + dtb); float x = dt * a;
#pragma unroll
        for (int o = 1; o < 64; o <<= 1) { const float y = __shfl_up(x, o); if (lane >= o) x += y; }
        const float cl = __shfl(x, 63);
        gtw[lane] = x; gtw[64 + lane] = dt; gtw[128 + lane] = fexp(cl - x) * dt; gtw[192 + lane] = fexp(x);
    }
    f32x16 S; for (int r = 0; r < 16; ++r) S[r] = 0.f;
    for (int i = tid; i < 17408 / 4; i += NTHR) ((LAS unsigned*)(lds + SBF))[i] = 0u;
    prefetch(0, PA); prefetch(1, PB);
    LBAR();
    const int ti = w >> 1, pj0 = 2 * (w & 1), pi = w >> 2, ni = w & 3, q4 = lane >> 4, c16 = lane & 15;
    const int voffz = ((ti * 16 + 4 * q4 + 3) * NU + UC_Z + h * 64 + pj0 * 16 + c16) * 2, voffy = ((ti * 16 + 4 * q4) * MIXW + h * 64 + pj0 * 16 + c16) * 2;
    const float nw0 = INP(I_SNW)[l * 1024 + h * 64 + pj0 * 16 + c16], nw1 = INP(I_SNW)[l * 1024 + h * 64 + (pj0 + 1) * 16 + c16];
    auto step = [&](int c, Pre& P) {
        const int t0 = c * L; const LAS float* gt = (const LAS float*)(lds + GT) + c * 256;
        { float o0[4], o1[4];
#pragma unroll
          for (int i = 0; i < 4; ++i) { float a0 = cbx[0], a1 = cbx[1];
#pragma unroll
              for (int j = 0; j < 4; ++j) { a0 += cwx[j][0] * lo_bf(P.rx[i + j]); a1 += cwx[j][1] * hi_bf(P.rx[i + j]); }
              o0[i] = siluf_(a0); o1[i] = siluf_(a1); }
          *(LAS v2u*)(lds + XST + (2 * px) * 144 + 8 * gx) = (v2u){pk2(o0[0], o0[1]), pk2(o0[2], o0[3])};
          *(LAS v2u*)(lds + XST + (2 * px + 1) * 144 + 8 * gx) = (v2u){pk2(o1[0], o1[1]), pk2(o1[2], o1[3])}; }
        { float o0[8], o1[8];
#pragma unroll
          for (int i = 0; i < 8; ++i) { *(LAS unsigned*)(lds + BS + (8 * gb + i) * 272 + 4 * pb) = P.rb[i]; *(LAS unsigned*)(lds + CS + (8 * gb + i) * 272 + 4 * pb) = P.rc[i];
              const float ws = gt[128 + 8 * gb + i]; o0[i] = lo_bf(P.rb[i]) * ws; o1[i] = hi_bf(P.rb[i]) * ws; }
          *(LAS v4u*)(lds + BST + (2 * pb) * 144 + 16 * gb) = (v4u){pk2(o0[0], o0[1]), pk2(o0[2], o0[3]), pk2(o0[4], o0[5]), pk2(o0[6], o0[7])};
          *(LAS v4u*)(lds + BST + (2 * pb + 1) * 144 + 16 * gb) = (v4u){pk2(o1[0], o1[1]), pk2(o1[2], o1[3]), pk2(o1[4], o1[5]), pk2(o1[6], o1[7])}; }
        *(LAS v4u*)(lds + ZS + (tid >> 3) * 144 + (tid & 7) * 16) = P.rz;
        if (c + 2 < NCH) prefetch(c + 2, P);
        LBAR();
        { f32x4 ga[2] = {{0.f, 0.f, 0.f, 0.f}, {0.f, 0.f, 0.f, 0.f}};
#pragma unroll
          for (int kk = 0; kk < 4; ++kk) { const bf16x8 af = frag16(lds + CS, 272, ti * 16, kk, lane);
#pragma unroll
              for (int jj = 0; jj < 2; ++jj) { const bf16x8 bfr = frag16(lds + BS, 272, (pj0 + jj) * 16, kk, lane); ga[jj] = __builtin_amdgcn_mfma_f32_16x16x32_bf16(af, bfr, ga[jj], 0, 0, 0); } }
          float ct[4];
#pragma unroll
          for (int r = 0; r < 4; ++r) ct[r] = gt[ti * 16 + 4 * q4 + r];
#pragma unroll
          for (int jj = 0; jj < 2; ++jj) { const int s = (pj0 + jj) * 16 + c16; const float cs = gt[s], ds = gt[64 + s];
#pragma unroll
              for (int r = 0; r < 4; ++r) { const int t = ti * 16 + 4 * q4 + r; const float v = s <= t ? ga[jj][r] * fexp(ct[r] - cs) * ds : 0.f;
                  *(LAS bf16*)(lds + MS + t * 144 + s * 2) = (bf16)f2bf(v); } } }
        LBAR();
        { f32x4 ya[2] = {{0.f, 0.f, 0.f, 0.f}, {0.f, 0.f, 0.f, 0.f}};
#pragma unroll
          for (int kk = 0; kk < 4; ++kk) { const bf16x8 af = frag16(lds + CS, 272, ti * 16, kk, lane);
#pragma unroll
              for (int jj = 0; jj < 2; ++jj) { const bf16x8 bfr = frag16(lds + SBF, 272, (pj0 + jj) * 16, kk, lane); ya[jj] = __builtin_amdgcn_mfma_f32_16x16x32_bf16(af, bfr, ya[jj], 0, 0, 0); } }
#pragma unroll
          for (int r = 0; r < 4; ++r) { const float e = gt[192 + ti * 16 + 4 * q4 + r]; ya[0][r] *= e; ya[1][r] *= e; }
#pragma unroll
          for (int kk = 0; kk < 2; ++kk) { const bf16x8 af = frag16(lds + MS, 144, ti * 16, kk, lane);
#pragma unroll
              for (int jj = 0; jj < 2; ++jj) { const bf16x8 bfr = frag16(lds + XST, 144, (pj0 + jj) * 16, kk, lane); ya[jj] = __builtin_amdgcn_mfma_f32_16x16x32_bf16(af, bfr, ya[jj], 0, 0, 0); } }
          float sq[4] = {0.f, 0.f, 0.f, 0.f};
#pragma unroll
          for (int jj = 0; jj < 2; ++jj) { const int p = (pj0 + jj) * 16 + c16; const v2u xv = *(const LAS v2u*)(lds + XST + p * 144 + (ti * 16 + 4 * q4) * 2);
              const float xs4[4] = {lo_bf(xv.x), hi_bf(xv.x), lo_bf(xv.y), hi_bf(xv.y)};
#pragma unroll
              for (int r = 0; r < 4; ++r) { const float y = ya[jj][r] + Dh * xs4[r], yz = y * siluf_(bf2f(*(const LAS bf16*)(lds + ZS + (ti * 16 + 4 * q4 + r) * 144 + p * 2)));
                  __builtin_amdgcn_raw_buffer_store_b16((bf16)f2bf(yz * (jj ? nw1 : nw0)), ryz, voffy + jj * 32, (rowbase + t0 + r) * (MIXW * 2), 0); sq[r] += yz * yz; } }
#pragma unroll
          for (int r = 0; r < 4; ++r) { float v = row16_sum(sq[r]);
              if (c16 == 0) ((LAS float*)(lds + SSQP))[(w & 1) * 64 + ti * 16 + 4 * q4 + r] = v; } }
        { const float dal = gt[192 + 63];
#pragma unroll
          for (int r = 0; r < 16; ++r) S[r] *= dal;
#pragma unroll
          for (int kk = 0; kk < 4; ++kk) { const bf16x8 af = frag32(lds + XST, 144, pi * 32, kk, lane); const bf16x8 bfr = frag32(lds + BST, 144, ni * 32, kk, lane);
              S = __builtin_amdgcn_mfma_f32_32x32x16_bf16(af, bfr, S, 0, 0, 0); } }
        LBAR();
#pragma unroll
        for (int r = 0; r < 16; ++r) *(LAS bf16*)(lds + SBF + (pi * 32 + crow32(r, lane >> 5)) * 272 + (ni * 32 + (lane & 31)) * 2) = (bf16)f2bf(S[r]);
        if (tid < 64) SSQ[(size_t)(rowbase + t0 + tid) * 16 + h] = ((LAS float*)(lds + SSQP))[tid] + ((LAS float*)(lds + SSQP))[64 + tid];
        };
    for (int c2 = 0; c2 < NCH; c2 += 2) { step(c2, PA); step(c2 + 1, PB); }
    { float* so = OUTP() + O_P_SSM + (((size_t)l * NB_P + b) * 16 + h) * 8192;
#pragma unroll
      for (int r = 0; r < 16; ++r) so[(pi * 32 + crow32(r, lane >> 5)) * 128 + ni * 32 + (lane & 31)] = S[r]; }
    if (h == 0) { float* co = OUTP() + O_P_SCONV + ((size_t)l * NB_P + b) * 3 * CONVD;
        for (int idx = tid; idx < 3 * CONVD; idx += NTHR) { const int j = idx / CONVD, cc = idx % CONVD; co[idx] = bf2f(U[(size_t)(rowbase + SEQ_P - 3 + j) * NU + UC_XBC + cc]); } }
    LBAR();
}

__device__ __forceinline__ void bca_prepass(Frame& F, int l) {
    const rsrc_t ru = U_RSRC(); v4u* bca = (v4u*)P_BCA;
    const float* cw = INP(I_SCW) + (size_t)l * 4 * CONVD + 1024; const float* cb = INP(I_SCB) + (size_t)l * CONVD + 1024;
    for (int unit = blockIdx.x * NTHR + F.tid; unit < (MP / 8) * 64; unit += F.G * NTHR) {
        const int rg = unit >> 6, ch = unit & 63, row0 = rg * 8; const bool head = (row0 & (SEQ_P - 1)) == 0;
        v4u r[11];
#pragma unroll
        for (int i = 0; i < 11; ++i) { r[i] = __builtin_amdgcn_raw_buffer_load_b128(ru, (UC_XBC + 1024 + 8 * ch) * 2, (row0 + i) * ROWB, 0); if (head && i < 3) r[i] = (v4u){0u, 0u, 0u, 0u}; }
        v4u o[8];
#pragma unroll
        for (int e2 = 0; e2 < 4; ++e2) { float w0[4], w1[4];
#pragma unroll
            for (int j = 0; j < 4; ++j) { w0[j] = cw[j * CONVD + 8 * ch + 2 * e2]; w1[j] = cw[j * CONVD + 8 * ch + 2 * e2 + 1]; }
            const float b0 = cb[8 * ch + 2 * e2], b1 = cb[8 * ch + 2 * e2 + 1];
#pragma unroll
            for (int i = 0; i < 8; ++i) { float a0 = b0, a1 = b1;
#pragma unroll
                for (int j = 0; j < 4; ++j) { const unsigned u = r[i + j][e2]; a0 += w0[j] * lo_bf(u); a1 += w1[j] * hi_bf(u); }
                o[i][e2] = pk2(siluf_(a0), siluf_(a1)); } }
#pragma unroll
        for (int i = 0; i < 8; ++i) bca[(size_t)(row0 + i) * 64 + ch] = o[i];
    }
}

__device__ __forceinline__ bf16* ssd_sin_ptr(int b, int h, int c) { bf16* base = b < 4 ? (bf16*)WSP(WS_YZ + 34 * MiB) : (bf16*)WSP(WS_HN); return base + ((size_t)((b & 3) * 16 + h) * 32 + c) * 8192; }
__device__ __forceinline__ void ssd_passA(Frame& F, int l, int b, int h) {
    constexpr int L = 64, NCH = SEQ_P / L;
    constexpr int BST = 0, XST = 18432, GT = 27648;
    const int tid = F.tid, lane = F.lane, w = F.wave, g = h >> 3, rowbase = b * SEQ_P;
    LAS unsigned char* lds = F.lds;
    const bf16* U = P_U; const float* gates = P_GATES;
    const float a = -fexp(INP(I_ALOG)[l * 16 + h]), dtb = INP(I_DTB)[l * 16 + h];
    const int px = tid & 31, gx = tid >> 5, pb = tid & 63, gb = tid >> 6;
    const int colx = UC_XBC + h * 64 + 2 * px, colb = UC_XBC + 1024 + g * 128 + 2 * pb;
    float cwx[4][2], cwb[4][2], cbx[2], cbb[2];
    { const float* cw = INP(I_SCW) + (size_t)l * 4 * CONVD; const float* cb = INP(I_SCB) + (size_t)l * CONVD;
#pragma unroll
      for (int j = 0; j < 4; ++j)
#pragma unroll
          for (int e = 0; e < 2; ++e) { cwx[j][e] = cw[j * CONVD + colx - UC_XBC + e]; cwb[j][e] = cw[j * CONVD + colb - UC_XBC + e]; }
#pragma unroll
      for (int e = 0; e < 2; ++e) { cbx[e] = cb[colx - UC_XBC + e]; cbb[e] = cb[colb - UC_XBC + e]; } }
    unsigned rx[7], rb[11];
    const rsrc_t ru = U_RSRC();
    const int voffx = (4 * gx * NU + colx) * 2, voffb = (8 * gb * NU + colb) * 2;
    auto prefetch = [&](int c) {
        const int sb = (rowbase + c * L) * ROWB;
#pragma unroll
        for (int i = 0; i < 7; ++i) { rx[i] = __builtin_amdgcn_raw_buffer_load_b32(ru, voffx, sb + i * ROWB, 0); if (c == 0 && 4 * gx + i < 3) rx[i] = 0u; }
#pragma unroll
        for (int i = 0; i < 11; ++i) { rb[i] = __builtin_amdgcn_raw_buffer_load_b32(ru, voffb, sb + i * ROWB, 0); if (c == 0 && 8 * gb + i < 3) rb[i] = 0u; }
    };
    for (int c = w; c < NCH; c += NWAVES) {
        LAS float* gtw = (LAS float*)(lds + GT) + c * 128;
        const float dt = softplusf_(gates[(size_t)(rowbase + c * L + lane) * NG + h] + dtb); float x = dt * a;
#pragma unroll
        for (int o = 1; o < 64; o <<= 1) { const float y = __shfl_up(x, o); if (lane >= o) x += y; }
        const float cl = __shfl(x, 63);
        gtw[lane] = fexp(cl - x) * dt; if (lane == 63) gtw[64] = fexp(x);
    }
    f32x16 S; for (int r = 0; r < 16; ++r) S[r] = 0.f;
    prefetch(0);
    __syncthreads();
    const int pi = w >> 2, ni = w & 3;
    for (int c = 0; c < NCH; ++c) {
        const LAS float* gt = (const LAS float*)(lds + GT) + c * 128;
        { bf16* so = ssd_sin_ptr(b, h, c);
#pragma unroll
          for (int r = 0; r < 16; ++r) so[(pi * 32 + crow32(r, lane >> 5)) * 128 + ni * 32 + (lane & 31)] = (bf16)f2bf(S[r]); }
        { float o0[4], o1[4];
#pragma unroll
          for (int i = 0; i < 4; ++i) { float a0 = cbx[0], a1 = cbx[1];
#pragma unroll
              for (int j = 0; j < 4; ++j) { a0 += cwx[j][0] * lo_bf(rx[i + j]); a1 += cwx[j][1] * hi_bf(rx[i + j]); }
              o0[i] = siluf_(a0); o1[i] = siluf_(a1); }
          *(LAS v2u*)(lds + XST + (2 * px) * 144 + 8 * gx) = (v2u){pk2(o0[0], o0[1]), pk2(o0[2], o0[3])};
          *(LAS v2u*)(lds + XST + (2 * px + 1) * 144 + 8 * gx) = (v2u){pk2(o1[0], o1[1]), pk2(o1[2], o1[3])}; }
        { float o0[8], o1[8];
#pragma unroll
          for (int i = 0; i < 8; ++i) { float a0 = cbb[0], a1 = cbb[1];
#pragma unroll
              for (int j = 0; j < 4; ++j) { a0 += cwb[j][0] * lo_bf(rb[i + j]); a1 += cwb[j][1] * hi_bf(rb[i + j]); }
              const float ws = gt[8 * gb + i]; o0[i] = siluf_(a0) * ws; o1[i] = siluf_(a1) * ws; }
          *(LAS v4u*)(lds + BST + (2 * pb) * 144 + 16 * gb) = (v4u){pk2(o0[0], o0[1]), pk2(o0[2], o0[3]), pk2(o0[4], o0[5]), pk2(o0[6], o0[7])};
          *(LAS v4u*)(lds + BST + (2 * pb + 1) * 144 + 16 * gb) = (v4u){pk2(o1[0], o1[1]), pk2(o1[2], o1[3]), pk2(o1[4], o1[5]), pk2(o1[6], o1[7])}; }
        if (c + 1 < NCH) prefetch(c + 1);
        LBAR();
        { const float dal = gt[64];
#pragma unroll
          for (int r = 0; r < 16; ++r) S[r] *= dal;
#pragma unroll
          for (int kk = 0; kk < 4; ++kk) { const bf16x8 af = frag32(lds + XST, 144, pi * 32, kk, lane); const bf16x8 bfr = frag32(lds + BST, 144, ni * 32, kk, lane);
              S = __builtin_amdgcn_mfma_f32_32x32x16_bf16(af, bfr, S, 0, 0, 0); } }
        LBAR();
    }
    { float* so = OUTP() + O_P_SSM + (((size_t)l * NB_P + b) * 16 + h) * 8192;
#pragma unroll
      for (int r = 0; r < 16; ++r) so[(pi * 32 + crow32(r, lane >> 5)) * 128 + ni * 32 + (lane & 31)] = S[r]; }
    if (h == 0) { float* co = OUTP() + O_P_SCONV + ((size_t)l * NB_P + b) * 3 * CONVD;
        for (int idx = tid; idx < 3 * CONVD; idx += NTHR) { const int j = idx / CONVD, cc = idx % CONVD; co[idx] = bf2f(U[(size_t)(rowbase + SEQ_P - 3 + j) * NU + UC_XBC + cc]); } }
    __syncthreads();
}

__device__ __forceinline__ void ssd_passB(Frame& F, int l, int b, int c, int g) {
    constexpr int L = 64;
    constexpr int CS = 0, BS = 17408, GS = 34816, XST = 44032, GT = 117760;
    const int tid = F.tid, lane = F.lane, w = F.wave, rowbase = b * SEQ_P, t0 = c * L, h = g * 8 + w;
    LAS unsigned char* lds = F.lds;
    const float* gates = P_GATES;
    const rsrc_t ru = U_RSRC(); const rsrc_t ryc = mk_rsrc(P_YCAT, (unsigned)((size_t)MT * MIXW * 2));
    const float* cw = INP(I_SCW) + (size_t)l * 4 * CONVD; const float* cb = INP(I_SCB) + (size_t)l * CONVD;
    const int sb = (rowbase + t0) * ROWB;
    { LAS float* gtw = (LAS float*)(lds + GT) + w * 192;
      const float dt = softplusf_(gates[(size_t)(rowbase + t0 + lane) * NG + h] + INP(I_DTB)[l * 16 + h]); float x = -dt * fexp(INP(I_ALOG)[l * 16 + h]);
#pragma unroll
      for (int o = 1; o < 64; o <<= 1) { const float y = __shfl_up(x, o); if (lane >= o) x += y; }
      gtw[lane] = x; gtw[64 + lane] = dt; gtw[128 + lane] = fexp(x); }
    { const int pb = tid & 63, gb = tid >> 6, colb = UC_XBC + 1024 + g * 128 + 2 * pb, voffb = (8 * gb * NU + colb) * 2;
      unsigned rb[11], rc[11];
#pragma unroll
      for (int i = 0; i < 11; ++i) { rb[i] = __builtin_amdgcn_raw_buffer_load_b32(ru, voffb, sb + i * ROWB, 0); rc[i] = __builtin_amdgcn_raw_buffer_load_b32(ru, voffb + 512, sb + i * ROWB, 0);
          if (c == 0 && 8 * gb + i < 3) { rb[i] = 0u; rc[i] = 0u; } }
      float wb[4][2], wc[4][2], bb[2], bc[2];
#pragma unroll
      for (int e = 0; e < 2; ++e) { bb[e] = cb[colb - UC_XBC + e]; bc[e] = cb[colb + 256 - UC_XBC + e];
#pragma unroll
          for (int j = 0; j < 4; ++j) { wb[j][e] = cw[j * CONVD + colb - UC_XBC + e]; wc[j][e] = cw[j * CONVD + colb + 256 - UC_XBC + e]; } }
#pragma unroll
      for (int i = 0; i < 8; ++i) { float a0 = bb[0], a1 = bb[1], c0 = bc[0], c1 = bc[1];
#pragma unroll
          for (int j = 0; j < 4; ++j) { a0 += wb[j][0] * lo_bf(rb[i + j]); a1 += wb[j][1] * hi_bf(rb[i + j]); c0 += wc[j][0] * lo_bf(rc[i + j]); c1 += wc[j][1] * hi_bf(rc[i + j]); }
          *(LAS unsigned*)(lds + BS + (8 * gb + i) * 272 + 4 * pb) = pk2(siluf_(a0), siluf_(a1)); *(LAS unsigned*)(lds + CS + (8 * gb + i) * 272 + 4 * pb) = pk2(siluf_(c0), siluf_(c1)); } }
    { const int cx = tid & 63, gx8 = tid >> 6, colx = UC_XBC + g * 512 + 8 * cx, hh = cx >> 3, p0 = 8 * (cx & 7);
      v4u rx[11];
#pragma unroll
      for (int i = 0; i < 11; ++i) { rx[i] = __builtin_amdgcn_raw_buffer_load_b128(ru, (8 * gx8 * NU + colx) * 2, sb + i * ROWB, 0); if (c == 0 && 8 * gx8 + i < 3) rx[i] = (v4u){0u, 0u, 0u, 0u}; }
#pragma unroll
      for (int e2 = 0; e2 < 4; ++e2) {
          float w0[4], w1[4];
#pragma unroll
          for (int j = 0; j < 4; ++j) { w0[j] = cw[j * CONVD + colx - UC_XBC + 2 * e2]; w1[j] = cw[j * CONVD + colx - UC_XBC + 2 * e2 + 1]; }
          const float b0 = cb[colx - UC_XBC + 2 * e2], b1 = cb[colx - UC_XBC + 2 * e2 + 1];
          float o0[8], o1[8];
#pragma unroll
          for (int i = 0; i < 8; ++i) { float a0 = b0, a1 = b1;
#pragma unroll
              for (int j = 0; j < 4; ++j) { const unsigned u = rx[i + j][e2]; a0 += w0[j] * lo_bf(u); a1 += w1[j] * hi_bf(u); }
              o0[i] = siluf_(a0); o1[i] = siluf_(a1); }
          *(LAS v4u*)(lds + XST + hh * 9216 + (p0 + 2 * e2) * 144 + ((gx8 ^ (cx & 7)) << 4)) = (v4u){pk2(o0[0], o0[1]), pk2(o0[2], o0[3]), pk2(o0[4], o0[5]), pk2(o0[6], o0[7])};
          *(LAS v4u*)(lds + XST + hh * 9216 + (p0 + 2 * e2 + 1) * 144 + ((gx8 ^ (cx & 7)) << 4)) = (v4u){pk2(o1[0], o1[1]), pk2(o1[2], o1[3]), pk2(o1[4], o1[5]), pk2(o1[6], o1[7])}; } }
    const int q4 = lane >> 4, c16 = lane & 15;
    v2u zz[4][4];
    { const int voffz = ((c16 + 3) * NU + UC_Z + h * 64 + 4 * q4) * 2;
#pragma unroll
      for (int ti = 0; ti < 4; ++ti)
#pragma unroll
          for (int pj = 0; pj < 4; ++pj) zz[ti][pj] = __builtin_amdgcn_raw_buffer_load_b64(ru, voffz + pj * 32, sb + ti * 16 * ROWB, 0); }
    bf16x8 sf[4][4];
    { const bf16* sin = ssd_sin_ptr(b, h, c);
#pragma unroll
      for (int kk = 0; kk < 4; ++kk)
#pragma unroll
          for (int pj = 0; pj < 4; ++pj) sf[kk][pj] = *(const bf16x8*)(sin + (pj * 16 + c16) * 128 + kk * 32 + q4 * 8); }
    LBAR();
    { const int ti = w >> 1, sj0 = 2 * (w & 1); f32x4 ga[2] = {{0.f, 0.f, 0.f, 0.f}, {0.f, 0.f, 0.f, 0.f}};
#pragma unroll
      for (int kk = 0; kk < 4; ++kk) { const bf16x8 af = frag16(lds + CS, 272, ti * 16, kk, lane);
#pragma unroll
          for (int jj = 0; jj < 2; ++jj) { const bf16x8 bfr = frag16(lds + BS, 272, (sj0 + jj) * 16, kk, lane); ga[jj] = __builtin_amdgcn_mfma_f32_16x16x32_bf16(af, bfr, ga[jj], 0, 0, 0); } }
#pragma unroll
      for (int jj = 0; jj < 2; ++jj)
#pragma unroll
          for (int r = 0; r < 4; ++r) *(LAS bf16*)(lds + GS + (ti * 16 + 4 * q4 + r) * 144 + ((sj0 + jj) * 16 + c16) * 2) = (bf16)f2bf(ga[jj][r]); }
    LBAR();
    const LAS float* gt = (const LAS float*)(lds + GT) + w * 192;
    f32x4 acc[4][4];
#pragma unroll
    for (int pj = 0; pj < 4; ++pj)
#pragma unroll
        for (int ti = 0; ti < 4; ++ti) acc[pj][ti] = (f32x4){0.f, 0.f, 0.f, 0.f};
    {
#pragma unroll
      for (int kk = 0; kk < 4; ++kk) { bf16x8 bfr[4];
#pragma unroll
          for (int ti = 0; ti < 4; ++ti) bfr[ti] = frag16(lds + CS, 272, ti * 16, kk, lane);
#pragma unroll
          for (int pj = 0; pj < 4; ++pj)
#pragma unroll
              for (int ti = 0; ti < 4; ++ti) acc[pj][ti] = __builtin_amdgcn_mfma_f32_16x16x32_bf16(sf[kk][pj], bfr[ti], acc[pj][ti], 0, 0, 0); } }
#pragma unroll
    for (int ti = 0; ti < 4; ++ti) { const float e = gt[128 + ti * 16 + c16];
#pragma unroll
        for (int pj = 0; pj < 4; ++pj) acc[pj][ti] *= e; }
    { const float Dh = INP(I_SSD_D)[l * 16 + h];
#pragma unroll
      for (int kk = 0; kk < 2; ++kk) { bf16x8 af[4];
#pragma unroll
          for (int pj = 0; pj < 4; ++pj) af[pj] = *(const LAS bf16x8*)(lds + XST + w * 9216 + (pj * 16 + c16) * 144 + (((kk * 4 + q4) ^ ((2 * pj + (c16 >> 3)) & 7)) << 4));
          const int s0 = kk * 32 + q4 * 8; const f32x4 cs0 = *(const LAS f32x4*)(gt + s0), cs1 = *(const LAS f32x4*)(gt + s0 + 4), ds0 = *(const LAS f32x4*)(gt + 64 + s0), ds1 = *(const LAS f32x4*)(gt + 64 + s0 + 4);
          const float csv[8] = {cs0.x, cs0.y, cs0.z, cs0.w, cs1.x, cs1.y, cs1.z, cs1.w}, dsv[8] = {ds0.x, ds0.y, ds0.z, ds0.w, ds1.x, ds1.y, ds1.z, ds1.w};
#pragma unroll
          for (int ti = 2 * kk; ti < 4; ++ti) {
              const int t = ti * 16 + c16; const float ct = gt[t]; const bf16x8 g8 = *(const LAS bf16x8*)(lds + GS + t * 144 + s0 * 2); float mv[8];
#pragma unroll
              for (int j = 0; j < 8; ++j) { const int s = s0 + j; float v = s <= t ? bf2f((bf16)g8[j]) * fexp(ct - csv[j]) * dsv[j] : 0.f; if (s == t) v += Dh; mv[j] = v; }
              const v4u mp = (v4u){pk2(mv[0], mv[1]), pk2(mv[2], mv[3]), pk2(mv[4], mv[5]), pk2(mv[6], mv[7])}; const bf16x8 bfr = __builtin_bit_cast(bf16x8, mp);
#pragma unroll
              for (int pj = 0; pj < 4; ++pj) acc[pj][ti] = __builtin_amdgcn_mfma_f32_16x16x32_bf16(af[pj], bfr, acc[pj][ti], 0, 0, 0); } } }
    { const float* nwp = INP(I_SNW) + l * 1024 + h * 64 + 4 * q4; float nw[4][4];
#pragma unroll
      for (int pj = 0; pj < 4; ++pj) { const f32x4 n4 = *(const f32x4*)(nwp + pj * 16); nw[pj][0] = n4.x; nw[pj][1] = n4.y; nw[pj][2] = n4.z; nw[pj][3] = n4.w; }
      const int voffy = (c16 * MIXW + h * 64 + 4 * q4) * 2; float* SSQ = P_SSQ;
#pragma unroll
      for (int ti = 0; ti < 4; ++ti) { float sq = 0.f;
#pragma unroll
          for (int pj = 0; pj < 4; ++pj) { const v2u z2 = zz[ti][pj]; const float z4[4] = {lo_bf(z2.x), hi_bf(z2.x), lo_bf(z2.y), hi_bf(z2.y)}; float yz[4];
#pragma unroll
              for (int r = 0; r < 4; ++r) { yz[r] = acc[pj][ti][r] * siluf_(z4[r]); sq += yz[r] * yz[r]; }
              __builtin_amdgcn_raw_buffer_store_b64((v2u){pk2(yz[0] * nw[pj][0], yz[1] * nw[pj][1]), pk2(yz[2] * nw[pj][2], yz[3] * nw[pj][3])}, ryc, voffy + pj * 32, (rowbase + t0 + ti * 16) * (MIXW * 2), 0); }
          sq += __shfl_xor(sq, 16); sq += __shfl_xor(sq, 32);
          if (q4 == 0) SSQ[(size_t)(rowbase + t0 + ti * 16 + c16) * 16 + h] = sq; } }
    __syncthreads();
}

__device__ __forceinline__ bf16* ssd_sin_ptr2(int b, int h, int c) { return (bf16*)OUTP() + ((size_t)(b * 16 + h) * 32 + c) * 8192; }
__device__ __forceinline__ void ssd_passA2(Frame& F, int l, int b, int h, int flagset) {
    constexpr int L = 64, NCH = SEQ_P / L;
    constexpr int BST = 0, XST = 18432, GT = 27648;
    const int tid = F.tid, lane = F.lane, w = F.wave, g = h >> 3, rowbase = b * SEQ_P;
    LAS unsigned char* lds = F.lds;
    const bf16* U = P_U; const float* gates = P_GATES;
    const float a = -fexp(INP(I_ALOG)[l * 16 + h]), dtb = INP(I_DTB)[l * 16 + h];
    const int px = tid & 31, gx = tid >> 5, pb = tid & 63, gb = tid >> 6;
    const int colx = UC_XBC + h * 64 + 2 * px;
    float cwx[4][2], cbx[2];
    { const float* cw = INP(I_SCW) + (size_t)l * 4 * CONVD; const float* cb = INP(I_SCB) + (size_t)l * CONVD;
#pragma unroll
      for (int j = 0; j < 4; ++j)
#pragma unroll
          for (int e = 0; e < 2; ++e) cwx[j][e] = cw[j * CONVD + colx - UC_XBC + e];
#pragma unroll
      for (int e = 0; e < 2; ++e) cbx[e] = cb[colx - UC_XBC + e]; }
    unsigned rx[7], rb[8];
    const rsrc_t ru = U_RSRC(); const rsrc_t rbca = mk_rsrc(P_BCA, (unsigned)((size_t)MP * 512 * 2));
    const int voffx = (4 * gx * NU + colx) * 2, voffbc = (8 * gb * 512 + g * 128 + 2 * pb) * 2;
    auto prefetch = [&](int c) {
        const int sb = (rowbase + c * L) * ROWB;
#pragma unroll
        for (int i = 0; i < 7; ++i) { rx[i] = __builtin_amdgcn_raw_buffer_load_b32(ru, voffx, sb + i * ROWB, 0); if (c == 0 && 4 * gx + i < 3) rx[i] = 0u; }
#pragma unroll
        for (int i = 0; i < 8; ++i) rb[i] = __builtin_amdgcn_raw_buffer_load_b32(rbca, voffbc, (rowbase + c * L + i) * 1024, 0);
    };
    for (int c = w; c < NCH; c += NWAVES) {
        LAS float* gtw = (LAS float*)(lds + GT) + c * 128;
        const float dt = softplusf_(gates[(size_t)(rowbase + c * L + lane) * NG + h] + dtb); float x = dt * a;
#pragma unroll
        for (int o = 1; o < 64; o <<= 1) { const float y = __shfl_up(x, o); if (lane >= o) x += y; }
        const float cl = __shfl(x, 63);
        gtw[lane] = fexp(cl - x) * dt; if (lane == 63) gtw[64] = fexp(x);
    }
    f32x16 S; for (int r = 0; r < 16; ++r) S[r] = 0.f;
    prefetch(0);
    __syncthreads();
    const int pi = w >> 2, ni = w & 3;
    for (int c = 0; c < NCH; ++c) {
        const LAS float* gt = (const LAS float*)(lds + GT) + c * 128;
        { bf16* so = ssd_sin_ptr2(b, h, c);
#pragma unroll
          for (int r = 0; r < 16; ++r) so[(pi * 32 + crow32(r, lane >> 5)) * 128 + ni * 32 + (lane & 31)] = (bf16)f2bf(S[r]); }
        { float o0[4], o1[4];
#pragma unroll
          for (int i = 0; i < 4; ++i) { float a0 = cbx[0], a1 = cbx[1];
#pragma unroll
              for (int j = 0; j < 4; ++j) { a0 += cwx[j][0] * lo_bf(rx[i + j]); a1 += cwx[j][1] * hi_bf(rx[i + j]); }
              o0[i] = siluf_(a0); o1[i] = siluf_(a1); }
          *(LAS v2u*)(lds + XST + (2 * px) * 144 + 8 * gx) = (v2u){pk2(o0[0], o0[1]), pk2(o0[2], o0[3])};
          *(LAS v2u*)(lds + XST + (2 * px + 1) * 144 + 8 * gx) = (v2u){pk2(o1[0], o1[1]), pk2(o1[2], o1[3])}; }
        { float o0[8], o1[8];
#pragma unroll
          for (int i = 0; i < 8; ++i) { const float ws = gt[8 * gb + i]; o0[i] = lo_bf(rb[i]) * ws; o1[i] = hi_bf(rb[i]) * ws; }
          *(LAS v4u*)(lds + BST + (2 * pb) * 144 + 16 * gb) = (v4u){pk2(o0[0], o0[1]), pk2(o0[2], o0[3]), pk2(o0[4], o0[5]), pk2(o0[6], o0[7])};
          *(LAS v4u*)(lds + BST + (2 * pb + 1) * 144 + 16 * gb) = (v4u){pk2(o1[0], o1[1]), pk2(o1[2], o1[3]), pk2(o1[4], o1[5]), pk2(o1[6], o1[7])}; }
        if (c + 1 < NCH) prefetch(c + 1);
        LBAR();
        { const float dal = gt[64];
#pragma unroll
          for (int r = 0; r < 16; ++r) S[r] *= dal;
#pragma unroll
          for (int kk = 0; kk < 4; ++kk) { const bf16x8 af = frag32(lds + XST, 144, pi * 32, kk, lane); const bf16x8 bfr = frag32(lds + BST, 144, ni * 32, kk, lane);
              S = __builtin_amdgcn_mfma_f32_32x32x16_bf16(af, bfr, S, 0, 0, 0); } }
        LBAR();
    }
    { float* so = OUTP() + O_P_SSM + (((size_t)l * NB_P + b) * 16 + h) * 8192;
#pragma unroll
      for (int r = 0; r < 16; ++r) so[(pi * 32 + crow32(r, lane >> 5)) * 128 + ni * 32 + (lane & 31)] = S[r]; }
    if (h == 0) { float* co = OUTP() + O_P_SCONV + ((size_t)l * NB_P + b) * 3 * CONVD;
        for (int idx = tid; idx < 3 * CONVD; idx += NTHR) { const int j = idx / CONVD, cc = idx % CONVD; co[idx] = bf2f(U[(size_t)(rowbase + SEQ_P - 3 + j) * NU + UC_XBC + cc]); } }
    asm volatile("s_waitcnt vmcnt(0)" ::: "memory");
    __syncthreads();
    if (tid == 0) { __builtin_amdgcn_fence(__ATOMIC_RELEASE, "agent"); asm volatile("s_waitcnt vmcnt(0)" ::: "memory");
        __hip_atomic_store(P_CTL + CW_FLAG2 + 16 * ((flagset * 2 + l) * 128 + b * 16 + h), 1u, __ATOMIC_RELAXED, __HIP_MEMORY_SCOPE_AGENT); }
    __syncthreads();
}

__device__ __forceinline__ void ssd_passB2(Frame& F, int l, int b, int c, int g, int flagset) {
    constexpr int L = 64;
    constexpr int CS = 0, BS = 17408, GS = 34816, XST = 44032, GT = 117760;
    const int tid = F.tid, lane = F.lane, w = F.wave, rowbase = b * SEQ_P, t0 = c * L, h = g * 8 + w;
    LAS unsigned char* lds = F.lds;
    const float* gates = P_GATES;
    const rsrc_t ru = U_RSRC(); const rsrc_t ryc = mk_rsrc(P_YCAT, (unsigned)((size_t)MT * MIXW * 2));
    const float* cw = INP(I_SCW) + (size_t)l * 4 * CONVD; const float* cb = INP(I_SCB) + (size_t)l * CONVD;
    const int sb = (rowbase + t0) * ROWB;
    { LAS float* gtw = (LAS float*)(lds + GT) + w * 192;
      const float dt = softplusf_(gates[(size_t)(rowbase + t0 + lane) * NG + h] + INP(I_DTB)[l * 16 + h]); float x = -dt * fexp(INP(I_ALOG)[l * 16 + h]);
#pragma unroll
      for (int o = 1; o < 64; o <<= 1) { const float y = __shfl_up(x, o); if (lane >= o) x += y; }
      gtw[lane] = x; gtw[64 + lane] = dt; gtw[128 + lane] = fexp(x); }
    if (tid == 0) { unsigned spins = 0;
        for (int hh = 0; hh < 8; ++hh) { unsigned* fl = P_CTL + CW_FLAG2 + 16 * ((flagset * 2 + l) * 128 + b * 16 + g * 8 + hh);
            while (__hip_atomic_load(fl, __ATOMIC_RELAXED, __HIP_MEMORY_SCOPE_AGENT) == 0u) { __builtin_amdgcn_s_sleep(8); if (++spins > (1u << 22)) break; } }
        __builtin_amdgcn_fence(__ATOMIC_ACQUIRE, "agent"); asm volatile("s_waitcnt vmcnt(0)" ::: "memory"); }
    __syncthreads();
    { const v4u* bca = (const v4u*)P_BCA;
#pragma unroll
      for (int i = 0; i < 2; ++i) { const int id = tid + NTHR * i, row = id >> 4, pc = id & 15; const size_t rb_ = (size_t)(rowbase + t0 + row) * 64;
          *(LAS v4u*)(lds + BS + row * 272 + pc * 16) = bca[rb_ + g * 16 + pc]; *(LAS v4u*)(lds + CS + row * 272 + pc * 16) = bca[rb_ + 32 + g * 16 + pc]; } }
    { const int cx = tid & 63, gx8 = tid >> 6, colx = UC_XBC + g * 512 + 8 * cx, hh = cx >> 3, p0 = 8 * (cx & 7);
      v4u rx[11];
#pragma unroll
      for (int i = 0; i < 11; ++i) { rx[i] = __builtin_amdgcn_raw_buffer_load_b128(ru, (8 * gx8 * NU + colx) * 2, sb + i * ROWB, 0); if (c == 0 && 8 * gx8 + i < 3) rx[i] = (v4u){0u, 0u, 0u, 0u}; }
#pragma unroll
      for (int e2 = 0; e2 < 4; ++e2) {
          float w0[4], w1[4];
#pragma unroll
          for (int j = 0; j < 4; ++j) { w0[j] = cw[j * CONVD + colx - UC_XBC + 2 * e2]; w1[j] = cw[j * CONVD + colx - UC_XBC + 2 * e2 + 1]; }
          const float b0 = cb[colx - UC_XBC + 2 * e2], b1 = cb[colx - UC_XBC + 2 * e2 + 1];
          float o0[8], o1[8];
#pragma unroll
          for (int i = 0; i < 8; ++i) { float a0 = b0, a1 = b1;
#pragma unroll
              for (int j = 0; j < 4; ++j) { const unsigned u = rx[i + j][e2]; a0 += w0[j] * lo_bf(u); a1 += w1[j] * hi_bf(u); }
              o0[i] = siluf_(a0); o1[i] = siluf_(a1); }
          *(LAS v4u*)(lds + XST + hh * 9216 + (p0 + 2 * e2) * 144 + ((gx8 ^ (cx & 7)) << 4)) = (v4u){pk2(o0[0], o0[1]), pk2(o0[2], o0[3]), pk2(o0[4], o0[5]), pk2(o0[6], o0[7])};
          *(LAS v4u*)(lds + XST + hh * 9216 + (p0 + 2 * e2 + 1) * 144 + ((gx8 ^ (cx & 7)) << 4)) = (v4u){pk2(o1[0], o1[1]), pk2(o1[2], o1[3]), pk2(o1[4], o1[5]), pk2(o1[6], o1[7])}; } }
    const int q4 = lane >> 4, c16 = lane & 15;
    v2u zz[4][4];
    { const int voffz = ((c16 + 3) * NU + UC_Z + h * 64 + 4 * q4) * 2;
#pragma unroll
      for (int ti = 0; ti < 4; ++ti)
#pragma unroll
          for (int pj = 0; pj < 4; ++pj) zz[ti][pj] = __builtin_amdgcn_raw_buffer_load_b64(ru, voffz + pj * 32, sb + ti * 16 * ROWB, 0); }
    bf16x8 sf[4][4];
    { const bf16* sin = ssd_sin_ptr2(b, h, c);
#pragma unroll
      for (int kk = 0; kk < 4; ++kk)
#pragma unroll
          for (int pj = 0; pj < 4; ++pj) sf[kk][pj] = *(const bf16x8*)(sin + (pj * 16 + c16) * 128 + kk * 32 + q4 * 8); }
    LBAR();
    { const int ti = w >> 1, sj0 = 2 * (w & 1); f32x4 ga[2] = {{0.f, 0.f, 0.f, 0.f}, {0.f, 0.f, 0.f, 0.f}};
#pragma unroll
      for (int kk = 0; kk < 4; ++kk) { const bf16x8 af = frag16(lds + CS, 272, ti * 16, kk, lane);
#pragma unroll
          for (int jj = 0; jj < 2; ++jj) { const bf16x8 bfr = frag16(lds + BS, 272, (sj0 + jj) * 16, kk, lane); ga[jj] = __builtin_amdgcn_mfma_f32_16x16x32_bf16(af, bfr, ga[jj], 0, 0, 0); } }
#pragma unroll
      for (int jj = 0; jj < 2; ++jj)
#pragma unroll
          for (int r = 0; r < 4; ++r) *(LAS bf16*)(lds + GS + (ti * 16 + 4 * q4 + r) * 144 + ((sj0 + jj) * 16 + c16) * 2) = (bf16)f2bf(ga[jj][r]); }
    LBAR();
    const LAS float* gt = (const LAS float*)(lds + GT) + w * 192;
    f32x4 acc[4][4];
#pragma unroll
    for (int pj = 0; pj < 4; ++pj)
#pragma unroll
        for (int ti = 0; ti < 4; ++ti) acc[pj][ti] = (f32x4){0.f, 0.f, 0.f, 0.f};
    {
#pragma unroll
      for (int kk = 0; kk < 4; ++kk) { bf16x8 bfr[4];
#pragma unroll
          for (int ti = 0; ti < 4; ++ti) bfr[ti] = frag16(lds + CS, 272, ti * 16, kk, lane);
#pragma unroll
          for (int pj = 0; pj < 4; ++pj)
#pragma unroll
              for (int ti = 0; ti < 4; ++ti) acc[pj][ti] = __builtin_amdgcn_mfma_f32_16x16x32_bf16(sf[kk][pj], bfr[ti], acc[pj][ti], 0, 0, 0); } }
#pragma unroll
    for (int ti = 0; ti < 4; ++ti) { const float e = gt[128 + ti * 16 + c16];
#pragma unroll
        for (int pj = 0; pj < 4; ++pj) acc[pj][ti] *= e; }
    { const float Dh = INP(I_SSD_D)[l * 16 + h];
#pragma unroll
      for (int kk = 0; kk < 2; ++kk) { bf16x8 af[4];
#pragma unroll
          for (int pj = 0; pj < 4; ++pj) af[pj] = *(const LAS bf16x8*)(lds + XST + w * 9216 + (pj * 16 + c16) * 144 + (((kk * 4 + q4) ^ ((2 * pj + (c16 >> 3)) & 7)) << 4));
          const int s0 = kk * 32 + q4 * 8; const f32x4 cs0 = *(const LAS f32x4*)(gt + s0), cs1 = *(const LAS f32x4*)(gt + s0 + 4), ds0 = *(const LAS f32x4*)(gt + 64 + s0), ds1 = *(const LAS f32x4*)(gt + 64 + s0 + 4);
          const float csv[8] = {cs0.x, cs0.y, cs0.z, cs0.w, cs1.x, cs1.y, cs1.z, cs1.w}, dsv[8] = {ds0.x, ds0.y, ds0.z, ds0.w, ds1.x, ds1.y, ds1.z, ds1.w};
#pragma unroll
          for (int ti = 2 * kk; ti < 4; ++ti) {
              const int t = ti * 16 + c16; const float ct = gt[t]; const bf16x8 g8 = *(const LAS bf16x8*)(lds + GS + t * 144 + s0 * 2); float mv[8];
#pragma unroll
              for (int j = 0; j < 8; ++j) { const int s = s0 + j; float v = s <= t ? bf2f((bf16)g8[j]) * fexp(ct - csv[j]) * dsv[j] : 0.f; if (s == t) v += Dh; mv[j] = v; }
              const v4u mp = (v4u){pk2(mv[0], mv[1]), pk2(mv[2], mv[3]), pk2(mv[4], mv[5]), pk2(mv[6], mv[7])}; const bf16x8 bfr = __builtin_bit_cast(bf16x8, mp);
#pragma unroll
              for (int pj = 0; pj < 4; ++pj) acc[pj][ti] = __builtin_amdgcn_mfma_f32_16x16x32_bf16(af[pj], bfr, acc[pj][ti], 0, 0, 0); } } }
    { const float* nwp = INP(I_SNW) + l * 1024 + h * 64 + 4 * q4; float nw[4][4];
#pragma unroll
      for (int pj = 0; pj < 4; ++pj) { const f32x4 n4 = *(const f32x4*)(nwp + pj * 16); nw[pj][0] = n4.x; nw[pj][1] = n4.y; nw[pj][2] = n4.z; nw[pj][3] = n4.w; }
      const int voffy = (c16 * MIXW + h * 64 + 4 * q4) * 2; float* SSQ = P_SSQ;
#pragma unroll
      for (int ti = 0; ti < 4; ++ti) { float sq = 0.f;
#pragma unroll
          for (int pj = 0; pj < 4; ++pj) { const v2u z2 = zz[ti][pj]; const float z4[4] = {lo_bf(z2.x), hi_bf(z2.x), lo_bf(z2.y), hi_bf(z2.y)}; float yz[4];
#pragma unroll
              for (int r = 0; r < 4; ++r) { yz[r] = acc[pj][ti][r] * siluf_(z4[r]); sq += yz[r] * yz[r]; }
              __builtin_amdgcn_raw_buffer_store_b64((v2u){pk2(yz[0] * nw[pj][0], yz[1] * nw[pj][1]), pk2(yz[2] * nw[pj][2], yz[3] * nw[pj][3])}, ryc, voffy + pj * 32, (rowbase + t0 + ti * 16) * (MIXW * 2), 0); }
          sq += __shfl_xor(sq, 16); sq += __shfl_xor(sq, 32);
          if (q4 == 0) SSQ[(size_t)(rowbase + t0 + ti * 16 + c16) * 16 + h] = sq; } }
    __syncthreads();
}

__device__ __forceinline__ void mlstm_prompt_item(Frame& F, int l, int b, int h) {
    constexpr int L = 64, NCH = SEQ_P / L;
    constexpr int QS = 0, KS = 17408, KST = 34816, VST = 53248, WS = 71680, CBF = 80896, GT = 115712, GSUM = GT + NCH * 768, NN = GSUM + 512, SSQP = NN + 1024;
    static_assert(SSQP + 512 <= MISC_OFF, "mLSTM LDS map");
    constexpr float KSCALE = 0.08838834764831845f;
    const int tid = F.tid, lane = F.lane, w = F.wave, rowbase = b * SEQ_P;
    LAS unsigned char* lds = F.lds;
    const bf16* U = P_U; const float* gates = P_GATES; bf16* YC = P_YCAT;
    const float ib = INP(I_MIB)[l * 4 + h], fb = INP(I_MFB)[l * 4 + h];
    const int dp = tid & 63, sg = tid >> 6;
    v4u rq[2], rk4[2]; unsigned rkt[8], rvt[8];
    const rsrc_t ru = U_RSRC(); const rsrc_t ryc = mk_rsrc(YC, (unsigned)((size_t)MT * MIXW * 2));
    const int voffq = (((tid >> 4) + 3) * NU + UC_Q + h * 128 + (tid & 15) * 8) * 2, voffk = ((8 * sg + 3) * NU + UC_K + h * 128 + 2 * dp) * 2;
    auto prefetch = [&](int c) {
        const int sb = (rowbase + c * L) * ROWB;
#pragma unroll
        for (int i = 0; i < 2; ++i) { rq[i] = __builtin_amdgcn_raw_buffer_load_b128(ru, voffq, sb + 32 * i * ROWB, 0); rk4[i] = __builtin_amdgcn_raw_buffer_load_b128(ru, voffq + 1024, sb + 32 * i * ROWB, 0); }
#pragma unroll
        for (int i = 0; i < 8; ++i) { rkt[i] = __builtin_amdgcn_raw_buffer_load_b32(ru, voffk, sb + i * ROWB, 0); rvt[i] = __builtin_amdgcn_raw_buffer_load_b32(ru, voffk + 1024, sb + i * ROWB, 0); }
    };
    for (int c = w; c < NCH; c += NWAVES) {
        LAS float* gtw = (LAS float*)(lds + GT) + c * 192; LAS float* gs = (LAS float*)(lds + GSUM);
        const size_t row = (size_t)(rowbase + c * L + lane);
        const float ig = gates[row * NG + 16 + h] + ib, lf = -softplusf_(-(gates[row * NG + 20 + h] + fb));
        float bc = lf;
#pragma unroll
        for (int o = 1; o < 64; o <<= 1) { const float y = __shfl_up(bc, o); if (lane >= o) bc += y; }
        const float e = ig - bc; float pm = e;
#pragma unroll
        for (int o = 1; o < 64; o <<= 1) { const float y = __shfl_up(pm, o); if (lane >= o) pm = fmaxf(pm, y); }
        gtw[lane] = e; gtw[64 + lane] = bc; gtw[128 + lane] = pm;
        if (lane == 63) { gs[c] = bc; gs[32 + c] = pm; }
    }
    __syncthreads();
    if (tid == 0) { LAS float* gs = (LAS float*)(lds + GSUM); float mp = 0.f; for (int c = 0; c < NCH; ++c) { gs[64 + c] = mp; mp = gs[c] + fmaxf(mp, gs[32 + c]); } gs[64 + NCH] = mp; }
    f32x16 c0, c1; for (int r = 0; r < 16; ++r) { c0[r] = 0.f; c1[r] = 0.f; }
    for (int i = tid; i < 34816 / 4; i += NTHR) ((LAS unsigned*)(lds + CBF))[i] = 0u;
    if (tid < 256) ((LAS float*)(lds + NN))[tid] = 0.f;
    prefetch(0);
    __syncthreads();
    const int ti = w >> 1, sj0 = 2 * (w & 1), vbase = (w & 1) * 64, vi = w >> 1, di0 = 2 * (w & 1), q4 = lane >> 4, c16 = lane & 15;
    const float* nw = INP(I_MNW) + l * 512 + h * 128;
    const int voffo = ((ti * 16 + 4 * q4 + 3) * NU + UC_O + h * 128 + vbase + c16) * 2, voffyc = ((ti * 16 + 4 * q4) * MIXW + 1024 + h * 128 + vbase + c16) * 2;
    unsigned orr[4][4];
#pragma unroll
    for (int vj = 0; vj < 4; ++vj)
#pragma unroll
        for (int r = 0; r < 4; ++r) orr[vj][r] = __builtin_amdgcn_raw_buffer_load_b16(ru, voffo + vj * 32, (rowbase + r) * ROWB, 0);
    for (int c = 0; c < NCH; ++c) {
        const int t0 = c * L; const LAS float* gt = (const LAS float*)(lds + GT) + c * 192;
        const float mpv = ((const LAS float*)(lds + GSUM))[64 + c], pml = fmaxf(mpv, ((const LAS float*)(lds + GSUM))[32 + c]);
        const LAS float* nn = (const LAS float*)(lds + NN) + (c & 1) * 128; LAS float* nn_next = (LAS float*)(lds + NN) + ((c + 1) & 1) * 128;
#pragma unroll
        for (int i = 0; i < 2; ++i) { const int id = tid + NTHR * i, row = id >> 4, ch = id & 15; *(LAS v4u*)(lds + QS + row * 272 + ch * 16) = rq[i]; *(LAS v4u*)(lds + KS + row * 272 + ch * 16) = rk4[i]; }
        { float k0[8], k1[8];
#pragma unroll
          for (int i = 0; i < 8; ++i) { const float ws = fexp(gt[8 * sg + i] - pml) * KSCALE; k0[i] = lo_bf(rkt[i]) * ws; k1[i] = hi_bf(rkt[i]) * ws; }
          *(LAS v4u*)(lds + KST + (2 * dp) * 144 + 16 * sg) = (v4u){pk2(k0[0], k0[1]), pk2(k0[2], k0[3]), pk2(k0[4], k0[5]), pk2(k0[6], k0[7])};
          *(LAS v4u*)(lds + KST + (2 * dp + 1) * 144 + 16 * sg) = (v4u){pk2(k1[0], k1[1]), pk2(k1[2], k1[3]), pk2(k1[4], k1[5]), pk2(k1[6], k1[7])};
          *(LAS v4u*)(lds + VST + (2 * dp) * 144 + 16 * sg) = (v4u){(rvt[0] & 0xffffu) | (rvt[1] << 16), (rvt[2] & 0xffffu) | (rvt[3] << 16), (rvt[4] & 0xffffu) | (rvt[5] << 16), (rvt[6] & 0xffffu) | (rvt[7] << 16)};
          *(LAS v4u*)(lds + VST + (2 * dp + 1) * 144 + 16 * sg) = (v4u){(rvt[0] >> 16) | (rvt[1] & 0xffff0000u), (rvt[2] >> 16) | (rvt[3] & 0xffff0000u), (rvt[4] >> 16) | (rvt[5] & 0xffff0000u), (rvt[6] >> 16) | (rvt[7] & 0xffff0000u)}; }
        if (c + 1 < NCH) prefetch(c + 1);
        LBAR();
        { f32x4 sa[2] = {{0.f, 0.f, 0.f, 0.f}, {0.f, 0.f, 0.f, 0.f}};
#pragma unroll
          for (int kk = 0; kk < 4; ++kk) { const bf16x8 af = frag16(lds + QS, 272, ti * 16, kk, lane);
#pragma unroll
              for (int jj = 0; jj < 2; ++jj) { const bf16x8 bfr = frag16(lds + KS, 272, (sj0 + jj) * 16, kk, lane); sa[jj] = __builtin_amdgcn_mfma_f32_16x16x32_bf16(af, bfr, sa[jj], 0, 0, 0); } }
          float pt[4];
#pragma unroll
          for (int r = 0; r < 4; ++r) pt[r] = fmaxf(mpv, gt[128 + ti * 16 + 4 * q4 + r]);
#pragma unroll
          for (int jj = 0; jj < 2; ++jj) { const int s = (sj0 + jj) * 16 + c16; const float es = gt[s];
#pragma unroll
              for (int r = 0; r < 4; ++r) { const int t = ti * 16 + 4 * q4 + r; const float v = s <= t ? sa[jj][r] * KSCALE * fexp(es - pt[r]) : 0.f;
                  *(LAS bf16*)(lds + WS + t * 144 + s * 2) = (bf16)f2bf(v); } } }
        LBAR();
        f32x4 ha[4];
        { const int trow = ti * 16 + c16;
          float dsum = 0.f, qn = 0.f;
          { const LAS bf16x8* wp = (const LAS bf16x8*)(lds + WS + trow * 144 + q4 * 32);
#pragma unroll
            for (int i = 0; i < 2; ++i) { const bf16x8 v8 = wp[i];
#pragma unroll
                for (int e = 0; e < 8; ++e) dsum += bf2f((bf16)v8[e]); }
            const LAS bf16x8* qp = (const LAS bf16x8*)(lds + QS + trow * 272 + q4 * 64); const LAS f32x4* np = (const LAS f32x4*)(nn + q4 * 32);
#pragma unroll
            for (int i = 0; i < 4; ++i) { const bf16x8 v8 = qp[i]; const f32x4 n0 = np[2 * i], n1 = np[2 * i + 1];
                qn += bf2f((bf16)v8[0]) * n0.x + bf2f((bf16)v8[1]) * n0.y + bf2f((bf16)v8[2]) * n0.z + bf2f((bf16)v8[3]) * n0.w
                    + bf2f((bf16)v8[4]) * n1.x + bf2f((bf16)v8[5]) * n1.y + bf2f((bf16)v8[6]) * n1.z + bf2f((bf16)v8[7]) * n1.w; } }
          dsum += __shfl_xor(dsum, 16); dsum += __shfl_xor(dsum, 32); qn += __shfl_xor(qn, 16); qn += __shfl_xor(qn, 32);
          const float pmt = fmaxf(mpv, gt[128 + trow]); const float dfull = dsum + fexp(mpv - pmt) * qn, dent = fmaxf(fabsf(dfull), fexp(-(gt[64 + trow] + pmt)));
          float dr[4], it4[4];
#pragma unroll
          for (int r = 0; r < 4; ++r) { dr[r] = frcp(__shfl(dent, 4 * q4 + r)); it4[r] = fexp(mpv - fmaxf(mpv, gt[128 + ti * 16 + 4 * q4 + r])); }
#pragma unroll
          for (int vj = 0; vj < 4; ++vj) ha[vj] = (f32x4){0.f, 0.f, 0.f, 0.f};
#pragma unroll
          for (int kk = 0; kk < 4; ++kk) { const bf16x8 af = frag16(lds + QS, 272, ti * 16, kk, lane);
#pragma unroll
              for (int vj = 0; vj < 4; ++vj) { const bf16x8 bfr = frag16(lds + CBF, 272, vbase + vj * 16, kk, lane); ha[vj] = __builtin_amdgcn_mfma_f32_16x16x32_bf16(af, bfr, ha[vj], 0, 0, 0); } }
#pragma unroll
          for (int vj = 0; vj < 4; ++vj)
#pragma unroll
              for (int r = 0; r < 4; ++r) ha[vj][r] *= it4[r];
#pragma unroll
          for (int kk = 0; kk < 2; ++kk) { const bf16x8 af = frag16(lds + WS, 144, ti * 16, kk, lane);
#pragma unroll
              for (int vj = 0; vj < 4; ++vj) { const bf16x8 bfr = frag16(lds + VST, 144, vbase + vj * 16, kk, lane); ha[vj] = __builtin_amdgcn_mfma_f32_16x16x32_bf16(af, bfr, ha[vj], 0, 0, 0); } }
          float sq[4] = {0.f, 0.f, 0.f, 0.f};
#pragma unroll
          for (int vj = 0; vj < 4; ++vj)
#pragma unroll
              for (int r = 0; r < 4; ++r) { ha[vj][r] = ha[vj][r] * dr[r]; sq[r] += ha[vj][r] * ha[vj][r]; }
#pragma unroll
          for (int r = 0; r < 4; ++r) { float v = sq[r]; v += __shfl_xor(v, 1); v += __shfl_xor(v, 2); v += __shfl_xor(v, 4); v += __shfl_xor(v, 8);
              if (c16 == 0) ((LAS float*)(lds + SSQP))[(w & 1) * 64 + ti * 16 + 4 * q4 + r] = v; } }
        { const float dc = fexp(mpv - pml);
#pragma unroll
          for (int r = 0; r < 16; ++r) { c0[r] *= dc; c1[r] *= dc; }
#pragma unroll
          for (int kk = 0; kk < 4; ++kk) { const bf16x8 af = frag32(lds + VST, 144, vi * 32, kk, lane);
              const bf16x8 b0 = frag32(lds + KST, 144, di0 * 32, kk, lane), b1 = frag32(lds + KST, 144, (di0 + 1) * 32, kk, lane);
              c0 = __builtin_amdgcn_mfma_f32_32x32x16_bf16(af, b0, c0, 0, 0, 0); c1 = __builtin_amdgcn_mfma_f32_32x32x16_bf16(af, b1, c1, 0, 0, 0); }
          const int d = tid >> 2, part = tid & 3; const LAS bf16x8* kp = (const LAS bf16x8*)(lds + KST + d * 144 + part * 32); float ks = 0.f;
#pragma unroll
          for (int i = 0; i < 2; ++i) { const bf16x8 v8 = kp[i];
#pragma unroll
              for (int e = 0; e < 8; ++e) ks += bf2f((bf16)v8[e]); }
          ks += __shfl_xor(ks, 1); ks += __shfl_xor(ks, 2);
          if (part == 0) nn_next[d] = dc * nn[d] + ks; }
        LBAR();
#pragma unroll
        for (int vj = 0; vj < 4; ++vj)
#pragma unroll
            for (int r = 0; r < 4; ++r) asm volatile("" : "+v"(orr[vj][r]));
#pragma unroll
        for (int r = 0; r < 4; ++r) { const int t = ti * 16 + 4 * q4 + r; const float rstd = __builtin_amdgcn_rsqf((((LAS float*)(lds + SSQP))[t] + ((LAS float*)(lds + SSQP))[64 + t]) * (1.f / 128.f) + EPS);
#pragma unroll
            for (int vj = 0; vj < 4; ++vj) { const int v = vbase + vj * 16 + c16;
                __builtin_amdgcn_raw_buffer_store_b16((bf16)f2bf(ha[vj][r] * rstd * nw[v] * sigmoidf_(bf2f((bf16)orr[vj][r]))), ryc, voffyc + vj * 32, (rowbase + t0 + r) * (MIXW * 2), 0); } }
        if (c + 1 < NCH) {
#pragma unroll
            for (int vj = 0; vj < 4; ++vj)
#pragma unroll
                for (int r = 0; r < 4; ++r) orr[vj][r] = __builtin_amdgcn_raw_buffer_load_b16(ru, voffo + vj * 32, (rowbase + t0 + L + r) * ROWB, 0); }
#pragma unroll
        for (int r = 0; r < 16; ++r) { const int v = vi * 32 + crow32(r, lane >> 5);
            *(LAS bf16*)(lds + CBF + v * 272 + (di0 * 32 + (lane & 31)) * 2) = (bf16)f2bf(c0[r]); *(LAS bf16*)(lds + CBF + v * 272 + ((di0 + 1) * 32 + (lane & 31)) * 2) = (bf16)f2bf(c1[r]); }
    }
    { float* co = OUTP() + O_P_MC + (((size_t)l * NB_P + b) * 4 + h) * 16384;
#pragma unroll
      for (int r = 0; r < 16; ++r) { const int v = vi * 32 + crow32(r, lane >> 5); co[v * 128 + di0 * 32 + (lane & 31)] = c0[r]; co[v * 128 + (di0 + 1) * 32 + (lane & 31)] = c1[r]; }
      if (tid < 128) OUTP()[O_P_MN + (((size_t)l * NB_P + b) * 4 + h) * 128 + tid] = ((LAS float*)(lds + NN))[(NCH & 1) * 128 + tid];
      if (tid == 0) OUTP()[O_P_MM + ((size_t)l * NB_P + b) * 4 + h] = ((const LAS float*)(lds + GSUM))[64 + NCH]; }
    __syncthreads();
}

__device__ __forceinline__ void mlstm_passA(Frame& F, int l, int b, int h, int flagset) {
    constexpr int L = 64, NCH = SEQ_P / L;
    constexpr int KST = 0, VST = 18432, GT = 36864, GSUM = GT + NCH * 768, NN = GSUM + 512;
    constexpr float KSCALE = 0.08838834764831845f;
    const int tid = F.tid, lane = F.lane, w = F.wave, rowbase = b * SEQ_P;
    LAS unsigned char* lds = F.lds;
    const float* gates = P_GATES;
    const float ib = INP(I_MIB)[l * 4 + h], fb = INP(I_MFB)[l * 4 + h];
    const int dp = tid & 63, sg = tid >> 6;
    unsigned rkt[8], rvt[8];
    const rsrc_t ru = U_RSRC();
    const int voffk = ((8 * sg + 3) * NU + UC_K + h * 128 + 2 * dp) * 2;
    auto prefetch = [&](int c) {
        const int sb = (rowbase + c * L) * ROWB;
#pragma unroll
        for (int i = 0; i < 8; ++i) { rkt[i] = __builtin_amdgcn_raw_buffer_load_b32(ru, voffk, sb + i * ROWB, 0); rvt[i] = __builtin_amdgcn_raw_buffer_load_b32(ru, voffk + 1024, sb + i * ROWB, 0); }
    };
    for (int c = w; c < NCH; c += NWAVES) {
        LAS float* gtw = (LAS float*)(lds + GT) + c * 192; LAS float* gs = (LAS float*)(lds + GSUM);
        const size_t row = (size_t)(rowbase + c * L + lane);
        const float ig = gates[row * NG + 16 + h] + ib, lf = -softplusf_(-(gates[row * NG + 20 + h] + fb));
        float bc = lf;
#pragma unroll
        for (int o = 1; o < 64; o <<= 1) { const float y = __shfl_up(bc, o); if (lane >= o) bc += y; }
        const float e = ig - bc; float pm = e;
#pragma unroll
        for (int o = 1; o < 64; o <<= 1) { const float y = __shfl_up(pm, o); if (lane >= o) pm = fmaxf(pm, y); }
        gtw[lane] = e; gtw[64 + lane] = bc; gtw[128 + lane] = pm;
        if (lane == 63) { gs[c] = bc; gs[32 + c] = pm; }
    }
    LBAR();
    if (tid == 0) { LAS float* gs = (LAS float*)(lds + GSUM); float* mg = P_MLG + (size_t)(b * 4 + h) * 40; float mp = 0.f;
        for (int c = 0; c < NCH; ++c) { gs[64 + c] = mp; mg[c] = mp; mp = gs[c] + fmaxf(mp, gs[32 + c]); } gs[64 + NCH] = mp; }
    f32x16 c0, c1; for (int r = 0; r < 16; ++r) { c0[r] = 0.f; c1[r] = 0.f; }
    if (tid < 256) ((LAS float*)(lds + NN))[tid] = 0.f;
    prefetch(0);
    LBAR();
    const int vi = w >> 1, di0 = 2 * (w & 1);
    bf16* cin = P_CIN + (size_t)(b * 4 + h) * NCH * 16384; float* nin = P_NIN + (size_t)(b * 4 + h) * NCH * 128;
    for (int c = 0; c < NCH; ++c) {
        const LAS float* gt = (const LAS float*)(lds + GT) + c * 192;
        const float mpv = ((const LAS float*)(lds + GSUM))[64 + c], pml = fmaxf(mpv, ((const LAS float*)(lds + GSUM))[32 + c]);
        const LAS float* nn = (const LAS float*)(lds + NN) + (c & 1) * 128; LAS float* nn_next = (LAS float*)(lds + NN) + ((c + 1) & 1) * 128;
#pragma unroll
        for (int r = 0; r < 16; ++r) { bf16* cp = cin + (size_t)c * 16384 + (vi * 32 + crow32(r, lane >> 5)) * 128 + di0 * 32 + (lane & 31); cp[0] = (bf16)f2bf(c0[r]); cp[32] = (bf16)f2bf(c1[r]); }
        if (tid < 128) nin[c * 128 + tid] = nn[tid];
        { float k0[8], k1[8];
#pragma unroll
          for (int i = 0; i < 8; ++i) { const float ws = fexp(gt[8 * sg + i] - pml) * KSCALE; k0[i] = lo_bf(rkt[i]) * ws; k1[i] = hi_bf(rkt[i]) * ws; }
          *(LAS v4u*)(lds + KST + (2 * dp) * 144 + 16 * sg) = (v4u){pk2(k0[0], k0[1]), pk2(k0[2], k0[3]), pk2(k0[4], k0[5]), pk2(k0[6], k0[7])};
          *(LAS v4u*)(lds + KST + (2 * dp + 1) * 144 + 16 * sg) = (v4u){pk2(k1[0], k1[1]), pk2(k1[2], k1[3]), pk2(k1[4], k1[5]), pk2(k1[6], k1[7])};
          *(LAS v4u*)(lds + VST + (2 * dp) * 144 + 16 * sg) = (v4u){(rvt[0] & 0xffffu) | (rvt[1] << 16), (rvt[2] & 0xffffu) | (rvt[3] << 16), (rvt[4] & 0xffffu) | (rvt[5] << 16), (rvt[6] & 0xffffu) | (rvt[7] << 16)};
          *(LAS v4u*)(lds + VST + (2 * dp + 1) * 144 + 16 * sg) = (v4u){(rvt[0] >> 16) | (rvt[1] & 0xffff0000u), (rvt[2] >> 16) | (rvt[3] & 0xffff0000u), (rvt[4] >> 16) | (rvt[5] & 0xffff0000u), (rvt[6] >> 16) | (rvt[7] & 0xffff0000u)}; }
        if (c + 1 < NCH) prefetch(c + 1);
        LBAR();
        { const float dc = fexp(mpv - pml);
#pragma unroll
          for (int r = 0; r < 16; ++r) { c0[r] *= dc; c1[r] *= dc; }
#pragma unroll
          for (int kk = 0; kk < 4; ++kk) { const bf16x8 af = frag32(lds + VST, 144, vi * 32, kk, lane);
              const bf16x8 b0 = frag32(lds + KST, 144, di0 * 32, kk, lane), b1 = frag32(lds + KST, 144, (di0 + 1) * 32, kk, lane);
              c0 = __builtin_amdgcn_mfma_f32_32x32x16_bf16(af, b0, c0, 0, 0, 0); c1 = __builtin_amdgcn_mfma_f32_32x32x16_bf16(af, b1, c1, 0, 0, 0); }
          const int d = tid >> 2, part = tid & 3; const LAS bf16x8* kp = (const LAS bf16x8*)(lds + KST + d * 144 + part * 32); float ks = 0.f;
#pragma unroll
          for (int i = 0; i < 2; ++i) { const bf16x8 v8 = kp[i];
#pragma unroll
              for (int e = 0; e < 8; ++e) ks += bf2f((bf16)v8[e]); }
          ks += dppf<0xB1>(ks); ks += dppf<0x4E>(ks);
          if (part == 0) nn_next[d] = dc * nn[d] + ks; }
        LBAR();
    }
    { float* co = OUTP() + O_P_MC + (((size_t)l * NB_P + b) * 4 + h) * 16384;
#pragma unroll
      for (int r = 0; r < 16; ++r) { const int v = vi * 32 + crow32(r, lane >> 5); co[v * 128 + di0 * 32 + (lane & 31)] = c0[r]; co[v * 128 + (di0 + 1) * 32 + (lane & 31)] = c1[r]; }
      if (tid < 128) OUTP()[O_P_MN + (((size_t)l * NB_P + b) * 4 + h) * 128 + tid] = ((LAS float*)(lds + NN))[(NCH & 1) * 128 + tid];
      if (tid == 0) OUTP()[O_P_MM + ((size_t)l * NB_P + b) * 4 + h] = ((const LAS float*)(lds + GSUM))[64 + NCH]; }
    asm volatile("s_waitcnt vmcnt(0)" ::: "memory");
    LBAR();
    if (tid == 0) { __builtin_amdgcn_fence(__ATOMIC_RELEASE, "agent"); asm volatile("s_waitcnt vmcnt(0)" ::: "memory");
        __hip_atomic_store(P_CTL + CW_FLAG + 64 * ((flagset * 2 + l) * 32 + b * 4 + h), 1u, __ATOMIC_RELAXED, __HIP_MEMORY_SCOPE_AGENT); }
    LBAR();
}
__device__ __forceinline__ void mlstm_passB(Frame& F, int l, int b, int h, int c, int flagset) {
    constexpr int L = 64, NCH = SEQ_P / L;
    constexpr int QS = 0, KS = 17408, VST = 34816, WS = 53248, CBF = 62464, GT = 97280, NN = 98304, SSQP = 98816;
    constexpr float KSCALE = 0.08838834764831845f;
    const int tid = F.tid, lane = F.lane, w = F.wave, rowbase = b * SEQ_P, t0 = c * L;
    LAS unsigned char* lds = F.lds;
    const float* gates = P_GATES; bf16* YC = P_YCAT;
    const float ib = INP(I_MIB)[l * 4 + h], fb = INP(I_MFB)[l * 4 + h];
    const int dp = tid & 63, sg = tid >> 6;
    const rsrc_t ru = U_RSRC(); const rsrc_t ryc = mk_rsrc(YC, (unsigned)((size_t)MT * MIXW * 2));
    const int voffq = (((tid >> 4) + 3) * NU + UC_Q + h * 128 + (tid & 15) * 8) * 2, voffk = ((8 * sg + 3) * NU + UC_K + h * 128 + 2 * dp) * 2;
    const int ti = w >> 1, sj0 = 2 * (w & 1), vbase = (w & 1) * 64, q4 = lane >> 4, c16 = lane & 15;
    const float* nw = INP(I_MNW) + l * 512 + h * 128;
    const int voffo = ((ti * 16 + 4 * q4 + 3) * NU + UC_O + h * 128 + vbase + c16) * 2, voffyc = ((ti * 16 + 4 * q4) * MIXW + 1024 + h * 128 + vbase + c16) * 2;
    const int sb = (rowbase + t0) * ROWB;
    float nwv[4];
#pragma unroll
    for (int vj = 0; vj < 4; ++vj) nwv[vj] = nw[vbase + vj * 16 + c16];
    if (flagset >= 0) {
        if (tid == 0) { unsigned* fl = P_CTL + CW_FLAG + 64 * ((flagset * 2 + l) * 32 + b * 4 + h); unsigned spins = 0;
            while (__hip_atomic_load(fl, __ATOMIC_RELAXED, __HIP_MEMORY_SCOPE_AGENT) == 0u) { __builtin_amdgcn_s_sleep(8); if (++spins > (1u << 22)) break; }
            __builtin_amdgcn_fence(__ATOMIC_ACQUIRE, "agent"); asm volatile("s_waitcnt vmcnt(0)" ::: "memory"); }
        LBAR(); }
    v4u rq[2], rk4[2], rc[4]; unsigned rvt[8], orr[4][4];
#pragma unroll
    for (int i = 0; i < 2; ++i) { rq[i] = __builtin_amdgcn_raw_buffer_load_b128(ru, voffq, sb + 32 * i * ROWB, 0); rk4[i] = __builtin_amdgcn_raw_buffer_load_b128(ru, voffq + 1024, sb + 32 * i * ROWB, 0); }
#pragma unroll
    for (int i = 0; i < 8; ++i) rvt[i] = __builtin_amdgcn_raw_buffer_load_b32(ru, voffk + 1024, sb + i * ROWB, 0);
    { const v4u* cin = (const v4u*)(P_CIN + ((size_t)(b * 4 + h) * NCH + c) * 16384);
#pragma unroll
      for (int i = 0; i < 4; ++i) rc[i] = cin[tid + NTHR * i]; }
    const float mpv = P_MLG[(size_t)(b * 4 + h) * 40 + c];
    if (w == 0) { LAS float* gtw = (LAS float*)(lds + GT);
        const size_t row = (size_t)(rowbase + t0 + lane);
        const float ig = gates[row * NG + 16 + h] + ib, lf = -softplusf_(-(gates[row * NG + 20 + h] + fb));
        float bc = lf;
#pragma unroll
        for (int o = 1; o < 64; o <<= 1) { const float y = __shfl_up(bc, o); if (lane >= o) bc += y; }
        const float e = ig - bc; float pm = e;
#pragma unroll
        for (int o = 1; o < 64; o <<= 1) { const float y = __shfl_up(pm, o); if (lane >= o) pm = fmaxf(pm, y); }
        gtw[lane] = e; gtw[64 + lane] = bc; gtw[128 + lane] = pm; }
    if (tid < 128) ((LAS float*)(lds + NN))[tid] = P_NIN[((size_t)(b * 4 + h) * NCH + c) * 128 + tid];
#pragma unroll
    for (int vj = 0; vj < 4; ++vj)
#pragma unroll
        for (int r = 0; r < 4; ++r) orr[vj][r] = __builtin_amdgcn_raw_buffer_load_b16(ru, voffo + vj * 32, (rowbase + t0 + r) * ROWB, 0);
#pragma unroll
    for (int i = 0; i < 2; ++i) { const int id = tid + NTHR * i, row = id >> 4, ch = id & 15; *(LAS v4u*)(lds + QS + row * 272 + ch * 16) = rq[i]; *(LAS v4u*)(lds + KS + row * 272 + ch * 16) = rk4[i]; }
    *(LAS v4u*)(lds + VST + (2 * dp) * 144 + 16 * sg) = (v4u){(rvt[0] & 0xffffu) | (rvt[1] << 16), (rvt[2] & 0xffffu) | (rvt[3] << 16), (rvt[4] & 0xffffu) | (rvt[5] << 16), (rvt[6] & 0xffffu) | (rvt[7] << 16)};
    *(LAS v4u*)(lds + VST + (2 * dp + 1) * 144 + 16 * sg) = (v4u){(rvt[0] >> 16) | (rvt[1] & 0xffff0000u), (rvt[2] >> 16) | (rvt[3] & 0xffff0000u), (rvt[4] >> 16) | (rvt[5] & 0xffff0000u), (rvt[6] >> 16) | (rvt[7] & 0xffff0000u)};
#pragma unroll
    for (int i = 0; i < 4; ++i) { const int id = tid + NTHR * i, row = id >> 4, ch = id & 15; *(LAS v4u*)(lds + CBF + row * 272 + ch * 16) = rc[i]; }
    LBAR();
    const LAS float* gt = (const LAS float*)(lds + GT); const LAS float* nn = (const LAS float*)(lds + NN);
    {
        { f32x4 sa[2] = {{0.f, 0.f, 0.f, 0.f}, {0.f, 0.f, 0.f, 0.f}};
#pragma unroll
          for (int kk = 0; kk < 4; ++kk) { const bf16x8 af = frag16(lds + QS, 272, ti * 16, kk, lane);
#pragma unroll
              for (int jj = 0; jj < 2; ++jj) { const bf16x8 bfr = frag16(lds + KS, 272, (sj0 + jj) * 16, kk, lane); sa[jj] = __builtin_amdgcn_mfma_f32_16x16x32_bf16(af, bfr, sa[jj], 0, 0, 0); } }
          float pt[4];
#pragma unroll
          for (int r = 0; r < 4; ++r) pt[r] = fmaxf(mpv, gt[128 + ti * 16 + 4 * q4 + r]);
#pragma unroll
          for (int jj = 0; jj < 2; ++jj) { const int s = (sj0 + jj) * 16 + c16; const float es = gt[s];
#pragma unroll
              for (int r = 0; r < 4; ++r) { const int t = ti * 16 + 4 * q4 + r; const float v = s <= t ? sa[jj][r] * KSCALE * fexp(es - pt[r]) : 0.f;
                  *(LAS bf16*)(lds + WS + t * 144 + s * 2) = (bf16)f2bf(v); } } }
    }
    LBAR();
    f32x4 ha[4];
    {
        { const int trow = ti * 16 + c16;
          float dsum = 0.f, qn = 0.f;
          { const LAS bf16x8* wp = (const LAS bf16x8*)(lds + WS + trow * 144 + q4 * 32);
#pragma unroll
            for (int i = 0; i < 2; ++i) { const bf16x8 v8 = wp[i];
#pragma unroll
                for (int e = 0; e < 8; ++e) dsum += bf2f((bf16)v8[e]); }
            const LAS bf16x8* qp = (const LAS bf16x8*)(lds + QS + trow * 272 + q4 * 64); const LAS f32x4* np = (const LAS f32x4*)(nn + q4 * 32);
#pragma unroll
            for (int i = 0; i < 4; ++i) { const bf16x8 v8 = qp[i]; const f32x4 n0 = np[2 * i], n1 = np[2 * i + 1];
                qn += bf2f((bf16)v8[0]) * n0.x + bf2f((bf16)v8[1]) * n0.y + bf2f((bf16)v8[2]) * n0.z + bf2f((bf16)v8[3]) * n0.w
                    + bf2f((bf16)v8[4]) * n1.x + bf2f((bf16)v8[5]) * n1.y + bf2f((bf16)v8[6]) * n1.z + bf2f((bf16)v8[7]) * n1.w; } }
          dsum = xsum32(xsum16(dsum)); qn = xsum32(xsum16(qn));
          const float pmt = fmaxf(mpv, gt[128 + trow]); const float dfull = dsum + fexp(mpv - pmt) * qn, dent = fmaxf(fabsf(dfull), fexp(-(gt[64 + trow] + pmt)));
          float dr[4], it4[4];
#pragma unroll
          for (int r = 0; r < 4; ++r) { dr[r] = frcp(__shfl(dent, 4 * q4 + r)); it4[r] = fexp(mpv - fmaxf(mpv, gt[128 + ti * 16 + 4 * q4 + r])); }
#pragma unroll
          for (int vj = 0; vj < 4; ++vj) ha[vj] = (f32x4){0.f, 0.f, 0.f, 0.f};
#pragma unroll
          for (int kk = 0; kk < 4; ++kk) { const bf16x8 af = frag16(lds + QS, 272, ti * 16, kk, lane);
#pragma unroll
              for (int vj = 0; vj < 4; ++vj) { const bf16x8 bfr = frag16(lds + CBF, 272, vbase + vj * 16, kk, lane); ha[vj] = __builtin_amdgcn_mfma_f32_16x16x32_bf16(af, bfr, ha[vj], 0, 0, 0); } }
#pragma unroll
          for (int vj = 0; vj < 4; ++vj)
#pragma unroll
              for (int r = 0; r < 4; ++r) ha[vj][r] *= it4[r];
#pragma unroll
          for (int kk = 0; kk < 2; ++kk) { const bf16x8 af = frag16(lds + WS, 144, ti * 16, kk, lane);
#pragma unroll
              for (int vj = 0; vj < 4; ++vj) { const bf16x8 bfr = frag16(lds + VST, 144, vbase + vj * 16, kk, lane); ha[vj] = __builtin_amdgcn_mfma_f32_16x16x32_bf16(af, bfr, ha[vj], 0, 0, 0); } }
          float sq[4] = {0.f, 0.f, 0.f, 0.f};
#pragma unroll
          for (int vj = 0; vj < 4; ++vj)
#pragma unroll
              for (int r = 0; r < 4; ++r) { ha[vj][r] = ha[vj][r] * dr[r]; sq[r] += ha[vj][r] * ha[vj][r]; }
#pragma unroll
          for (int r = 0; r < 4; ++r) { float v = row16_sum(sq[r]);
              if (c16 == 0) ((LAS float*)(lds + SSQP))[(w & 1) * 64 + ti * 16 + 4 * q4 + r] = v; } }
    }
    LBAR();
    {
#pragma unroll
        for (int vj = 0; vj < 4; ++vj)
#pragma unroll
            for (int r = 0; r < 4; ++r) asm volatile("" : "+v"(orr[vj][r]));
#pragma unroll
        for (int r = 0; r < 4; ++r) { const int t = ti * 16 + 4 * q4 + r; const float rstd = __builtin_amdgcn_rsqf((((LAS float*)(lds + SSQP))[t] + ((LAS float*)(lds + SSQP))[64 + t]) * (1.f / 128.f) + EPS);
#pragma unroll
            for (int vj = 0; vj < 4; ++vj) { const int v = vbase + vj * 16 + c16;
                __builtin_amdgcn_raw_buffer_store_b16((bf16)f2bf(ha[vj][r] * rstd * nwv[vj] * sigmoidf_(bf2f((bf16)orr[vj][r]))), ryc, voffyc + vj * 32, (rowbase + t0 + r) * (MIXW * 2), 0); } }
    }
    LBAR();
}

__device__ __forceinline__ void lru_prompt_item(Frame& F, int l, int b, int kb, int dh) {
    constexpr int L = 128, NCH = SEQ_P / L;
    constexpr int WAT = 0, WXT = 17408, XC = 34816, COMP = 69632;
    const int tid = F.tid, lane = F.lane, w = F.wave, rowbase = b * SEQ_P;
    LAS unsigned char* lds = F.lds;
    const int di = w & 1, tq = w >> 1, hi = lane >> 5, dloc = di * 32 + (lane & 31), ch = kb * 128 + dh * 64 + dloc;
    const rsrc_t ru = U_RSRC(); const rsrc_t ryc = mk_rsrc(P_YCAT, (unsigned)((size_t)MT * MIXW * 2));
    { const int d = tid & 63, cg = tid >> 6; const float* wa = INP(I_LWA) + (((size_t)l * 4 + kb) * 128 + cg * 16) * 128 + dh * 64 + d; const float* wx = INP(I_LWX) + (((size_t)l * 4 + kb) * 128 + cg * 16) * 128 + dh * 64 + d;
      float va[16], vx[16];
#pragma unroll
      for (int i = 0; i < 16; ++i) { va[i] = wa[i * 128]; vx[i] = wx[i * 128]; }
      *(LAS v4u*)(lds + WAT + d * 272 + cg * 32) = (v4u){pk2(va[0], va[1]), pk2(va[2], va[3]), pk2(va[4], va[5]), pk2(va[6], va[7])};
      *(LAS v4u*)(lds + WAT + d * 272 + cg * 32 + 16) = (v4u){pk2(va[8], va[9]), pk2(va[10], va[11]), pk2(va[12], va[13]), pk2(va[14], va[15])};
      *(LAS v4u*)(lds + WXT + d * 272 + cg * 32) = (v4u){pk2(vx[0], vx[1]), pk2(vx[2], vx[3]), pk2(vx[4], vx[5]), pk2(vx[6], vx[7])};
      *(LAS v4u*)(lds + WXT + d * 272 + cg * 32 + 16) = (v4u){pk2(vx[8], vx[9]), pk2(vx[10], vx[11]), pk2(vx[12], vx[13]), pk2(vx[14], vx[15])}; }
    const int pc = tid & 63, gq = tid >> 6;
    float cw[4][2], cb[2];
#pragma unroll
    for (int e = 0; e < 2; ++e) { cb[e] = INP(I_LCB)[l * LRUW + kb * 128 + 2 * pc + e];
#pragma unroll
        for (int j = 0; j < 4; ++j) cw[j][e] = INP(I_LCW)[((size_t)l * 4 + j) * LRUW + kb * 128 + 2 * pc + e]; }
    const float ba = INP(I_LBA)[l * LRUW + ch], bx = INP(I_LBX)[l * LRUW + ch], spl8 = 8.f * softplusf_(-INP(I_LLAM)[l * LRUW + ch]);
    const int voffs = (16 * gq * NU + UC_XR + kb * 128 + 2 * pc) * 2;
    const int voffg = ((tq * 32 + 4 * hi + 3) * NU + UC_GR + ch) * 2, voffy = ((tq * 32 + 4 * hi) * MIXW + 1536 + ch) * 2;
    unsigned rs[19];
    auto prefetch = [&](int c) {
        const int sb = (rowbase + c * L) * ROWB;
#pragma unroll
        for (int i = 0; i < 19; ++i) { rs[i] = __builtin_amdgcn_raw_buffer_load_b32(ru, voffs, sb + i * ROWB, 0); if (c == 0 && 16 * gq + i < 3) rs[i] = 0u; }
    };
    float hcar = 0.f;
    prefetch(0);
    unsigned gr[16];
#pragma unroll
    for (int r = 0; r < 16; ++r) gr[r] = __builtin_amdgcn_raw_buffer_load_b16(ru, voffg, (rowbase + (r & 3) + 8 * (r >> 2)) * ROWB, 0);
    for (int c = 0; c < NCH; ++c) {
        const int t0 = c * L;
#pragma unroll
        for (int i = 0; i < 16; ++i) { float a0 = cb[0], a1 = cb[1];
#pragma unroll
            for (int j = 0; j < 4; ++j) { a0 += cw[j][0] * lo_bf(rs[i + j]); a1 += cw[j][1] * hi_bf(rs[i + j]); }
            *(LAS unsigned*)(lds + XC + (16 * gq + i) * 272 + 4 * pc) = pk2(a0, a1); }
        if (c + 1 < NCH) prefetch(c + 1);
        LBAR();
        f32x16 ra, ri; for (int r = 0; r < 16; ++r) { ra[r] = 0.f; ri[r] = 0.f; }
#pragma unroll
        for (int kk = 0; kk < 8; ++kk) { const bf16x8 af = frag32(lds + XC, 272, tq * 32, kk, lane);
            const bf16x8 b0 = frag32(lds + WAT, 272, di * 32, kk, lane), b1 = frag32(lds + WXT, 272, di * 32, kk, lane);
            ra = __builtin_amdgcn_mfma_f32_32x32x16_bf16(af, b0, ra, 0, 0, 0); ri = __builtin_amdgcn_mfma_f32_32x32x16_bf16(af, b1, ri, 0, 0, 0); }
#pragma unroll
        for (int r = 0; r < 16; ++r) { const int t = tq * 32 + crow32(r, hi);
            const float rg = frcp(1.f + fexp(-(ra[r] + ba))), ig = frcp(1.f + fexp(-(ri[r] + bx))), la = -spl8 * rg, x2 = 2.f * la;
            const float av = fexp(la), om = x2 > -0.03f ? -x2 * (1.f + x2 * (0.5f + x2 * (0.16666667f + x2 * 0.041666668f))) : 1.f - av * av;
            float mult = __builtin_amdgcn_sqrtf(om); if (c == 0 && t == 0) mult = 1.f;
            const float xcv = bf2f(*(const LAS bf16*)(lds + XC + t * 272 + (dh * 64 + dloc) * 2));
            ra[r] = av; ri[r] = mult * ig * xcv; }
        float GA[4], GB[4], OA[4], OB[4], PA[4], PB[4];
#pragma unroll
        for (int g = 0; g < 4; ++g) { const float a0 = ra[4 * g], a1 = ra[4 * g + 1], a2 = ra[4 * g + 2], a3 = ra[4 * g + 3];
            GA[g] = (a0 * a1) * (a2 * a3); GB[g] = ((ri[4 * g] * a1 + ri[4 * g + 1]) * a2 + ri[4 * g + 2]) * a3 + ri[4 * g + 3];
            OA[g] = xchg32(GA[g], lane); OB[g] = xchg32(GB[g], lane); }
        float TA = 1.f, TB = 0.f;
#pragma unroll
        for (int g = 0; g < 4; ++g) {
            const float A0 = hi ? OA[g] : GA[g], B0 = hi ? OB[g] : GB[g], A1 = hi ? GA[g] : OA[g], B1 = hi ? GB[g] : OB[g];
            const float eA = TA, eB = TB; TB = A0 * TB + B0; TA = A0 * TA;
            const float oA = TA, oB = TB; TB = A1 * TB + B1; TA = A1 * TA;
            PA[g] = hi ? oA : eA; PB[g] = hi ? oB : eB; }
        if (hi == 0) { LAS float* cp = (LAS float*)(lds + COMP) + (tq * 64 + dloc) * 2; cp[0] = TA; cp[1] = TB; }
        LBAR();
        float hin = hcar, hall = hcar;
#pragma unroll
        for (int q = 0; q < 4; ++q) { const LAS float* cp = (const LAS float*)(lds + COMP) + (q * 64 + dloc) * 2; const float qa = cp[0], qb = cp[1];
            hall = qa * hall + qb; if (q < tq) hin = hall; }
        hcar = hall;
#pragma unroll
        for (int r = 0; r < 16; ++r) asm volatile("" : "+v"(gr[r]));
#pragma unroll
        for (int g = 0; g < 4; ++g) { float hv = PA[g] * hin + PB[g];
#pragma unroll
            for (int j = 0; j < 4; ++j) { const int r = 4 * g + j; hv = ra[r] * hv + ri[r];
                const float x = bf2f((bf16)gr[r]), u = 0.7978845608028654f * (x + 0.044715f * x * x * x), th = 1.f - 2.f * frcp(fexp(2.f * u) + 1.f);
                __builtin_amdgcn_raw_buffer_store_b16((bf16)f2bf(hv * 0.5f * x * (1.f + th)), ryc, voffy, (rowbase + t0 + (r & 3) + 8 * (r >> 2)) * (MIXW * 2), 0); } }
        if (c + 1 < NCH) {
#pragma unroll
            for (int r = 0; r < 16; ++r) gr[r] = __builtin_amdgcn_raw_buffer_load_b16(ru, voffg, (rowbase + t0 + L + (r & 3) + 8 * (r >> 2)) * ROWB, 0); }
    }
    if (tq == 0 && hi == 0) OUTP()[O_P_LH + ((size_t)l * NB_P + b) * LRUW + ch] = hcar;
    if (tid < 192) { const int j = tid >> 6, dd = tid & 63, cc = kb * 128 + dh * 64 + dd;
        OUTP()[O_P_LCONV + (((size_t)l * NB_P + b) * 3 + j) * LRUW + cc] = bf2f(P_U[(size_t)(rowbase + SEQ_P - 3 + j) * NU + UC_XR + cc]); }
    LBAR();
}

__device__ __forceinline__ void ssd_sample_item(Frame& F, int l, int b, int g) {
    const int tid = F.tid, rowbase = MP + b * SEQ_S, p = tid >> 3, nq = tid & 7, n0 = nq * 16;
    LAS float* xs = (LAS float*)F.lds; LAS float* Bm = xs + 8 * 512; LAS float* Cm = Bm + 1024; LAS float* dts = Cm + 1024; LAS float* dAs = dts + 64; LAS float* ybuf = dAs + 64;
    const bf16* U = P_U; const float* gates = P_GATES; bf16* YC = P_YCAT; const float* snw = INP(I_SNW) + l * 1024;
    { const float* cw = INP(I_SCW) + (size_t)l * 4 * CONVD; const float* cb = INP(I_SCB) + (size_t)l * CONVD; const float* hist = INP(I_SCONV) + ((size_t)l * NB_S + b) * 3 * CONVD;
#pragma unroll
      for (int k = 0; k < 2; ++k) { const int ci = tid + NTHR * k;
          if (ci < 768) { const int c = ci < 512 ? g * 512 + ci : (ci < 640 ? 1024 + g * 128 + (ci - 512) : 1280 + g * 128 + (ci - 640));
              float v[11];
#pragma unroll
              for (int j = 0; j < 3; ++j) v[j] = hist[j * CONVD + c];
#pragma unroll
              for (int t = 0; t < 8; ++t) v[3 + t] = bf2f(U[(size_t)(rowbase + t) * NU + UC_XBC + c]);
              const float w0 = cw[c], w1 = cw[CONVD + c], w2 = cw[2 * CONVD + c], w3 = cw[3 * CONVD + c], bb = cb[c];
#pragma unroll
              for (int t = 0; t < 8; ++t) { const float act = siluf_(bb + w0 * v[t] + w1 * v[t + 1] + w2 * v[t + 2] + w3 * v[t + 3]);
                  if (ci < 512) xs[t * 512 + ci] = act; else if (ci < 640) Bm[t * 128 + ci - 512] = act; else Cm[t * 128 + ci - 640] = act; } } } }
    if (tid < 64) { const int hh = tid >> 3, tt = tid & 7, h = g * 8 + hh; const float dt = softplusf_(gates[(size_t)(rowbase + tt) * NG + h] + INP(I_DTB)[l * 16 + h]);
        dts[tid] = dt; dAs[tid] = fexp(-dt * fexp(INP(I_ALOG)[l * 16 + h])); }
    const f32x4* sin = (const f32x4*)(INP(I_SSM) + ((((size_t)l * NB_S + b) * 16 + g * 8) * 64 + p) * 128) + nq;
    f32x4* sout = (f32x4*)(OUTP() + O_S_SSM + ((((size_t)l * NB_S + b) * 16 + g * 8) * 64 + p) * 128) + nq;
    LAS float* zbuf = ybuf + 4096; LAS float* nwbuf = zbuf + 8 * 512; LAS float* dbuf = nwbuf + 512;
#pragma unroll
    for (int hh = 0; hh < 8; ++hh) zbuf[hh * 512 + tid] = bf2f(U[(size_t)(rowbase + nq) * NU + UC_Z + (g * 8 + hh) * 64 + p]);
    nwbuf[tid] = snw[g * 512 + tid]; if (tid < 8) dbuf[tid] = INP(I_SSD_D)[l * 16 + g * 8 + tid];
    f32x4 Sn[4], Sm[4];
#pragma unroll
    for (int j = 0; j < 4; ++j) { Sn[j] = sin[8 * j]; Sm[j] = sin[2048 + 8 * j]; }
    LBAR();
#pragma unroll 2
    for (int hh = 0; hh < 8; ++hh) {
        const int h = g * 8 + hh;
        float S[16];
#pragma unroll
        for (int j = 0; j < 4; ++j) { S[4 * j] = Sn[j].x; S[4 * j + 1] = Sn[j].y; S[4 * j + 2] = Sn[j].z; S[4 * j + 3] = Sn[j].w; Sn[j] = Sm[j]; }
        if (hh < 6) {
#pragma unroll
            for (int j = 0; j < 4; ++j) Sm[j] = sin[(hh + 2) * 2048 + 8 * j]; }
        const float zv = zbuf[hh * 512 + tid];
        float ymine = 0.f;
#pragma unroll
        for (int tt = 0; tt < 8; ++tt) {
            const float dt = dts[hh * 8 + tt], dA = dAs[hh * 8 + tt], dx = dt * xs[tt * 512 + hh * 64 + p]; float part = 0.f;
#pragma unroll
            for (int j = 0; j < 16; ++j) { const int n = ((j >> 2) * 8 + nq) * 4 + (j & 3); S[j] = dA * S[j] + dx * Bm[tt * 128 + n]; part += Cm[tt * 128 + n] * S[j]; }
            part = row8_sum(part);
            ymine = (nq == tt) ? part : ymine; }
        { const float y = ymine + dbuf[hh] * xs[nq * 512 + hh * 64 + p], yz = y * siluf_(zv);
          YC[(size_t)(rowbase + nq) * MIXW + h * 64 + p] = (bf16)f2bf(yz * nwbuf[hh * 64 + p]); ybuf[(hh * 8 + nq) * 64 + p] = yz; }
#pragma unroll
        for (int j = 0; j < 4; ++j) sout[hh * 2048 + 8 * j] = (f32x4){S[4 * j], S[4 * j + 1], S[4 * j + 2], S[4 * j + 3]};
    }
    LBAR();
    { const int pr = tid >> 3, part = tid & 7, hh = pr >> 3, tt = pr & 7; float s = 0.f;
#pragma unroll
      for (int j = 0; j < 8; ++j) { const float y = ybuf[pr * 64 + part * 8 + j]; s += y * y; }
      s = row8_sum(s);
      if (part == 0) P_SSQ[(size_t)(rowbase + tt) * 16 + g * 8 + hh] = s; }
    if (g == 0) { float* co = OUTP() + O_S_SCONV + ((size_t)l * NB_S + b) * 3 * CONVD;
        for (int idx = tid; idx < 3 * CONVD; idx += NTHR) { const int j = idx / CONVD, c = idx % CONVD; co[idx] = bf2f(U[(size_t)(rowbase + SEQ_S - 3 + j) * NU + UC_XBC + c]); } }
    LBAR();
}

__device__ __forceinline__ void mlstm_sample_item(Frame& F, int l, int b, int h) {
    const int tid = F.tid, rowbase = MP + b * SEQ_S, v = tid >> 3, dq = tid & 7;
    LAS float* q = (LAS float*)F.lds; LAS float* k = q + 1024; LAS float* vv = k + 1024; LAS float* oo = vv + 1024; LAS float* igs = oo + 1024; LAS float* lfs = igs + 8; LAS float* hbuf = lfs + 8;
    const bf16* U = P_U; const float* gates = P_GATES;
    const f32x4* cpa = (const f32x4*)(INP(I_MC) + ((((size_t)l * NB_S + b) * 4 + h) * 128 + v) * 128) + dq; const f32x4* cpb = cpa + 64 * 32;
    const f32x4* np = (const f32x4*)(INP(I_MN) + (((size_t)l * NB_S + b) * 4 + h) * 128) + dq;
    f32x4 ca[4], cb[4], n4[4];
#pragma unroll
    for (int j = 0; j < 4; ++j) { ca[j] = cpa[8 * j]; cb[j] = cpb[8 * j]; n4[j] = np[8 * j]; }
    float m = INP(I_MM)[((size_t)l * NB_S + b) * 4 + h];
    { float vals[8];
#pragma unroll
      for (int j8 = 0; j8 < 8; ++j8) { const int idx = tid + NTHR * j8, arr = idx >> 10, tt = (idx >> 7) & 7, d = idx & 127; vals[j8] = bf2f(U[(size_t)(rowbase + tt) * NU + UC_Q + arr * 512 + h * 128 + d]); }
#pragma unroll
      for (int j8 = 0; j8 < 8; ++j8) { const int idx = tid + NTHR * j8; q[idx] = (idx >> 10) == 1 ? vals[j8] * 0.08838834764831845f : vals[j8]; } }
    if (tid < 8) { const size_t row = (size_t)(rowbase + tid); igs[tid] = gates[row * NG + 16 + h] + INP(I_MIB)[l * 4 + h]; lfs[tid] = -softplusf_(-(gates[row * NG + 20 + h] + INP(I_MFB)[l * 4 + h])); }
    LBAR();
#pragma unroll 2
    for (int tt = 0; tt < 8; ++tt) {
        const float igv = igs[tt], lfv = lfs[tt], mn = fmaxf(lfv + m, igv), al = fexp(lfv + m - mn), be = fexp(igv - mn); m = mn;
        const float bva = be * vv[tt * 128 + v], bvb = be * vv[tt * 128 + 64 + v]; f32x4 pa = {0.f, 0.f, 0.f, 0.f}, pb = pa, pd = pa;
#pragma unroll
        for (int j = 0; j < 4; ++j) { const f32x4 k4 = *(const LAS f32x4*)(k + tt * 128 + (dq + 8 * j) * 4), q4 = *(const LAS f32x4*)(q + tt * 128 + (dq + 8 * j) * 4);
            ca[j] = ca[j] * al + k4 * bva; cb[j] = cb[j] * al + k4 * bvb; n4[j] = n4[j] * al + k4 * be; pa += ca[j] * q4; pb += cb[j] * q4; pd += n4[j] * q4; }
        float sa = (pa.x + pa.y) + (pa.z + pa.w), sb = (pb.x + pb.y) + (pb.z + pb.w), sd = (pd.x + pd.y) + (pd.z + pd.w);
        sa = row8_sum(sa); sb = row8_sum(sb); sd = row8_sum(sd);
        if (dq == 0) { const float rd = frcp(fmaxf(fabsf(sd), fexp(-m))); hbuf[tt * 128 + v] = sa * rd; hbuf[tt * 128 + 64 + v] = sb * rd; }
    }
    const float* nwp = INP(I_MNW) + l * 512 + h * 128; const float nwa = nwp[F.lane], nwb = nwp[64 + F.lane];
    { f32x4* coa = (f32x4*)(OUTP() + O_S_MC + ((((size_t)l * NB_S + b) * 4 + h) * 128 + v) * 128) + dq; f32x4* cob = coa + 64 * 32;
#pragma unroll
      for (int j = 0; j < 4; ++j) { coa[8 * j] = ca[j]; cob[8 * j] = cb[j]; }
      if (v == 0) { f32x4* no = (f32x4*)(OUTP() + O_S_MN + (((size_t)l * NB_S + b) * 4 + h) * 128) + dq;
#pragma unroll
          for (int j = 0; j < 4; ++j) no[8 * j] = n4[j]; }
      if (tid == 0) OUTP()[O_S_MM + ((size_t)l * NB_S + b) * 4 + h] = m; }
    LBAR();
    { const int tt = F.wave; const size_t row = (size_t)(rowbase + tt); const float h0 = hbuf[tt * 128 + F.lane], h1 = hbuf[tt * 128 + 64 + F.lane];
      const float rstd = __builtin_amdgcn_rsqf(wave_sum(h0 * h0 + h1 * h1) * (1.f / 128.f) + EPS);
      bf16* yo = P_YCAT + row * MIXW + 1024 + h * 128;
      yo[F.lane] = (bf16)f2bf(h0 * rstd * nwa * sigmoidf_(oo[tt * 128 + F.lane])); yo[64 + F.lane] = (bf16)f2bf(h1 * rstd * nwb * sigmoidf_(oo[tt * 128 + 64 + F.lane])); }
    LBAR();
}

__device__ __forceinline__ void lru_sample_item(Frame& F, int l, int kb, int dh, int bg) {
    constexpr int WAT = 0, WXT = 17408, XC = 34816;
    const int tid = F.tid, lane = F.lane, w = F.wave, rowbase = MP + bg * 128;
    LAS unsigned char* lds = F.lds;
    const int di = w & 1, tq = w >> 1, hi = lane >> 5, dloc = di * 32 + (lane & 31), ch = kb * 128 + dh * 64 + dloc;
    const bf16* U = P_U; bf16* YC = P_YCAT;
    { const int d = tid & 63, cg = tid >> 6; const float* wa = INP(I_LWA) + (((size_t)l * 4 + kb) * 128 + cg * 16) * 128 + dh * 64 + d; const float* wx = INP(I_LWX) + (((size_t)l * 4 + kb) * 128 + cg * 16) * 128 + dh * 64 + d;
      float va[16], vx[16];
#pragma unroll
      for (int i = 0; i < 16; ++i) { va[i] = wa[i * 128]; vx[i] = wx[i * 128]; }
      *(LAS v4u*)(lds + WAT + d * 272 + cg * 32) = (v4u){pk2(va[0], va[1]), pk2(va[2], va[3]), pk2(va[4], va[5]), pk2(va[6], va[7])};
      *(LAS v4u*)(lds + WAT + d * 272 + cg * 32 + 16) = (v4u){pk2(va[8], va[9]), pk2(va[10], va[11]), pk2(va[12], va[13]), pk2(va[14], va[15])};
      *(LAS v4u*)(lds + WXT + d * 272 + cg * 32) = (v4u){pk2(vx[0], vx[1]), pk2(vx[2], vx[3]), pk2(vx[4], vx[5]), pk2(vx[6], vx[7])};
      *(LAS v4u*)(lds + WXT + d * 272 + cg * 32 + 16) = (v4u){pk2(vx[8], vx[9]), pk2(vx[10], vx[11]), pk2(vx[12], vx[13]), pk2(vx[14], vx[15])}; }
    { const int pc = tid & 63, gq = tid >> 6, c0 = kb * 128 + 2 * pc;
      float cw[4][2], cb[2];
#pragma unroll
      for (int e = 0; e < 2; ++e) { cb[e] = INP(I_LCB)[l * LRUW + c0 + e];
#pragma unroll
          for (int j = 0; j < 4; ++j) cw[j][e] = INP(I_LCW)[((size_t)l * 4 + j) * LRUW + c0 + e]; }
#pragma unroll
      for (int bb = 0; bb < 2; ++bb) { const int batch = bg * 16 + 2 * gq + bb; const float* hist = INP(I_LCONV) + ((size_t)l * NB_S + batch) * 3 * LRUW + c0;
          float v0[11], v1[11];
#pragma unroll
          for (int j = 0; j < 3; ++j) { v0[j] = hist[j * LRUW]; v1[j] = hist[j * LRUW + 1]; }
#pragma unroll
          for (int t = 0; t < 8; ++t) { const unsigned u = *(const unsigned*)(U + (size_t)(MP + batch * 8 + t) * NU + UC_XR + c0); v0[3 + t] = lo_bf(u); v1[3 + t] = hi_bf(u); }
#pragma unroll
          for (int t = 0; t < 8; ++t) { const float a0 = cb[0] + cw[0][0] * v0[t] + cw[1][0] * v0[t + 1] + cw[2][0] * v0[t + 2] + cw[3][0] * v0[t + 3], a1 = cb[1] + cw[0][1] * v1[t] + cw[1][1] * v1[t + 1] + cw[2][1] * v1[t + 2] + cw[3][1] * v1[t + 3];
              *(LAS unsigned*)(lds + XC + (16 * gq + 8 * bb + t) * 272 + 4 * pc) = pk2(a0, a1); } } }
    const float ba = INP(I_LBA)[l * LRUW + ch], bx = INP(I_LBX)[l * LRUW + ch], spl8 = 8.f * softplusf_(-INP(I_LLAM)[l * LRUW + ch]);
    float gr[16], h0[4];
#pragma unroll
    for (int r = 0; r < 16; ++r) gr[r] = bf2f(U[(size_t)(rowbase + tq * 32 + crow32(r, hi)) * NU + UC_GR + ch]);
#pragma unroll
    for (int g = 0; g < 4; ++g) h0[g] = INP(I_LH)[((size_t)l * NB_S + bg * 16 + tq * 4 + g) * LRUW + ch];
    LBAR();
    f32x16 ra, ri; for (int r = 0; r < 16; ++r) { ra[r] = 0.f; ri[r] = 0.f; }
#pragma unroll
    for (int kk = 0; kk < 8; ++kk) { const bf16x8 af = frag32(lds + XC, 272, tq * 32, kk, lane);
        const bf16x8 b0 = frag32(lds + WAT, 272, di * 32, kk, lane), b1 = frag32(lds + WXT, 272, di * 32, kk, lane);
        ra = __builtin_amdgcn_mfma_f32_32x32x16_bf16(af, b0, ra, 0, 0, 0); ri = __builtin_amdgcn_mfma_f32_32x32x16_bf16(af, b1, ri, 0, 0, 0); }
#pragma unroll
    for (int r = 0; r < 16; ++r) { const int t = tq * 32 + crow32(r, hi);
        const float rg = frcp(1.f + fexp(-(ra[r] + ba))), ig = frcp(1.f + fexp(-(ri[r] + bx))), la = -spl8 * rg, x2 = 2.f * la;
        const float av = fexp(la), om = x2 > -0.03f ? -x2 * (1.f + x2 * (0.5f + x2 * (0.16666667f + x2 * 0.041666668f))) : 1.f - av * av;
        const float xcv = bf2f(*(const LAS bf16*)(lds + XC + t * 272 + (dh * 64 + dloc) * 2));
        ra[r] = av; ri[r] = __builtin_amdgcn_sqrtf(om) * ig * xcv; }
#pragma unroll
    for (int g = 0; g < 4; ++g) {
        float hv = h0[g], lo4[4], hi4[4];
#pragma unroll
        for (int j = 0; j < 4; ++j) { hv = ra[4 * g + j] * hv + ri[4 * g + j]; lo4[j] = hv; }
        float hx = xchg32(hv, lane);
#pragma unroll
        for (int j = 0; j < 4; ++j) { hx = ra[4 * g + j] * hx + ri[4 * g + j]; hi4[j] = hx; }
#pragma unroll
        for (int j = 0; j < 4; ++j) { const float hh = hi ? hi4[j] : lo4[j], x = gr[4 * g + j], u = 0.7978845608028654f * (x + 0.044715f * x * x * x), th = 1.f - 2.f * frcp(fexp(2.f * u) + 1.f);
            YC[(size_t)(rowbase + tq * 32 + 8 * g + 4 * hi + j) * MIXW + 1536 + ch] = (bf16)f2bf(hh * 0.5f * x * (1.f + th)); }
        if (hi) OUTP()[O_S_LH + ((size_t)l * NB_S + bg * 16 + tq * 4 + g) * LRUW + ch] = hx;
    }
    for (int idx = tid; idx < 16 * 3 * 64; idx += NTHR) { const int bb = idx / 192, j = (idx >> 6) % 3, dd = idx & 63, batch = bg * 16 + bb, cc = kb * 128 + dh * 64 + dd;
        OUTP()[O_S_LCONV + (((size_t)l * NB_S + batch) * 3 + j) * LRUW + cc] = bf2f(U[(size_t)(MP + batch * 8 + 5 + j) * NU + UC_XR + cc]); }
    LBAR();
}

__device__ __forceinline__ void mixer_phase(Frame& F, int l, int rep) {
    constexpr int NCV = (CONV_ALL - CONV_EARLY) / NWAVES;
    static_assert((CONV_ALL - CONV_EARLY) % NWAVES == 0, "conversion items per block");
    const int ncv = l == 0 ? NCV : 0;
    constexpr int N0 = 32, N1 = N0 + 128, N2 = N1 + 64, N3 = N2 + 256, N4 = N3 + 512, N5 = N4 + 64;
    volatile LAS int* slot = (volatile LAS int*)(F.lds + 65536);
    for (;;) {
        if (F.tid == 0) *slot = (int)atomicAdd(P_CTL + CW_Q + 64 * l + 128 * rep, 1u);
        LBAR();
        const int q = __builtin_amdgcn_readfirstlane(*slot);
        LBAR();
#ifndef DUPMIX
#define DUPMIX 0
#endif
        constexpr int DUP_LO = DUPMIX == 5 ? 0 : DUPMIX == 6 ? N0 : DUPMIX == 7 ? N1 : DUPMIX == 2 ? N2 : DUPMIX == 3 ? N2 : DUPMIX == 4 ? N3 : DUPMIX == 8 ? N4 : 0, DUP_N = DUPMIX == 5 ? N0 : DUPMIX == 6 ? N1 - N0 : DUPMIX == 7 ? N2 - N1 : DUPMIX == 2 ? N5 - N2 : DUPMIX == 3 ? N3 - N2 : DUPMIX == 4 ? N4 - N3 : DUPMIX == 8 ? N5 - N4 : 0;
        constexpr int NSB2 = SSD2F ? NB_P * 32 * 2 : 0, NPB = (MERGEB && !SSD2PASS) ? NSB2 + NB_P * 4 * 32 : 0;
        if (q >= N5 + ncv + NPB + DUP_N + (DUPMIX == 9 ? NPB : 0)) break;
#ifndef QORDER
#define QORDER 0
#endif
        constexpr int NS = N5 - N2;
        const bool conv = QORDER == 1 ? (q >= N5 && q < N5 + ncv) : (q >= N2 && q < N2 + ncv);
        const bool passb = (q >= N5 + ncv && q < N5 + ncv + NPB) || (DUPMIX == 9 && q >= N5 + ncv + NPB);
        const int qb = (DUPMIX == 9 && q >= N5 + ncv + NPB) ? q - NPB : q;
        const int it = q >= N5 + ncv + NPB ? q - (N5 + ncv + NPB) + DUP_LO : QORDER == 1 ? (q < NS ? N2 + q : q - NS) : (q < N2 ? q : q - ncv);
        { int wv_ = F.wave; asm volatile("" : "+s"(wv_)); int t_ = wv_ * 64 + (int)__builtin_amdgcn_mbcnt_hi(~0u, __builtin_amdgcn_mbcnt_lo(~0u, 0u)); asm volatile("" : "+v"(t_)); F.tid = t_; F.lane = t_ & 63; F.wave = __builtin_amdgcn_readfirstlane(t_ >> 6); }
#ifndef ITEMMASK
#define ITEMMASK 63
#endif
        if (passb) { const int j0 = qb - (N5 + ncv); if (j0 < NSB2) ssd_passB2(F, l, j0 >> 6, (j0 >> 1) & 31, j0 & 1, rep); else { const int j = j0 - NSB2; mlstm_passB(F, l, j >> 7, (j >> 5) & 3, j & 31, rep); } }
        else if (conv) { convert_item(F, CONV_EARLY + (q - N2) * NWAVES + F.wave); LBAR(); }
        else if (it < N0) { if (ITEMMASK & 1) mlstm_passA(F, l, it >> 2, it & 3, rep); }
        else if (it < N1) { if (ITEMMASK & 2) { if (SSD2F) ssd_passA2(F, l, (it - N0) >> 4, (it - N0) & 15, rep); else if (SSD2PASS) ssd_passA(F, l, (it - N0) >> 4, (it - N0) & 15); else ssd_prompt_item(F, l, (it - N0) >> 4, (it - N0) & 15); } }
        else if (it < N2) { if (ITEMMASK & 4) lru_prompt_item(F, l, (it - N1) >> 3, ((it - N1) >> 1) & 3, (it - N1) & 1); }
        else if (it < N3) { if (ITEMMASK & 8) ssd_sample_item(F, l, (it - N2) >> 1, (it - N2) & 1); }
        else if (it < N4) { if (ITEMMASK & 16) mlstm_sample_item(F, l, (it - N3) >> 2, (it - N3) & 3); }
        else { if (ITEMMASK & 32) lru_sample_item(F, l, (it - N4) >> 4, ((it - N4) >> 3) & 1, (it - N4) & 7); }
    }
}

__device__ __forceinline__ void mixerB_phase(Frame& F, int l, int rep) {
    constexpr int NSB = SSD2PASS ? NB_P * 32 * 2 : 0, NSM = NSB, NB = NSM + NB_P * 4 * 32;
    volatile LAS int* slot = (volatile LAS int*)(F.lds + MISC_OFF + 64);
    for (;;) {
        if (F.tid == 0) *slot = (int)atomicAdd(P_CTL + CW_Q + 64 * l + 256 + 128 * rep, 1u);
        __syncthreads();
        int it = __builtin_amdgcn_readfirstlane(*slot);
        __syncthreads();
#ifndef DUPB
#define DUPB 0
#endif
        if (it >= NB + (DUPB == 1 ? NSB : DUPB == 2 ? NB - NSM : 0)) break;
        if (it >= NB) it = DUPB == 1 ? it - NB : it - NB + NSM;
        { int wv_ = F.wave; asm volatile("" : "+s"(wv_)); int t_ = wv_ * 64 + (int)__builtin_amdgcn_mbcnt_hi(~0u, __builtin_amdgcn_mbcnt_lo(~0u, 0u)); asm volatile("" : "+v"(t_)); F.tid = t_; F.lane = t_ & 63; F.wave = __builtin_amdgcn_readfirstlane(t_ >> 6); }
        if (it < NSB) ssd_passB(F, l, it >> 6, (it >> 1) & 31, it & 1);
        else if (it < NSM) mlstm_sample_item(F, l, (it - NSB) >> 2, (it - NSB) & 3);
        else { const int j = it - NSM; mlstm_passB(F, l, j >> 7, (j >> 5) & 3, j & 31, -1); }
    }
}

#ifndef PHMASK
#define PHMASK 1023
#endif
constexpr int NPH = 18;
__global__ void __launch_bounds__(NTHR, 2) mega(Args args) {
    extern __shared__ __attribute__((aligned(16))) unsigned char lds_raw[];
    Frame F;
    F.lds = (LAS unsigned char*)lds_raw;
    const int wave_s = __builtin_amdgcn_readfirstlane((int)threadIdx.x >> 6);
    F.wave = wave_s; F.lane = (int)__builtin_amdgcn_mbcnt_hi(~0u, __builtin_amdgcn_mbcnt_lo(~0u, 0u)); F.tid = wave_s * 64 + F.lane; F.G = gridDim.x;
    volatile LAS unsigned* MISC = (volatile LAS unsigned*)(F.lds + MISC_OFF);
    for (int u = F.tid; u < (LDS_BYTES - LDSCTL_OFF) / 4; u += NTHR) ((LAS unsigned*)(F.lds + LDSCTL_OFF))[u] = 0u;
    __syncthreads();
    XcdBarrier bar; bar.bar = nullptr; bar.x = 0; bar.st = nullptr;
    const bool multi = (args.ph_hi - args.ph_lo) > 1;
    if (multi) bar = xcd_barrier_post(P_CTL + CW_BAR, MISC + 8, F.tid);
#ifndef DUPPH
#define DUPPH -1
#endif
    int rep = 0;
    for (int ph = args.ph_lo; ph < args.ph_hi; ++ph) {
        { int wv_ = wave_s; asm volatile("" : "+s"(wv_)); int t_ = wv_ * 64 + (int)__builtin_amdgcn_mbcnt_hi(~0u, __builtin_amdgcn_mbcnt_lo(~0u, 0u)); asm volatile("" : "+v"(t_)); F.tid = t_; F.lane = t_ & 63; F.wave = __builtin_amdgcn_readfirstlane(t_ >> 6); }
        if (ph == 0) { if (PHMASK & 256) p0_prologue(F); }
        else if (ph == NPH - 1) { if (PHMASK & 512) final_norm_phase(F); }
        else {
            constexpr bool PREP = !SSD2PASS && MERGEB;
            const int l = (ph - 1) >> 3, sub_ = (ph - 1) & 7, sub = PREP ? (sub_ < 2 ? sub_ : sub_ - 1) : (sub_ < 3 ? sub_ : sub_ - 1);
            if (PREP && sub_ == 2) { if (PHMASK & 4) bca_prepass(F, l); }
            else if (!PREP && sub_ == 3) { if (PHMASK & 4) mixerB_phase(F, l, rep); } else
            if (sub == 0) { if (PHMASK & 1) { if (F.G == 256) norm1g_phase(F, l); else norm_phase<true>(F, l, 1); } }
            else if (sub == 1) { if (PHMASK & 2) { pg8::Gemm g{P_HN, P_WINT + (size_t)l * NU * DM, MT, NU, DM}; pg8::StaticOrder S; S.init(MT, NU, F.G, (int)blockIdx.x);
                pg8::EpiBf16<0> E{P_U, NU}; pg8::gemm_phase<pg8::EpiBf16<0>, pg8::StaticOrder, true, true>(F.lds, g, S, E, F.tid); } }
            else if (sub == 2) { if (PHMASK & 4) mixer_phase(F, l, rep); }
            else if (sub == 3) { if (PHMASK & 16) { pg8::Gemm g{P_YCAT, P_WOUTT + (size_t)l * DM * MIXW, MT, DM, MIXW}; pg8::MidkOrder S; S.init(MP, DM, MIXW, F.G, (int)blockIdx.x, 16);
                const float* gate = P_MOD + (size_t)l * MODROWS * MODLD + 2048;
                pg8::EpiResid<true> E{(const pg8::bf16_t*)P_XWB, (pg8::bf16_t*)P_XWB, gate, P_SSQ, 16, 1.f / 1024.f, EPS};     pg8::gemm_phase<pg8::EpiResid<true>, pg8::MidkOrder, true, true>(F.lds, g, S, E, F.tid);
                { pg8::SampleSplitOrder S2; S2.init(DM, MIXW, (int)blockIdx.x, 4, 16); pg8::EpiAtomic<true> E2{P_XW, gate, P_SSQ, 16, 1.f / 1024.f, EPS}; pg8::gemm_phase<pg8::EpiAtomic<true>, pg8::SampleSplitOrder, true, true>(F.lds, g, S2, E2, F.tid); } } }
            else if (sub == 4) { if (PHMASK & 32) norm_phase<false>(F, l, 2); }
            else if (sub == 5) { if (PHMASK & 64) { pg8::Gemm g{P_HN, P_WUPT + (size_t)l * DFF * DM, MT, DFF, DM}; pg8::StaticOrder S; S.init(MT, DFF, F.G, (int)blockIdx.x);
                pg8::EpiBf16<1> E{P_HID, DFF}; pg8::gemm_phase<pg8::EpiBf16<1>, pg8::StaticOrder, true, true>(F.lds, g, S, E, F.tid); } }
            else { if (PHMASK & 128) { pg8::Gemm g{P_HID, P_WDNT + (size_t)l * DM * DFF, MT, DM, DFF}; pg8::StaticOrder S; S.init(MP, DM, F.G, (int)blockIdx.x); const float* gate = P_MOD + (size_t)l * MODROWS * MODLD + 5120;
                pg8::EpiResid<false> E{(const pg8::bf16_t*)P_XWB, (pg8::bf16_t*)P_XWB, gate, nullptr, 0, 0.f, 0.f}; pg8::gemm_phase<pg8::EpiResid<false>, pg8::StaticOrder, true, true>(F.lds, g, S, E, F.tid);
                { pg8::SampleSplitOrder S2; S2.init(DM, DFF, (int)blockIdx.x, 4, 0); pg8::EpiAtomic<false> E2{P_XW, gate, nullptr, 0, 0.f, 0.f}; pg8::gemm_phase<pg8::EpiAtomic<false>, pg8::SampleSplitOrder, true, true>(F.lds, g, S2, E2, F.tid); } } }
        }
        if (ph + 1 < args.ph_hi) xcd_barrier(bar, F.tid);
        if (ph == DUPPH && rep == 0) { rep = 1; --ph; }
    }
}

extern "C" void kernel_launch(void* const* d_in, const int* in_sizes, int n_in, void* d_out, int out_size, void* d_ws, size_t ws_size, hipStream_t stream) {
    static int grid = 0;
    if (grid == 0) {
        if (n_in != 36 || out_size != (int)O_END || ws_size < WS_END) { fprintf(stderr, "kernel_launch: unexpected shapes: n_in %d out %d ws %zu; nothing launched\n", n_in, out_size, ws_size); grid = -1; return; }
        int dev = 0, cus = 0, per_cu = 0;
        if (hipGetDevice(&dev) != hipSuccess || hipDeviceGetAttribute(&cus, hipDeviceAttributeMultiprocessorCount, dev) != hipSuccess) { grid = -1; return; }
        if (hipFuncSetAttribute((const void*)mega, hipFuncAttributeMaxDynamicSharedMemorySize, LDS_BYTES) != hipSuccess) { fprintf(stderr, "kernel_launch: hipFuncSetAttribute failed\n"); grid = -1; return; }
        if (hipOccupancyMaxActiveBlocksPerMultiprocessor(&per_cu, (const void*)mega, NTHR, LDS_BYTES) != hipSuccess || per_cu < 1) { fprintf(stderr, "kernel_launch: occupancy query says %d\n", per_cu); per_cu = 1; }
        (void)hipGetLastError();
        grid = cus;
    }
    if (grid < 0) return;
    if (hipMemsetAsync((char*)d_ws + WS_CTL, 0, CTL_ZERO_BYTES, stream) != hipSuccess) { fprintf(stderr, "kernel_launch: memset failed\n"); return; }
    Args a{};
    for (int i = 0; i < 36; ++i) a.in[i] = (const float*)d_in[i];
    a.out = (float*)d_out; a.ws = (unsigned char*)d_ws;
#if MK_ONE
    a.ph_lo = 0; a.ph_hi = NPH;
    { void* kargs[] = {&a}; hipError_t e = hipLaunchCooperativeKernel((const void*)mega, dim3(grid), dim3(NTHR), kargs, LDS_BYTES, stream);
      if (e != hipSuccess) fprintf(stderr, "kernel_launch: cooperative launch failed: %s (grid %d)\n", hipGetErrorString(e), grid); }
#else
    for (int ph = 0; ph < NPH; ++ph) { a.ph_lo = ph; a.ph_hi = ph + 1; hipLaunchKernelGGL(mega, dim3(grid), dim3(NTHR), LDS_BYTES, stream, a); }
#endif
}
```
